# Optimizing an MI355X kernel written in HIP

```python
import math
import jax, jax.numpy as jnp
from jax import lax
import numpy as np

D_MODEL = 1024
BATCH = 2
SEQ = 8192
DEPTH = 4

N_A_LAYERS = DEPTH // 2
N_B_LAYERS = DEPTH - N_A_LAYERS
ALPHA = (2.0 * DEPTH) ** 0.25
BETA = (8.0 * DEPTH) ** -0.25
LN_EPS = 1e-5
A_HEADS = 4
A_DQK = D_MODEL // 8
A_DV = D_MODEL // 4
A_CHUNK = 64
A_PROJ = 2 * A_HEADS * A_DQK + 2 * A_HEADS * A_DV + 2 * A_HEADS
A_NORM_EPS = 1e-6
B_WINDOWS = (128, 512, 2048)
B_DILATIONS = (1, 4, 16)
B_GROUPS = 3
B_HEADS = 8
B_HEAD_DIM = 64
B_WIDTH = B_HEADS * B_HEAD_DIM
ROPE_THETA = 10000.0
MOE_GROUPS = 4
MOE_EXPERTS_PER_GROUP = 8
MOE_EXPERTS = MOE_GROUPS * MOE_EXPERTS_PER_GROUP
MOE_TOPK = 2
MOE_HIDDEN = D_MODEL // 4
MOE_BLOCK = 128

kernel_name = "yoco_mlstm_dilated_hmoe_deepnorm_adaln"


def layer_norm(x, g, b):
    xf = x.astype(jnp.float32)
    mu = jnp.mean(xf, axis=-1, keepdims=True)
    var = jnp.mean(jnp.square(xf - mu), axis=-1, keepdims=True)
    return ((xf - mu) * lax.rsqrt(var + LN_EPS) * g.astype(jnp.float32) + b.astype(jnp.float32)).astype(x.dtype)


def rope(x, pos):
    dh = x.shape[-1]
    half = dh // 2
    inv = jnp.power(jnp.float32(ROPE_THETA), -jnp.arange(half, dtype=jnp.float32) * 2.0 / dh)
    ang = pos.astype(jnp.float32)[..., None] * inv
    ang = ang.reshape(ang.shape[:2] + (1,) * (x.ndim - 3) + (half,))
    cos, sin = jnp.cos(ang), jnp.sin(ang)
    xf = x.astype(jnp.float32)
    x1, x2 = xf[..., :half], xf[..., half:]
    return jnp.concatenate([x1 * cos - x2 * sin, x2 * cos + x1 * sin], axis=-1).astype(x.dtype)


def mlstm_chunkwise(q, k, v, i_pre, f_pre):
    bsz, nh, s, dqk = q.shape
    dv = v.shape[-1]
    nc = s // A_CHUNK

    def chunks(t):
        t = t.astype(jnp.float32).reshape((bsz, nh, nc, A_CHUNK) + t.shape[3:])
        return jnp.moveaxis(t, 2, 0)

    qc, kc, vc = chunks(q), chunks(k), chunks(v)
    ic = chunks(i_pre)
    lfc = chunks(jax.nn.log_sigmoid(f_pre.astype(jnp.float32)))
    causal = jnp.tril(jnp.ones((A_CHUNK, A_CHUNK), dtype=bool))

    def step(carry, inp):
        c_st, n_st, m_st = carry
        qq, kk, vv, ii, lf = inp
        b = jnp.cumsum(lf, axis=-1)
        dmat = jnp.where(causal, b[..., :, None] - b[..., None, :] + ii[..., None, :], -jnp.inf)
        inter = b + m_st[..., None]
        m_t = jnp.maximum(inter, jnp.max(dmat, axis=-1))
        dw = jnp.exp(dmat - m_t[..., None])
        iw = jnp.exp(inter - m_t)
        sc = jnp.einsum('bhtd,bhsd->bhts', qq, kk) * dw
        num = jnp.einsum('bhts,bhsv->bhtv', sc, vv) + iw[..., None] * jnp.einsum('bhtd,bhdv->bhtv', qq, c_st)
        den = jnp.sum(sc, axis=-1) + iw * jnp.einsum('bhtd,bhd->bht', qq, n_st)
        h = num / jnp.maximum(jnp.abs(den), jnp.exp(-m_t))[..., None]
        b_last = b[..., -1]
        ws_log = b_last[..., None] - b + ii
        m_new = jnp.maximum(b_last + m_st, jnp.max(ws_log, axis=-1))
        ws = jnp.exp(ws_log - m_new[..., None])
        decay = jnp.exp(b_last + m_st - m_new)
        c_new = decay[..., None, None] * c_st + jnp.einsum('bhs,bhsd,bhsv->bhdv', ws, kk, vv)
        n_new = decay[..., None] * n_st + jnp.einsum('bhs,bhsd->bhd', ws, kk)
        return (c_new, n_new, m_new), h

    init = (jnp.zeros((bsz, nh, dqk, dv), jnp.float32),
            jnp.zeros((bsz, nh, dqk), jnp.float32),
            jnp.zeros((bsz, nh), jnp.float32))
    _, h = lax.scan(step, init, (qc, kc, vc, ic, lfc))
    return jnp.moveaxis(h, 0, 2).reshape(bsz, nh, s, dv)


def mlstm_mixer(h, w_in, b_gate, norm_g, w_out):
    bsz, s, _ = h.shape
    proj = h @ w_in
    o1 = A_HEADS * A_DQK
    o2 = 2 * o1
    o3 = o2 + A_HEADS * A_DV
    o4 = o3 + A_HEADS * A_DV
    q = proj[..., :o1].reshape(bsz, s, A_HEADS, A_DQK)
    k = proj[..., o1:o2].reshape(bsz, s, A_HEADS, A_DQK) * (A_DQK ** -0.5)
    v = proj[..., o2:o3].reshape(bsz, s, A_HEADS, A_DV)
    o_gate = proj[..., o3:o4]
    gates = proj[..., o4:].astype(jnp.float32) + b_gate.astype(jnp.float32)
    i_pre = jnp.transpose(gates[..., :A_HEADS], (0, 2, 1))
    f_pre = jnp.transpose(gates[..., A_HEADS:], (0, 2, 1))
    ht = mlstm_chunkwise(jnp.transpose(q, (0, 2, 1, 3)), jnp.transpose(k, (0, 2, 1, 3)),
                         jnp.transpose(v, (0, 2, 1, 3)), i_pre, f_pre)
    mu = jnp.mean(ht, axis=-1, keepdims=True)
    var = jnp.mean(jnp.square(ht - mu), axis=-1, keepdims=True)
    hn = (ht - mu) * lax.rsqrt(var + A_NORM_EPS)
    hn = jnp.transpose(hn, (0, 2, 1, 3)).reshape(bsz, s, A_HEADS * A_DV) * norm_g.astype(jnp.float32)
    y = (hn * jax.nn.sigmoid(o_gate.astype(jnp.float32))).astype(h.dtype)
    return y @ w_out


def dilated_branch(q, k, v, window, dilation):
    bsz, s, nh, dh = q.shape
    wb = window // dilation
    span = wb * dilation
    p = -(-s // span) * span
    nb = p // span

    def to_blocks(t):
        t = jnp.pad(t, ((0, 0), (0, p - s), (0, 0), (0, 0)))
        t = t.reshape(bsz, p // dilation, dilation, nh, dh).transpose(0, 2, 1, 3, 4)
        return t.reshape(bsz, dilation, nb, wb, nh, dh)

    def with_prev(t):
        prev = jnp.concatenate([jnp.zeros_like(t[:, :, :1]), t[:, :, :-1]], axis=2)
        return jnp.concatenate([prev, t], axis=3)

    qb = to_blocks(q)
    kw = with_prev(to_blocks(k))
    vw = with_prev(to_blocks(v)).astype(jnp.float32)
    sc = jnp.einsum('brnqhe,brnkhe->brnhqk', qb, kw).astype(jnp.float32) * (dh ** -0.5)
    qi = jnp.arange(wb)[:, None]
    kj = jnp.arange(2 * wb)[None, :]
    band = (kj >= qi) & (kj <= qi + wb)
    valid = band[None] & ((jnp.arange(nb)[:, None, None] > 0) | (kj >= wb)[None])
    sc = jnp.where(valid[None, None, :, None], sc, -jnp.inf)
    m = jnp.max(sc, axis=-1, keepdims=True)
    pr = jnp.exp(sc - m)
    l = jnp.sum(pr, axis=-1)
    o = jnp.einsum('brnhqk,brnkhe->brnqhe', pr, vw) / jnp.swapaxes(l, -1, -2)[..., None]
    lse = jnp.swapaxes(m[..., 0] + jnp.log(l), -1, -2)

    def from_blocks(t):
        t = t.reshape((bsz, dilation, p // dilation) + t.shape[4:]).swapaxes(1, 2)
        return t.reshape((bsz, p) + t.shape[3:])[:, :s]

    return from_blocks(o), from_blocks(lse)


def dilated_mixer(h, positions, k_sh, v_sh, w_q, w_o):
    bsz, s, _ = h.shape
    q = rope((h @ w_q).reshape(bsz, s, B_GROUPS, B_HEADS, B_HEAD_DIM), positions)
    outs, lses = [], []
    for g in range(B_GROUPS):
        o_g, l_g = dilated_branch(q[:, :, g], k_sh[:, :, g], v_sh[:, :, g], B_WINDOWS[g], B_DILATIONS[g])
        outs.append(o_g)
        lses.append(l_g)
    wts = jax.nn.softmax(jnp.stack(lses, axis=0), axis=0)
    o = jnp.sum(wts[..., None] * jnp.stack(outs, axis=0), axis=0)
    return o.reshape(bsz, s, B_WIDTH).astype(h.dtype) @ w_o


def hier_moe(h, w_r1, b_r1, w_r2, b_r2, w_gate, w_up, w_down):
    bsz, s, d = h.shape
    t = h.reshape(-1, d)
    n_tok = t.shape[0]
    p1 = jax.nn.softmax((t @ w_r1).astype(jnp.float32) + b_r1.astype(jnp.float32), axis=-1)
    pg, g_idx = lax.top_k(p1, 1)
    lg2 = ((t @ w_r2).astype(jnp.float32) + b_r2.astype(jnp.float32)).reshape(n_tok, MOE_GROUPS, MOE_EXPERTS_PER_GROUP)
    sel = jnp.take_along_axis(lg2, g_idx[:, :, None], axis=1)[:, 0]
    v2, j2 = lax.top_k(sel, MOE_TOPK)
    weight = pg * jax.nn.softmax(v2, axis=-1)
    expert = g_idx * MOE_EXPERTS_PER_GROUP + j2

    n_as = n_tok * MOE_TOPK
    flat_e = expert.reshape(-1)
    flat_w = weight.reshape(-1)
    order = jnp.argsort(flat_e)
    se = flat_e[order]
    tok = order // MOE_TOPK
    counts = jnp.zeros((MOE_EXPERTS,), jnp.int32).at[flat_e].add(1)
    starts = jnp.cumsum(counts) - counts
    pcounts = (counts + MOE_BLOCK - 1) // MOE_BLOCK * MOE_BLOCK
    pends = jnp.cumsum(pcounts)
    pstarts = pends - pcounts
    dest = pstarts[se] + (jnp.arange(n_as, dtype=jnp.int32) - starts[se])
    n_blocks = -(-n_as // MOE_BLOCK) + MOE_EXPERTS
    xbuf = jnp.zeros((n_blocks * MOE_BLOCK, d), t.dtype).at[dest].set(t[tok])
    block_e = jnp.clip(jnp.searchsorted(pends, jnp.arange(n_blocks, dtype=jnp.int32) * MOE_BLOCK, side='right'),
                       0, MOE_EXPERTS - 1)

    def run(args):
        xb, e = args
        return (jax.nn.silu(xb @ w_gate[e]) * (xb @ w_up[e])) @ w_down[e]

    ybuf = lax.map(run, (xbuf.reshape(n_blocks, MOE_BLOCK, d), block_e)).reshape(n_blocks * MOE_BLOCK, d)
    y = ybuf[dest] * flat_w[order][:, None].astype(t.dtype)
    out = jnp.zeros((n_tok, d), t.dtype).at[tok].add(y)
    return out.reshape(bsz, s, d)


def setup_inputs(seed: int = 0) -> dict:
    key = jax.random.key(seed)
    ks = jax.random.split(key, 24)
    f32 = jnp.float32
    d = D_MODEL
    nrm = lambda k, shp: jax.random.normal(k, shp, f32)
    x = nrm(ks[0], (BATCH, SEQ, d))
    c = nrm(ks[1], (BATCH, d))
    offs = jax.random.randint(ks[2], (BATCH, 1), 0, 1024, dtype=jnp.int32)
    positions = (offs + jnp.arange(SEQ, dtype=jnp.int32)[None, :]).astype(jnp.int32)
    ada_w = nrm(ks[3], (DEPTH, d, 6 * d)) * (0.1 * d ** -0.5)
    ada_b = nrm(ks[4], (DEPTH, 6 * d)) * 0.01
    ln_g = 1.0 + 0.02 * nrm(ks[5], (DEPTH, 2, d))
    ln_b = 0.02 * nrm(ks[6], (DEPTH, 2, d))
    a_w_in = nrm(ks[7], (N_A_LAYERS, d, A_PROJ)) * d ** -0.5
    i_bias = 0.1 * nrm(ks[8], (N_A_LAYERS, A_HEADS))
    f_bias = jnp.linspace(3.0, 6.0, A_HEADS, dtype=f32)[None, :] + 0.1 * nrm(ks[9], (N_A_LAYERS, A_HEADS))
    a_b_gate = jnp.concatenate([i_bias, f_bias], axis=-1)
    a_norm_g = 1.0 + 0.02 * nrm(ks[10], (N_A_LAYERS, A_HEADS * A_DV))
    a_w_out = nrm(ks[11], (N_A_LAYERS, A_HEADS * A_DV, d)) * ((A_HEADS * A_DV) ** -0.5 * BETA)
    b_w_kv = nrm(ks[12], (d, 2 * B_GROUPS * B_WIDTH)) * d ** -0.5
    b_w_q = nrm(ks[13], (N_B_LAYERS, d, B_GROUPS * B_WIDTH)) * d ** -0.5
    b_w_o = nrm(ks[14], (N_B_LAYERS, B_WIDTH, d)) * (B_WIDTH ** -0.5 * BETA)
    moe_w_r1 = nrm(ks[15], (DEPTH, d, MOE_GROUPS)) * d ** -0.5
    moe_b_r1 = 0.01 * nrm(ks[16], (DEPTH, MOE_GROUPS))
    moe_w_r2 = nrm(ks[17], (DEPTH, d, MOE_EXPERTS)) * d ** -0.5
    moe_b_r2 = 0.01 * nrm(ks[18], (DEPTH, MOE_EXPERTS))
    moe_w_gate = nrm(ks[19], (DEPTH, MOE_EXPERTS, d, MOE_HIDDEN)) * d ** -0.5
    moe_w_up = nrm(ks[20], (DEPTH, MOE_EXPERTS, d, MOE_HIDDEN)) * d ** -0.5
    moe_w_down = nrm(ks[21], (DEPTH, MOE_EXPERTS, MOE_HIDDEN, d)) * (MOE_HIDDEN ** -0.5 * BETA)
    return {"x": x, "c": c, "positions": positions, "ada_w": ada_w, "ada_b": ada_b,
            "ln_g": ln_g, "ln_b": ln_b, "a_w_in": a_w_in, "a_b_gate": a_b_gate, "a_norm_g": a_norm_g,
            "a_w_out": a_w_out, "b_w_kv": b_w_kv, "b_w_q": b_w_q, "b_w_o": b_w_o,
            "moe_w_r1": moe_w_r1, "moe_b_r1": moe_b_r1, "moe_w_r2": moe_w_r2, "moe_b_r2": moe_b_r2,
            "moe_w_gate": moe_w_gate, "moe_w_up": moe_w_up, "moe_w_down": moe_w_down}


def reference(x, c, positions, ada_w, ada_b, ln_g, ln_b, a_w_in, a_b_gate, a_norm_g, a_w_out,
              b_w_kv, b_w_q, b_w_o, moe_w_r1, moe_b_r1, moe_w_r2, moe_b_r2, moe_w_gate, moe_w_up, moe_w_down):
    bsz, s, d = x.shape
    cond = jax.nn.silu(c)
    k_sh = None
    v_sh = None
    for l in range(DEPTH):
        mod = cond @ ada_w[l] + ada_b[l]
        sh1, sc1, g1, sh2, sc2, g2 = [m[:, None, :] for m in jnp.split(mod, 6, axis=-1)]
        h = x * (1.0 + sc1) + sh1
        if l < N_A_LAYERS:
            y = mlstm_mixer(h, a_w_in[l], a_b_gate[l], a_norm_g[l], a_w_out[l])
        else:
            y = dilated_mixer(h, positions, k_sh, v_sh, b_w_q[l - N_A_LAYERS], b_w_o[l - N_A_LAYERS])
        x = layer_norm(ALPHA * x + (1.0 + g1) * y, ln_g[l, 0], ln_b[l, 0])
        h = x * (1.0 + sc2) + sh2
        y = hier_moe(h, moe_w_r1[l], moe_b_r1[l], moe_w_r2[l], moe_b_r2[l],
                     moe_w_gate[l], moe_w_up[l], moe_w_down[l])
        x = layer_norm(ALPHA * x + (1.0 + g2) * y, ln_g[l, 1], ln_b[l, 1])
        if l == N_A_LAYERS - 1:
            kv = (x @ b_w_kv).reshape(bsz, s, 2, B_GROUPS, B_HEADS, B_HEAD_DIM)
            k_sh = rope(kv[:, :, 0], positions)
            v_sh = kv[:, :, 1]
    return x
```

```cpp
#include <hip/hip_runtime.h>
#include <cstdio>
#include <cstdint>

#ifndef MK_N_LAUNCHES
#define MK_N_LAUNCHES 1
#endif

__device__ __forceinline__ int hw_tid(int wave_s) {
    unsigned z = 0u; asm volatile("" : "+s"(z));
    const unsigned lane = __builtin_amdgcn_mbcnt_hi(~0u, __builtin_amdgcn_mbcnt_lo(~0u, z));
    int t = (int)(((unsigned)wave_s << 6) | lane); asm volatile("" : "+v"(t)); return t;
}
namespace pg8 {
#define PG8_LAS __attribute__((address_space(3)))
typedef unsigned short bf16_t;
typedef short bf16x8 __attribute__((ext_vector_type(8)));
typedef float f32x4 __attribute__((ext_vector_type(4)));
typedef float f32x2 __attribute__((ext_vector_type(2)));
typedef unsigned u32x4 __attribute__((ext_vector_type(4)));
typedef unsigned u32x2 __attribute__((ext_vector_type(2)));
constexpr int BM = 256, BK = 64, HALF = 128, HTB = HALF * BK * 2  , STAGE_BYTES = 8 * HTB, NXCD = 8, WGM = 8;

__host__ __device__ __forceinline__ int lds_byte(int r, int c) { const int st = (r >> 4) * 2 + (c >> 5), rr = r & 15, cc = c & 31, ob = rr * 64 + cc * 2; return st * 1024 + (ob ^ (((ob >> 9) & 1) << 5)); }
__host__ __device__ __forceinline__ void stage_rc(int b, int& R, int& C) { const int st = b / 1024, sb = b % 1024, swz = sb ^ (((sb >> 9) & 1) << 5); R = (st >> 1) * 16 + swz / 64; C = (st & 1) * 32 + (swz % 64) / 2; }
__host__ __device__ __forceinline__ int perm32(int rho) { const int n = rho >> 4, i = rho & 15; return 8 * (i >> 2) + 4 * n + (i & 3); }

struct Unit { int pm, pn, ex, jb; };
struct Gemm { const bf16_t* A; const bf16_t* Bt; int M, N, K; };

struct StaticOrder {
    int nM, nN, nwg, G, c;
    __device__ void init(int M, int N, int G_, int c_) { nM = M / BM; nN = N / BM; nwg = nM * nN; G = G_; c = c_; }
    __device__ bool next(int i, Unit& u) const {
        const long L = (long)i * G + c; if (L >= nwg) return false;
        int wgid = (int)L; { const int q = nwg / NXCD, r = nwg % NXCD, xcd = wgid % NXCD, off = wgid / NXCD; wgid = (xcd < r ? xcd * (q + 1) : r * (q + 1) + (xcd - r) * q) + off; }
        const int nig = WGM * nN, gid = wgid / nig, fm = gid * WGM, gsz = (nM - fm) < WGM ? (nM - fm) : WGM;
        u.pm = fm + ((wgid % nig) % gsz); u.pn = (wgid % nig) / gsz; u.ex = 0; u.jb = 0; return true;
    }
    __device__ __forceinline__ const char* b_ptr(const Gemm& g, const Unit& u) const { return (const char*)g.Bt + (size_t)u.pn * BM * g.K * 2; }
    __device__ __forceinline__ unsigned a_off(const Gemm& g, const Unit& u, int h, int R, int C) const { return (unsigned)((u.pm * BM + h * HALF + R) * g.K + C) * 2u; }
};

struct MoeOrder {
    const PG8_LAS int* tab; const int* list; const bf16_t* W; size_t wstride; int ntn, G, c, gather;
    __device__ bool next(int i, Unit& u) const {
        const int L = i * G + c; const int total = tab[32] * ntn; if (L >= total) return false;
        const int rb = L / ntn; u.pn = L - rb * ntn;
        unsigned z = 0u; asm volatile("" : "+s"(z));
        const unsigned ln = __builtin_amdgcn_mbcnt_hi(~0u, __builtin_amdgcn_mbcnt_lo(~0u, z));
        const unsigned long long m = __ballot(rb >= tab[ln & 31u]);
        const int e = __builtin_popcount((unsigned)m) - 1;
        u.pm = rb; u.ex = e; u.jb = rb - tab[e]; return true;
    }
    __device__ __forceinline__ const char* b_ptr(const Gemm& g, const Unit& u) const { return (const char*)(W + (size_t)u.ex * wstride) + (size_t)u.pn * BM * g.K * 2; }
    __device__ __forceinline__ unsigned a_off(const Gemm& g, const Unit& u, int h, int R, int C) const {
        if (gather) { const int p = u.jb * BM + h * HALF + R; const int cnt = tab[33 + u.ex]; const int tok = list[u.ex * 16384 + (p < cnt ? p : 0)]; return (unsigned)(tok * g.K + C) * 2u; }
        return (unsigned)((u.pm * BM + h * HALF + R) * g.K + C) * 2u;
    }
};

__device__ __forceinline__ unsigned cvt_pk_bf16(float lo, float hi) { unsigned r; asm volatile("v_cvt_pk_bf16_f32 %0, %1, %2" : "=v"(r) : "v"(lo), "v"(hi)); return r; }

struct EpiF32 {
    static constexpr bool PERM = false;
    float* C; int ldc;
    __device__ __forceinline__ void operator()(const f32x4 (&acc)[2][2][4][2], const Unit& u, int wr, int wc, int fr, int fq) const {
        const int row0 = u.pm * BM + wr * 64 + fr, col0 = u.pn * BM + wc * 32 + 4 * fq;
#pragma unroll
        for (int ai = 0; ai < 2; ++ai)
#pragma unroll
            for (int m = 0; m < 4; ++m) { float* rowp = C + (size_t)(row0 + ai * HALF + m * 16) * ldc + col0;
#pragma unroll
                for (int bj = 0; bj < 2; ++bj)
#pragma unroll
                    for (int n = 0; n < 2; ++n) *(f32x4*)(rowp + bj * HALF + n * 16) = acc[ai][bj][m][n]; }
    }
};
struct EpiBf16S {
    static constexpr bool PERM = true;
    bf16_t* O; int ldc; int pn_lo, pn_hi; float scale;
    __device__ __forceinline__ void operator()(const f32x4 (&acc)[2][2][4][2], const Unit& u, int wr, int wc, int fr, int fq) const {
        const int row0 = u.pm * BM + wr * 64 + fr, col0 = u.pn * BM + wc * 32 + 8 * fq;
        const float sc = (u.pn >= pn_lo && u.pn < pn_hi) ? scale : 1.f;
#pragma unroll
        for (int ai = 0; ai < 2; ++ai)
#pragma unroll
            for (int m = 0; m < 4; ++m) { bf16_t* rowp = O + (size_t)(row0 + ai * HALF + m * 16) * ldc + col0;
#pragma unroll
                for (int bj = 0; bj < 2; ++bj) { const f32x4 v0 = acc[ai][bj][m][0] * sc, v1 = acc[ai][bj][m][1] * sc;
                    u32x4 w; w.x = cvt_pk_bf16(v0[0], v0[1]); w.y = cvt_pk_bf16(v0[2], v0[3]); w.z = cvt_pk_bf16(v1[0], v1[1]); w.w = cvt_pk_bf16(v1[2], v1[3]);
                    *(u32x4*)(rowp + bj * HALF) = w; } }
    }
};
struct EpiRope {
    static constexpr bool PERM = true;
    bf16_t* O; int ldc; int rope_tiles; const float* cs; float oscale;
    __device__ __forceinline__ void operator()(const f32x4 (&acc)[2][2][4][2], const Unit& u, int wr, int wc, int fr, int fq) const {
        const int row0 = u.pm * BM + wr * 64 + fr, col0 = u.pn * BM + wc * 32 + 8 * fq;
        const bool rope = u.pn < rope_tiles; const int i0 = 16 * (wc & 1) + 4 * fq;
#pragma unroll
        for (int ai = 0; ai < 2; ++ai)
#pragma unroll
            for (int m = 0; m < 4; ++m) { const int row = row0 + ai * HALF + m * 16; bf16_t* rowp = O + (size_t)row * ldc + col0;
                f32x4 t0 = (f32x4){1.f, 0.f, 1.f, 0.f}, t1 = (f32x4){1.f, 0.f, 1.f, 0.f};
                if (rope) { const f32x4* tp = (const f32x4*)(cs + ((size_t)row * 32 + i0) * 2); t0 = tp[0]; t1 = tp[1]; }
#pragma unroll
                for (int bj = 0; bj < 2; ++bj) { const f32x4 v0 = acc[ai][bj][m][0], v1 = acc[ai][bj][m][1];
                    const float a0 = v0[0] * t0[0] - v0[1] * t0[1], a1 = v0[1] * t0[0] + v0[0] * t0[1], a2 = v0[2] * t0[2] - v0[3] * t0[3], a3 = v0[3] * t0[2] + v0[2] * t0[3];
                    const float b0 = v1[0] * t1[0] - v1[1] * t1[1], b1 = v1[1] * t1[0] + v1[0] * t1[1], b2 = v1[2] * t1[2] - v1[3] * t1[3], b3 = v1[3] * t1[2] + v1[2] * t1[3];
                    u32x4 w; w.x = cvt_pk_bf16(a0 * oscale, a1 * oscale); w.y = cvt_pk_bf16(a2 * oscale, a3 * oscale); w.z = cvt_pk_bf16(b0 * oscale, b1 * oscale); w.w = cvt_pk_bf16(b2 * oscale, b3 * oscale);
                    *(u32x4*)(rowp + bj * HALF) = w; } }
    }
};
struct EpiGU {
    static constexpr bool PERM = true;
    bf16_t* O;
    __device__ __forceinline__ void operator()(const f32x4 (&acc)[2][2][4][2], const Unit& u, int wr, int wc, int fr, int fq) const {
        const int row0 = u.pm * BM + wr * 64 + fr, col0 = u.pn * HALF + wc * 32 + 8 * fq;
#pragma unroll
        for (int ai = 0; ai < 2; ++ai)
#pragma unroll
            for (int m = 0; m < 4; ++m) { bf16_t* rowp = O + (size_t)(row0 + ai * HALF + m * 16) * 256 + col0;
                float r[8];
#pragma unroll
                for (int n = 0; n < 2; ++n)
#pragma unroll
                    for (int j = 0; j < 4; ++j) { const float gt = acc[ai][0][m][n][j], up = acc[ai][1][m][n][j]; r[n * 4 + j] = gt * __builtin_amdgcn_rcpf(1.f + __expf(-gt)) * up; }
                u32x4 w; w.x = cvt_pk_bf16(r[0], r[1]); w.y = cvt_pk_bf16(r[2], r[3]); w.z = cvt_pk_bf16(r[4], r[5]); w.w = cvt_pk_bf16(r[6], r[7]);
                *(u32x4*)rowp = w; }
    }
};

template <class Epi, class Sched, bool ALIGN_EPI>
__device__ __forceinline__ void gemm_phase(PG8_LAS unsigned char* lds, const Gemm g, const Sched& S, const Epi& E, int wave_s) {
    const int tid = hw_tid(wave_s);
    const int wid = __builtin_amdgcn_readfirstlane(tid >> 6), lane = tid & 63, wr = wid >> 2, wc = wid & 3, fr = lane & 15, fq = lane >> 4;
    const int K = g.K, nt = K / BK;
    int sR[2], sC[2]; unsigned voffB[2];
#pragma unroll
    for (int i = 0; i < 2; ++i) { int R, C; stage_rc(tid * 16 + i * 8192, R, C); sR[i] = R; sC[i] = C; const int Rb = Epi::PERM ? ((R & ~31) + perm32(R & 31)) : R; voffB[i] = (unsigned)(Rb * K + C) * 2u; }
    const unsigned kstep = (unsigned)(BK * 2);
    const size_t hstep = (size_t)HALF * K * 2;
    const unsigned ldsw = (unsigned)wid * 1024u;
    const int aoff = lds_byte(wr * 64 + fr, fq * 8), boff = lds_byte(wc * 32 + fr, fq * 8);
    const char* const Ab = (const char*)g.A;
#define PG8_SA(b, h) (((b) * 2 + (h)) * HTB)
#define PG8_SB(b, h) ((4 + (b) * 2 + (h)) * HTB)
#define PG8_STAGEB(bufoff, gbase) do { _Pragma("unroll") for (int _i = 0; _i < 2; ++_i) \
        __builtin_amdgcn_global_load_lds((const unsigned*)((const char*)(gbase) + voffB[_i]), (PG8_LAS unsigned*)(lds + (bufoff) + ldsw + _i * 8192), 16, 0, 0); } while (0)
#define PG8_STAGEA(bufoff, o0, o1) do { \
        __builtin_amdgcn_global_load_lds((const unsigned*)(Ab + (o0)), (PG8_LAS unsigned*)(lds + (bufoff) + ldsw), 16, 0, 0); \
        __builtin_amdgcn_global_load_lds((const unsigned*)(Ab + (o1)), (PG8_LAS unsigned*)(lds + (bufoff) + ldsw + 8192), 16, 0, 0); } while (0)
#define PG8_LDA(dst, b, h) do { _Pragma("unroll") for (int m = 0; m < 4; ++m) _Pragma("unroll") for (int k = 0; k < 2; ++k) dst[m][k] = *(const PG8_LAS bf16x8*)(lds + PG8_SA(b, h) + aoff + m * 2048 + k * 1024); } while (0)
#define PG8_LDB(dst, b, h) do { _Pragma("unroll") for (int n = 0; n < 2; ++n) _Pragma("unroll") for (int k = 0; k < 2; ++k) dst[n][k] = *(const PG8_LAS bf16x8*)(lds + PG8_SB(b, h) + boff + n * 2048 + k * 1024); } while (0)
#define PG8_MMA(ai, bj, At, Bt) do { __builtin_amdgcn_s_setprio(1); _Pragma("unroll") for (int m = 0; m < 4; ++m) _Pragma("unroll") for (int n = 0; n < 2; ++n) _Pragma("unroll") for (int k = 0; k < 2; ++k) \
        acc[ai][bj][m][n] = __builtin_amdgcn_mfma_f32_16x16x32_bf16(Bt[n][k], At[m][k], acc[ai][bj][m][n], 0, 0, 0); __builtin_amdgcn_s_setprio(0); } while (0)
#define PG8_WAIT_V(n) asm volatile("s_waitcnt vmcnt(" #n ")" ::: "memory")
#define PG8_WAIT_L(n) asm volatile("s_waitcnt lgkmcnt(" #n ")" ::: "memory")
#define PG8_BAR __builtin_amdgcn_s_barrier()
#define PG8_SCHED __builtin_amdgcn_sched_barrier(0)
    Unit cur, nxt; int ui = 0;
    if (!S.next(0, cur)) return;
    f32x4 acc[2][2][4][2];
#pragma unroll
    for (int a = 0; a < 2; ++a)
#pragma unroll
        for (int b = 0; b < 2; ++b)
#pragma unroll
            for (int m = 0; m < 4; ++m)
#pragma unroll
                for (int n = 0; n < 2; ++n) acc[a][b][m][n] = (f32x4){0.f, 0.f, 0.f, 0.f};
    bf16x8 At[4][2], B0[2][2], B1[2][2];
    unsigned vA00, vA01, vA10, vA11;
    vA00 = S.a_off(g, cur, 0, sR[0], sC[0]); vA01 = S.a_off(g, cur, 0, sR[1], sC[1]); vA10 = S.a_off(g, cur, 1, sR[0], sC[0]); vA11 = S.a_off(g, cur, 1, sR[1], sC[1]);
    const char* cB = S.b_ptr(g, cur);
    PG8_STAGEB(PG8_SB(0, 0), cB); PG8_STAGEB(PG8_SB(0, 1), cB + hstep); PG8_STAGEA(PG8_SA(0, 0), vA00, vA01); PG8_STAGEA(PG8_SA(0, 1), vA10, vA11);
    if (wr == 1) PG8_BAR;
    PG8_WAIT_V(2); PG8_BAR;
    PG8_STAGEB(PG8_SB(1, 0), cB + kstep); PG8_STAGEA(PG8_SA(1, 0), vA00 + kstep, vA01 + kstep); PG8_STAGEB(PG8_SB(1, 1), cB + hstep + kstep);
    PG8_WAIT_V(6); PG8_BAR;
    for (;;) {
        const bool has_next = S.next(ui + 1, nxt);
        const char* nB = has_next ? S.b_ptr(g, nxt) : cB;
        unsigned nA00 = vA00, nA01 = vA01, nA10 = vA10, nA11 = vA11;
        if (has_next) { nA00 = S.a_off(g, nxt, 0, sR[0], sC[0]); nA01 = S.a_off(g, nxt, 0, sR[1], sC[1]); nA10 = S.a_off(g, nxt, 1, sR[0], sC[0]); nA11 = S.a_off(g, nxt, 1, sR[1], sC[1]); }
#pragma unroll 1
        for (int t = 0; t < nt; t += 2) {
            const bool last = (t == nt - 2);
            const unsigned k1 = (unsigned)(t + 1) * kstep;
            const unsigned k2 = last ? 0u : (unsigned)(t + 2) * kstep, k3 = k2 + kstep;
            const char* b2 = last ? nB : cB + (size_t)(t + 2) * kstep; const char* b3 = b2 + kstep;
            const unsigned s00 = (last ? nA00 : vA00), s01 = (last ? nA01 : vA01), s10 = (last ? nA10 : vA10), s11 = (last ? nA11 : vA11);
            PG8_LDB(B0, 0, 0); PG8_LDB(B1, 0, 1); PG8_SCHED; PG8_LDA(At, 0, 0); PG8_STAGEA(PG8_SA(1, 1), vA10 + k1, vA11 + k1);
            PG8_WAIT_V(8); PG8_WAIT_L(0); PG8_BAR; PG8_MMA(0, 0, At, B0); PG8_MMA(0, 1, At, B1); PG8_BAR; PG8_SCHED;
            PG8_LDA(At, 0, 1); PG8_STAGEB(PG8_SB(0, 0), b2); PG8_STAGEB(PG8_SB(0, 1), b2 + hstep); PG8_STAGEA(PG8_SA(0, 0), s00 + k2, s01 + k2);
            PG8_WAIT_V(8); PG8_WAIT_L(0); PG8_BAR; PG8_MMA(1, 0, At, B0); PG8_MMA(1, 1, At, B1); PG8_BAR; PG8_SCHED;
            PG8_LDB(B0, 1, 0); PG8_LDB(B1, 1, 1); PG8_SCHED; PG8_LDA(At, 1, 0); PG8_STAGEA(PG8_SA(0, 1), s10 + k2, s11 + k2);
            PG8_WAIT_V(8); PG8_WAIT_L(0); PG8_BAR; PG8_MMA(0, 0, At, B0); PG8_MMA(0, 1, At, B1); PG8_BAR; PG8_SCHED;
            PG8_LDA(At, 1, 1); PG8_STAGEB(PG8_SB(1, 0), b3); PG8_STAGEB(PG8_SB(1, 1), b3 + hstep); PG8_STAGEA(PG8_SA(1, 0), s00 + k3, s01 + k3);
            PG8_WAIT_V(8); PG8_WAIT_L(0); PG8_BAR; PG8_MMA(1, 0, At, B0); PG8_MMA(1, 1, At, B1); PG8_BAR; PG8_SCHED;
        }
        if constexpr (ALIGN_EPI) { if (wr == 0) PG8_BAR; }
        E(acc, cur, wr, wc, fr, fq);
        if (!has_next) break;
#pragma unroll
        for (int a = 0; a < 2; ++a)
#pragma unroll
            for (int b = 0; b < 2; ++b)
#pragma unroll
                for (int m = 0; m < 4; ++m)
#pragma unroll
                    for (int n = 0; n < 2; ++n) acc[a][b][m][n] = (f32x4){0.f, 0.f, 0.f, 0.f};
        cur = nxt; cB = nB; vA00 = nA00; vA01 = nA01; vA10 = nA10; vA11 = nA11; ++ui;
        if constexpr (ALIGN_EPI) { if (wr == 1) PG8_BAR; }
    }
    PG8_WAIT_V(0);
    if constexpr (!ALIGN_EPI) { if (wr == 0) PG8_BAR; }
    PG8_BAR;
#undef PG8_SA
#undef PG8_SB
#undef PG8_STAGEA
#undef PG8_STAGEB
#undef PG8_LDA
#undef PG8_LDB
#undef PG8_MMA
#undef PG8_WAIT_V
#undef PG8_WAIT_L
#undef PG8_BAR
#undef PG8_SCHED
}
}

constexpr int NWAVES = 8;
constexpr int BATCH = 2, SEQ = 8192, D = 1024, M = BATCH * SEQ, DEPTH = 4, NA = 2;
constexpr float ALPHA = 1.681792830507429f;
constexpr float LN_EPS = 1e-5f, A_NORM_EPS = 1e-6f;
constexpr int AH = 4, DQK = 128, DV = 256, APROJ = 3080, NPROJ = 3072;
constexpr int CH = 256, NCH = SEQ / CH;
constexpr int BG = 3, BH = 8, HD = 64, BW = 512, NQ = 1536, NKV = 3072;
constexpr int NE = 32, EG = 8, MH = 256;
constexpr int MAXRB = 160;

constexpr size_t MiB = 1u << 20;
constexpr size_t WS_CTL = 0, CTL_ZERO_BYTES = 128 * 1024;
constexpr size_t WS_MOD = 1 * MiB;
constexpr size_t WS_ROPE = 2 * MiB;
constexpr size_t WS_WR = 6 * MiB;
constexpr size_t WS_WG = 6 * MiB + 768 * 1024;
constexpr size_t WS_GATES = 7 * MiB;
constexpr size_t WS_ROUTE = 8 * MiB;
constexpr size_t WS_LIST = 9 * MiB;
constexpr size_t WS_MLS = 11 * MiB;
constexpr size_t WS_WIN = 12 * MiB, WS_WOUT = 24 * MiB, WS_WKV = 28 * MiB, WS_WQ = 34 * MiB, WS_WO = 40 * MiB, WS_WGU = 42 * MiB, WS_WD = 170 * MiB;
constexpr size_t WS_H = 234 * MiB;
constexpr size_t WS_YA = 266 * MiB;
constexpr size_t WS_S0 = 298 * MiB;
constexpr size_t WS_PROJ = WS_S0, WS_DC = WS_S0 + 96 * MiB, WS_CIN = WS_S0 + 128 * MiB;
constexpr size_t WS_Q = WS_S0, WS_OG = WS_S0 + 48 * MiB, WS_LSE = WS_S0 + 96 * MiB, WS_KV = WS_S0 + 112 * MiB;
constexpr size_t WS_YMIX = WS_S0;
constexpr size_t WS_Y = WS_S0, WS_ACT = WS_S0 + 80 * MiB;
constexpr size_t WS_X = WS_S0 + 208 * MiB;
constexpr size_t WS_END = WS_X + 64 * MiB;
constexpr int CW_BAR = 4096;
constexpr int CW_CNT = 16384;

constexpr int RING_BYTES = 131072;
constexpr int LDSCTL_OFF = 145408;
constexpr int LDS_BYTES = 147456;

#define GAS __attribute__((address_space(1)))
#define LAS __attribute__((address_space(3)))
typedef unsigned short bf16;
typedef unsigned v4u __attribute__((ext_vector_type(4)));
typedef unsigned v2u __attribute__((ext_vector_type(2)));
typedef float f32x4 __attribute__((ext_vector_type(4)));
typedef float f32x2 __attribute__((ext_vector_type(2)));
#define RLX_AGENT __ATOMIC_RELAXED, __HIP_MEMORY_SCOPE_AGENT
#ifndef ST_NT
#define ST_NT(p, v) __builtin_nontemporal_store((v), (p))
#endif
__device__ __forceinline__ unsigned f2bf(float f) { unsigned u = __builtin_bit_cast(unsigned, f); return (u + 0x7fffu + ((u >> 16) & 1u)) >> 16; }
typedef __bf16 bf16n2 __attribute__((ext_vector_type(2)));
__device__ __forceinline__ unsigned pk2(float lo, float hi) { bf16n2 v; v.x = (__bf16)lo; v.y = (__bf16)hi; return __builtin_bit_cast(unsigned, v); }
__device__ __forceinline__ float u2f(unsigned w) { return __builtin_bit_cast(float, w); }
__device__ __forceinline__ unsigned f2u(float f) { return __builtin_bit_cast(unsigned, f); }
__device__ __forceinline__ float bflo(unsigned w) { return __builtin_bit_cast(float, w << 16); }
__device__ __forceinline__ float bfhi(unsigned w) { return __builtin_bit_cast(float, w & 0xffff0000u); }
__device__ __forceinline__ float bf2f(bf16 v) { return __builtin_bit_cast(float, (unsigned)v << 16); }
template <int CTRL> __device__ __forceinline__ float dpp_mov(float v) { return __builtin_bit_cast(float, __builtin_amdgcn_update_dpp(0, __builtin_bit_cast(int, v), CTRL, 0xF, 0xF, true)); }
__device__ __forceinline__ float rdlane(float v, int l) { return __builtin_bit_cast(float, __builtin_amdgcn_readlane(__builtin_bit_cast(int, v), l)); }
__device__ __forceinline__ float quad_sum(float v) { v += dpp_mov<0xB1>(v); v += dpp_mov<0x4E>(v); return v; }
__device__ __forceinline__ float quad_max(float v) { v = fmaxf(v, dpp_mov<0xB1>(v)); v = fmaxf(v, dpp_mov<0x4E>(v)); return v; }
__device__ __forceinline__ float row16_sum(float v) { v += dpp_mov<0xB1>(v); v += dpp_mov<0x4E>(v); v += dpp_mov<0x141>(v); v += dpp_mov<0x140>(v); return v; }
__device__ __forceinline__ float row16_max(float v) { v = fmaxf(v, dpp_mov<0xB1>(v)); v = fmaxf(v, dpp_mov<0x4E>(v)); v = fmaxf(v, dpp_mov<0x141>(v)); v = fmaxf(v, dpp_mov<0x140>(v)); return v; }
__device__ __forceinline__ float wave_sum(float v) { v = row16_sum(v); return (rdlane(v, 0) + rdlane(v, 16)) + (rdlane(v, 32) + rdlane(v, 48)); }
__device__ __forceinline__ float wave_max(float v) { v = row16_max(v); return fmaxf(fmaxf(rdlane(v, 0), rdlane(v, 16)), fmaxf(rdlane(v, 32), rdlane(v, 48))); }
#define opaque_tid() hw_tid(F.wave)
__device__ __forceinline__ float sigmoidf_(float x) { return __builtin_amdgcn_rcpf(1.f + __expf(-x)); }
__device__ __forceinline__ float logsigmoidf_(float x) { return fminf(x, 0.f) - __logf(1.f + __expf(-fabsf(x))); }
__device__ __forceinline__ float lane_xor(float v, int m, int lane) { return __builtin_bit_cast(float, __builtin_amdgcn_ds_bpermute((lane ^ m) << 2, __builtin_bit_cast(int, v))); }
__device__ __forceinline__ float lane_up(float v, int o, int lane) { return __builtin_bit_cast(float, __builtin_amdgcn_ds_bpermute(((lane - o) & 63) << 2, __builtin_bit_cast(int, v))); }
__device__ __forceinline__ int lane_up(int v, int o, int lane) { return __builtin_amdgcn_ds_bpermute(((lane - o) & 63) << 2, v); }
__device__ __forceinline__ int lane_get(int v, int src) { return __builtin_amdgcn_ds_bpermute(src << 2, v); }

#define XB_TMO      128
#define XB_XCNT(j)  (256  + 64 * (j))
#define XB_XSUB(j)  (1280 + 64 * (j))
#define XB_XGEN(j)  (2304 + 64 * (j))
#define XB_TOP      3328
#define XB_TOPGEN   3392
#define XCD_BAR_WORDS 3456
#define XB_SPIN_CAP (1u << 18)

__device__ __forceinline__ unsigned xb_ld(unsigned* p)              { return __hip_atomic_load(p, __ATOMIC_RELAXED, __HIP_MEMORY_SCOPE_AGENT); }
__device__ __forceinline__ unsigned xb_add(unsigned* p, unsigned v) { return __hip_atomic_fetch_add(p, v, __ATOMIC_RELAXED, __HIP_MEMORY_SCOPE_AGENT); }
__device__ __forceinline__ unsigned xb_xcc_id() { return (unsigned)__builtin_amdgcn_s_getreg((3 << 11) | 20) & 0xFu; }
#define XB_SPIN(cond, bar) do { unsigned _sp = 0; while (cond) { __builtin_amdgcn_s_sleep(1); \
    if ((++_sp & 255u) == 0u) { if (xb_ld(&(bar)[XB_TMO])) break; if (_sp > XB_SPIN_CAP) { atomicAdd(&(bar)[XB_TMO], 1u); break; } } } } while (0)

struct XcdBarrier {
    unsigned* bar; unsigned x;
    volatile LAS unsigned* st;
    int w;
};
__device__ __forceinline__ XcdBarrier xcd_barrier_post(unsigned* bar, volatile LAS unsigned* st, int wave_s) {
    XcdBarrier b; b.bar = bar; b.x = xb_xcc_id(); b.st = st; b.w = wave_s;
    if (hw_tid(wave_s) == 0) (void)xb_add(&bar[XB_XCNT(b.x)], 1u);
    return b;
}
__device__ __forceinline__ void xcd_barrier_complete(unsigned* bar, unsigned x, unsigned& nloc, unsigned& nx) {
    const unsigned G = gridDim.x * gridDim.y * gridDim.z;
    unsigned sum, cnt, mine, sp = 0u;
    for (;;) {
        sum = 0u; cnt = 0u; mine = 0u;
#pragma unroll
        for (unsigned j = 0; j < 16; ++j) { const unsigned c = xb_ld(&bar[XB_XCNT(j)]); sum += c; cnt += (c > 0u) ? 1u : 0u; mine = (j == x) ? c : mine; }
        if (sum == G) break;
        __builtin_amdgcn_s_sleep(1);
        if ((++sp & 255u) == 0u) { if (xb_ld(&bar[XB_TMO])) break; if (sp > XB_SPIN_CAP) { atomicAdd(&bar[XB_TMO], 1u); break; } }
    }
    nloc = mine > 0u ? mine : 1u; nx = cnt > 0u ? cnt : 1u;
}
__device__ __forceinline__ void xcd_barrier(const XcdBarrier& b) {
    asm volatile("s_waitcnt vmcnt(0)" ::: "memory");
    __syncthreads();
    if (hw_tid(b.w) == 0) {
        unsigned* bar = b.bar;
        __builtin_amdgcn_s_waitcnt(0);
        unsigned nloc = b.st[0], nx = b.st[1];
        if (nloc == 0u) { xcd_barrier_complete(bar, b.x, nloc, nx); b.st[0] = nloc; b.st[1] = nx; }
        const unsigned old = xb_add(&bar[XB_XSUB(b.x)], 1u);
        const unsigned gen = old / nloc;
        if (old + 1u == (gen + 1u) * nloc) {
            __builtin_amdgcn_fence(__ATOMIC_RELEASE, "agent");
            asm volatile("s_waitcnt vmcnt(0)" ::: "memory");
            const unsigned og = xb_add(&bar[XB_TOP], 1u);
            const unsigned tg = og / nx;
            if (og + 1u == (tg + 1u) * nx) xb_add(&bar[XB_TOPGEN], 1u);
            else XB_SPIN(xb_ld(&bar[XB_TOPGEN]) == tg, bar);
            __builtin_amdgcn_fence(__ATOMIC_ACQUIRE, "agent");
            xb_add(&bar[XB_XGEN(b.x)], 1u);
            asm volatile("s_waitcnt vmcnt(0)" ::: "memory");
        } else {
            XB_SPIN(xb_ld(&bar[XB_XGEN(b.x)]) == gen, bar);
            __builtin_amdgcn_fence(__ATOMIC_ACQUIRE, "agent");
            asm volatile("s_waitcnt vmcnt(0)" ::: "memory");
        }
    }
    __syncthreads();
}

struct Frame {
    LAS unsigned char* lds;
    unsigned* ctl;
    unsigned char* ws;
    int tid, lane, wave, G;
    const float *x, *c; const int* pos; const float *ada_w, *ada_b, *ln_g, *ln_b, *a_w_in, *a_b_gate, *a_norm_g, *a_w_out, *b_w_kv, *b_w_q, *b_w_o,
                *w_r1, *b_r1, *w_r2, *b_r2, *w_gate, *w_up, *w_down;
    float* out;
};

__device__ __forceinline__ int rowmap(int mode, int n) {
    if (mode == 1 || (mode == 2 && n < 1536)) { const int e = n & 63; return (n & ~63) + 2 * (e & 31) + (e >> 5); }
    if (mode == 3) return ((n >> 7) << 8) + (n & 127);
    if (mode == 4) return ((n >> 7) << 8) + 128 + (n & 127);
    return n;
}
__device__ __forceinline__ void transpose_load(const float* W, int ldw, int k0, int n0, f32x4 (&t)[8], int lane) {
#pragma unroll
    for (int i = 0; i < 8; ++i) t[i] = *(const f32x4*)(W + (size_t)(k0 + 8 * i + (lane >> 3)) * ldw + n0 + 4 * (lane & 7));
}
__device__ __forceinline__ void transpose_store(const f32x4 (&t)[8], int k0, int n0, bf16* WT, int ldk, int mode, LAS float* scr, int lane) {
#pragma unroll
    for (int i = 0; i < 8; ++i) { LAS float* d = scr + (8 * i + (lane >> 3)) * 33 + 4 * (lane & 7); d[0] = t[i].x; d[1] = t[i].y; d[2] = t[i].z; d[3] = t[i].w; }
    asm volatile("s_waitcnt lgkmcnt(0)" ::: "memory");
    const int c = lane & 7;
#pragma unroll
    for (int j = 0; j < 4; ++j) { const int n = (lane >> 3) + 8 * j; const LAS float* s = scr + (8 * c) * 33 + n;
        v4u o; o.x = pk2(s[0 * 33], s[1 * 33]); o.y = pk2(s[2 * 33], s[3 * 33]); o.z = pk2(s[4 * 33], s[5 * 33]); o.w = pk2(s[6 * 33], s[7 * 33]);
        *(v4u*)(WT + (size_t)rowmap(mode, n0 + n) * ldk + k0 + 8 * c) = o; }
    asm volatile("s_waitcnt lgkmcnt(0)" ::: "memory");
}
struct TItem { const float* W; bf16* WT; int ldw, k0, n0, ldk, mode; };
__device__ __forceinline__ TItem conv_item(Frame& F, int kind, int l, int r) {
    TItem t; t.mode = 0;
    const float* const wg = F.w_gate; const float* const wu = F.w_up;
    if (kind == 0) { t.W = F.a_w_in + (size_t)l * D * APROJ; t.ldw = APROJ; t.k0 = 64 * (r / 96); t.n0 = 32 * (r % 96); t.WT = (bf16*)(F.ws + WS_WIN) + (size_t)l * NPROJ * D; t.ldk = D; }
    else if (kind == 1) { t.W = F.a_w_out + (size_t)l * D * D; t.ldw = D; t.k0 = 64 * (r / 32); t.n0 = 32 * (r % 32); t.WT = (bf16*)(F.ws + WS_WOUT) + (size_t)l * D * D; t.ldk = D; }
    else if (kind == 2) { t.W = F.b_w_kv; t.ldw = NKV; t.k0 = 64 * (r / 96); t.n0 = 32 * (r % 96); t.WT = (bf16*)(F.ws + WS_WKV); t.ldk = D; t.mode = 2; }
    else if (kind == 3) { t.W = F.b_w_q + (size_t)l * D * NQ; t.ldw = NQ; t.k0 = 64 * (r / 48); t.n0 = 32 * (r % 48); t.WT = (bf16*)(F.ws + WS_WQ) + (size_t)l * NQ * D; t.ldk = D; t.mode = 1; }
    else if (kind == 4) { t.W = F.b_w_o + (size_t)l * BW * D; t.ldw = D; t.k0 = 64 * (r / 32); t.n0 = 32 * (r % 32); t.WT = (bf16*)(F.ws + WS_WO) + (size_t)l * D * BW; t.ldk = BW; }
    else { const int sub = r >> 12, q = r & 4095, le = l * NE + (q >> 7), rr = q & 127;
        if (sub < 2) { t.W = (sub == 0 ? wg : wu) + (size_t)le * D * MH; t.ldw = MH; t.k0 = 64 * (rr / 8); t.n0 = 32 * (rr % 8); t.WT = (bf16*)(F.ws + WS_WGU) + (size_t)le * 512 * D; t.ldk = D; t.mode = 3 + sub; }
        else { t.W = F.w_down + (size_t)le * MH * D; t.ldw = D; t.k0 = 64 * (rr / 32); t.n0 = 32 * (rr % 32); t.WT = (bf16*)(F.ws + WS_WD) + (size_t)le * D * MH; t.ldk = MH; } }
    return t;
}
template <int STAGE> __device__ __forceinline__ int stage_count() { return STAGE == 0 ? 1536 + 512 + 12288 : STAGE == 1 ? 1536 + 512 : STAGE == 2 ? 1536 + 768 + 256 : STAGE == 3 ? 768 + 256 : 12288; }
template <int STAGE> __device__ __forceinline__ TItem stage_item(Frame& F, int r, int l) {
    if (STAGE == 0) { if (r < 1536) return conv_item(F, 0, 0, r); r -= 1536; if (r < 512) return conv_item(F, 1, 0, r); return conv_item(F, 5, 0, r - 512); }
    if (STAGE == 1) { if (r < 1536) return conv_item(F, 0, 1, r); return conv_item(F, 1, 1, r - 1536); }
    if (STAGE == 2) { if (r < 1536) return conv_item(F, 2, 0, r); r -= 1536; if (r < 768) return conv_item(F, 3, 0, r); return conv_item(F, 4, 0, r - 768); }
    if (STAGE == 3) { if (r < 768) return conv_item(F, 3, 1, r); return conv_item(F, 4, 1, r - 768); }
    return conv_item(F, 5, l, r);
}
template <int STAGE> __device__ __forceinline__ void conv_run(Frame& F, int l, int gw, int NGW, int lane, int wave) {
    LAS float* scr = (LAS float*)(F.lds + wave * 16384);
    const int NITEMS = stage_count<STAGE>();
    f32x4 cur[8], nxt[8];
    int it = gw;
    if (it < NITEMS) { const TItem t = stage_item<STAGE>(F, it, l); transpose_load(t.W, t.ldw, t.k0, t.n0, cur, lane); }
#pragma unroll 1
    for (; it < NITEMS; it += NGW) {
        const TItem t = stage_item<STAGE>(F, it, l);
        const bool more = it + NGW < NITEMS;
        if (more) { const TItem tn = stage_item<STAGE>(F, it + NGW, l); transpose_load(tn.W, tn.ldw, tn.k0, tn.n0, nxt, lane); }
        transpose_store(cur, t.k0, t.n0, t.WT, t.ldk, t.mode, scr, lane);
        if (more) {
#pragma unroll
            for (int j = 0; j < 8; ++j) cur[j] = nxt[j]; }
    }
}
template <int NF> __device__ __forceinline__ void gemv_run(Frame& F, int l, int j, int n, int tid, int lane, int wave) {
    LAS float* red = (LAS float*)F.lds;
    LAS float* sc = (LAS float*)(F.lds + 8192);
    float* mod = (float*)(F.ws + WS_MOD);
    if (j >= 64) return;
    for (int i = tid; i < 2 * D; i += NWAVES * 64) { const float c = F.c[i]; sc[i] = c / (1.f + expf(-c)); }
    __syncthreads();
    for (int it = j; it < 64; it += n) {
        const int n0 = it * 96;
        const float* Wu = F.ada_w + (size_t)l * D * 6144 + n0; const unsigned lo = 2u * (unsigned)(lane < 48 ? lane : 0);
        float a00 = 0.f, a01 = 0.f, a10 = 0.f, a11 = 0.f;
        const int k0 = wave * 128;
#pragma unroll 1
        for (int kb = k0; kb < k0 + 128; kb += NF) {
            f32x2 w[NF];
#pragma unroll
            for (int k = 0; k < NF; ++k) w[k] = *(const f32x2*)(Wu + (size_t)(kb + k) * 6144 + lo);
#pragma unroll
            for (int k = 0; k < NF; ++k) { const float c0 = sc[kb + k], c1 = sc[D + kb + k]; a00 += c0 * w[k].x; a01 += c0 * w[k].y; a10 += c1 * w[k].x; a11 += c1 * w[k].y; }
        }
        if (lane < 48) { red[(wave * 2 + 0) * 96 + 2 * lane] = a00; red[(wave * 2 + 0) * 96 + 2 * lane + 1] = a01;
                         red[(wave * 2 + 1) * 96 + 2 * lane] = a10; red[(wave * 2 + 1) * 96 + 2 * lane + 1] = a11; }
        __syncthreads();
        if (tid < 192) { const int b = tid / 96, nn = tid % 96; float s = 0.f;
#pragma unroll
            for (int w8 = 0; w8 < 8; ++w8) s += red[(w8 * 2 + b) * 96 + nn];
            mod[(size_t)(l * 2 + b) * 6144 + n0 + nn] = s + F.ada_b[l * 6144 + n0 + nn]; }
        __syncthreads();
    }
}
__device__ __forceinline__ void rope_table(Frame& F, int gt, int NGT) {
    float* cs = (float*)(F.ws + WS_ROPE);
    const float inv = powf(10000.f, -(float)(gt & 31) * 2.0f / 64.0f);
    for (int i = gt; i < M * 32; i += NGT) { const int tok = i >> 5;
        const float ang = (float)F.pos[tok] * inv;
        const double a = (double)ang; const double n = rint(a * 0.15915494309189535); const float r = (float)(a - n * 6.283185307179586);
        *(f32x2*)(cs + 2 * (size_t)i) = (f32x2){cosf(r), sinf(r)}; }
}
template <int STAGE> __device__ __forceinline__ void tail_fill(Frame& F, int l, int total_units, int vcu) {
    const int tid = opaque_tid(), lane = tid & 63, wave = __builtin_amdgcn_readfirstlane(tid >> 6);
    const int maxu = (total_units + F.G - 1) / F.G; int cut = total_units - (maxu - 1) * F.G; if (cut < 0 || F.G - cut < F.G / 2) cut = 0;
    if (vcu >= cut) {
        const int j = vcu - cut, n = F.G - cut;
        if (STAGE == 4) conv_run<STAGE>(F, l, j * NWAVES + wave, n * NWAVES, lane, wave);
        else {
            gemv_run<32>(F, STAGE, j, n, tid, lane, wave);
            const bool split = n >= 128;
            if (!split || j >= 64) { const int jj = split ? j - 64 : j, nn = split ? n - 64 : n;
                conv_run<STAGE>(F, l, jj * NWAVES + wave, nn * NWAVES, lane, wave);
                if (STAGE == 1) rope_table(F, jj * (NWAVES * 64) + tid, nn * (NWAVES * 64)); }
        }
    }
}
__device__ __forceinline__ void pro_a(Frame& F) {
    const int tid = opaque_tid(), lane = tid & 63, wave = __builtin_amdgcn_readfirstlane(tid >> 6);
    gemv_run<32>(F, 0, blockIdx.x, F.G, tid, lane, wave);
    conv_run<0>(F, 0, blockIdx.x * NWAVES + wave, F.G * NWAVES, lane, wave);
    {
        const int gt = blockIdx.x * (NWAVES * 64) + tid, NGT = F.G * NWAVES * 64;
        float* WR = (float*)(F.ws + WS_WR); float* WG = (float*)(F.ws + WS_WG);
        for (int i = gt; i < 4 * 48 * D; i += NGT) { const int l = i / (48 * D), c = (i / D) % 48, k = i % D;
            WR[i] = c < 4 ? F.w_r1[(size_t)(l * D + k) * 4 + c] : (c < 36 ? F.w_r2[(size_t)(l * D + k) * 32 + (c - 4)] : 0.f); }
        for (int i = gt; i < 2 * 8 * D; i += NGT) { const int l = i / (8 * D), j = (i / D) % 8, k = i % D; WG[i] = F.a_w_in[(size_t)(l * D + k) * APROJ + NPROJ + j]; }
    }
}

__device__ __forceinline__ void ln_row(f32x4 (&v)[4], const float* lng, const float* lnb, int lane) {
    float s = 0.f;
#pragma unroll
    for (int j = 0; j < 4; ++j) s += (v[j].x + v[j].y) + (v[j].z + v[j].w);
    const float mean = wave_sum(s) * (1.f / D); float q = 0.f;
#pragma unroll
    for (int j = 0; j < 4; ++j) { v[j] = v[j] - mean; q += (v[j].x * v[j].x + v[j].y * v[j].y) + (v[j].z * v[j].z + v[j].w * v[j].w); }
    const float rstd = 1.f / sqrtf(wave_sum(q) * (1.f / D) + LN_EPS);
#pragma unroll
    for (int j = 0; j < 4; ++j) { const f32x4 g = *(const f32x4*)(lng + 256 * j + 4 * lane), b = *(const f32x4*)(lnb + 256 * j + 4 * lane); v[j] = v[j] * rstd * g + b; }
}
__device__ __forceinline__ void modulate(const f32x4 (&v)[4], f32x4 (&h)[4], const float* sc, const float* sh, int lane) {
#pragma unroll
    for (int j = 0; j < 4; ++j) { const f32x4 s = *(const f32x4*)(sc + 256 * j + 4 * lane), t = *(const f32x4*)(sh + 256 * j + 4 * lane); h[j] = v[j] * (1.f + s) + t; }
}
__device__ __forceinline__ void store_row_bf16(bf16* dst, const f32x4 (&h)[4], int lane) {
#pragma unroll
    for (int j = 0; j < 4; ++j) { v2u o; o.x = pk2(h[j].x, h[j].y); o.y = pk2(h[j].z, h[j].w); ST_NT((v2u*)(dst + 256 * j + 4 * lane), o); }
}
__device__ __forceinline__ void gates_row(const f32x4 (&h)[4], const float* WGl, const float* bg, float* grow, int lane) {
    float p[8];
#pragma unroll
    for (int g = 0; g < 8; ++g) { float s = 0.f;
        if ((g & 1) == 0) asm volatile("" ::: "memory");
#pragma unroll
        for (int j = 0; j < 4; ++j) { const f32x4 w = *(const f32x4*)(WGl + g * D + 256 * j + 4 * lane); s += (h[j].x * w.x + h[j].y * w.y) + (h[j].z * w.z + h[j].w * w.w); }
        p[g] = wave_sum(s) + bg[g]; }
    if (lane == 0) { *(f32x4*)grow = (f32x4){p[0], p[1], p[2], p[3]}; *(f32x4*)(grow + 4) = (f32x4){p[4], p[5], p[6], p[7]}; }
}
template <int NR> __device__ __forceinline__ void gates_rows(const f32x4 (&h)[NR][4], const float* WGl, const float* bg, float* grow0, int lane) {
    float p[NR][8];
#pragma unroll
    for (int g = 0; g < 8; ++g) { f32x4 w[4];
#pragma unroll
        for (int j = 0; j < 4; ++j) w[j] = *(const f32x4*)(WGl + g * D + 256 * j + 4 * lane);
#pragma unroll
        for (int r = 0; r < NR; ++r) { float s = 0.f;
#pragma unroll
            for (int j = 0; j < 4; ++j) s += (h[r][j].x * w[j].x + h[r][j].y * w[j].y) + (h[r][j].z * w[j].z + h[r][j].w * w[j].w);
            p[r][g] = wave_sum(s) + bg[g]; } }
    if (lane == 0) {
#pragma unroll
        for (int r = 0; r < NR; ++r) { *(f32x4*)(grow0 + r * 8) = (f32x4){p[r][0], p[r][1], p[r][2], p[r][3]}; *(f32x4*)(grow0 + r * 8 + 4) = (f32x4){p[r][4], p[r][5], p[r][6], p[r][7]}; } }
}
constexpr int RW = 4;
__device__ __forceinline__ void pro_b(Frame& F) {
    const int tid = opaque_tid(), lane = tid & 63, wave = __builtin_amdgcn_readfirstlane(tid >> 6), gw = blockIdx.x * NWAVES + wave, NGW = F.G * NWAVES; (void)tid;
    const float* mod = (const float*)(F.ws + WS_MOD); bf16* H = (bf16*)(F.ws + WS_H); float* gates = (float*)(F.ws + WS_GATES); const float* WG = (const float*)(F.ws + WS_WG);
    for (int row0 = gw * RW; row0 < M; row0 += NGW * RW) {
        const int b = row0 >> 13; const float* mb = mod + (size_t)(0 * 2 + b) * 6144;
        f32x4 h[RW][4];
#pragma unroll
        for (int r = 0; r < RW; ++r)
#pragma unroll
            for (int j = 0; j < 4; ++j) h[r][j] = *(const f32x4*)(F.x + (size_t)(row0 + r) * D + 256 * j + 4 * lane);
#pragma unroll
        for (int r = 0; r < RW; ++r) { modulate(h[r], h[r], mb + 1024, mb, lane); store_row_bf16(H + (size_t)(row0 + r) * D, h[r], lane); }
        gates_rows<RW>(h, WG, F.a_b_gate, gates + (size_t)row0 * 8, lane);
    }
}
template <bool DRY> __device__ __forceinline__ void phase_r1(Frame& F, int l) {
    const int tid = opaque_tid(), lane = tid & 63, wave = __builtin_amdgcn_readfirstlane(tid >> 6), fr = lane & 15, fq = lane >> 4;
    const float* mod = (const float*)(F.ws + WS_MOD); bf16* H = (bf16*)(F.ws + WS_H); const bf16* ymix = (const bf16*)(F.ws + WS_YMIX);
    const float* WR = (const float*)(F.ws + WS_WR) + (size_t)l * 48 * D;
    unsigned* cnt = F.ctl + CW_CNT + l * 32 * 64;     int* list = (int*)(F.ws + WS_LIST); unsigned* route = (unsigned*)(F.ws + WS_ROUTE);
    float* const xres = (float*)(F.ws + WS_X);
    const float* xin = (l == 0) ? F.x : xres;
    constexpr int HSP = 1028, RB = 2, BR = NWAVES * RB;
    LAS float* HS = (LAS float*)F.lds; LAS float* PS = (LAS float*)(F.lds + 100864); LAS float* LG = (LAS float*)(F.lds + 125440);
    LAS float* VEC = (LAS float*)(F.lds + 67584);
    {
        const float* const m0 = mod + (size_t)(l * 2 + 0) * 6144; const float* const m1 = mod + (size_t)(l * 2 + 1) * 6144;
        const float* const p0 = F.ln_g + (size_t)(l * 2 + 0) * D; const float* const p1 = F.ln_b + (size_t)(l * 2 + 0) * D;
        const float* const p2 = m0 + 2048; const float* const p3 = m0 + 4096; const float* const p4 = m0 + 3072; const float* const p5 = m1 + 2048; const float* const p6 = m1 + 4096; const float* const p7 = m1 + 3072;
        const bool hi = tid >= 256; const int e = (tid & 255) * 4;
        const f32x4 a = *(const f32x4*)((hi ? p1 : p0) + e), b = *(const f32x4*)((hi ? p3 : p2) + e), c = *(const f32x4*)((hi ? p5 : p4) + e), d = *(const f32x4*)((hi ? p7 : p6) + e);
        LAS float* dst = VEC + (hi ? 1024 : 0) + e;
        *(LAS f32x4*)(dst) = a; *(LAS f32x4*)(dst + 2048) = b; *(LAS f32x4*)(dst + 4096) = c; *(LAS f32x4*)(dst + 6144) = d;
        if (tid < 36) VEC[8192 + tid] = tid < 4 ? F.b_r1[l * 4 + tid] : F.b_r2[l * 32 + tid - 4];
    }
    f32x4 b4[8][3];
#pragma unroll
    for (int mi = 0; mi < 8; ++mi)
#pragma unroll
        for (int ct = 0; ct < 3; ++ct) b4[mi][ct] = *(const f32x4*)(WR + (size_t)(16 * ct + fr) * D + 16 * (8 * wave + mi) + 4 * fq);
    int pe = 0, prow0 = -1; unsigned pp0 = 0u, pp1 = 0u; float pw0 = 0.f, pw1 = 0.f;
    auto flush = [&]() { if (prow0 >= 0 && lane < RB) { const int prow = prow0 + lane, pe0 = pe & 255, pe1 = pe >> 8; list[pe0 * 16384 + (int)pp0] = prow; list[pe1 * 16384 + (int)pp1] = prow;
            *(v4u*)(route + (size_t)prow * 8) = (v4u){(unsigned)pe0, pp0, (unsigned)pe1, pp1}; *(v2u*)(route + (size_t)prow * 8 + 4) = (v2u){f2u(pw0), f2u(pw1)}; } prow0 = -1; };
    auto route_rows = [&](int r0) {
        if (lane < RB) {
            const LAS float* lg = LG + (wave * RB + lane) * 40;
            const float l10 = lg[0], l11 = lg[1], l12 = lg[2], l13 = lg[3];
            int gi = 0; float mx = l10;
            if (l11 > mx) { mx = l11; gi = 1; }
            if (l12 > mx) { mx = l12; gi = 2; }
            if (l13 > mx) { mx = l13; gi = 3; }
            const float pg = 1.f / (expf(l10 - mx) + expf(l11 - mx) + expf(l12 - mx) + expf(l13 - mx));
            int j0 = 0; float v0 = lg[4 + gi * 8];
            for (int j = 1; j < 8; ++j) { const float t = lg[4 + gi * 8 + j]; if (t > v0) { v0 = t; j0 = j; } }
            int j1 = -1; float v1 = -3.0e38f;
            for (int j = 0; j < 8; ++j) { const float t = lg[4 + gi * 8 + j]; if (j != j0 && t > v1) { v1 = t; j1 = j; } }
            const float ee = expf(v1 - v0);
            pw0 = pg / (1.f + ee); pw1 = pg * ee / (1.f + ee); const int pe0 = gi * 8 + j0, pe1 = gi * 8 + j1; pe = pe0 | (pe1 << 8);
            pp0 = __hip_atomic_fetch_add(cnt + pe0 * 64, DRY ? 0u : 1u, RLX_AGENT); pp1 = __hip_atomic_fetch_add(cnt + pe1 * 64, DRY ? 0u : 1u, RLX_AGENT);
        }
        prow0 = r0; };
    int lrow0 = -1;
    f32x4 xv[RB][4]; v2u yv[RB][4];
    auto request = [&](int r0) {
#pragma unroll
        for (int r = 0; r < RB; ++r)
#pragma unroll
            for (int j = 0; j < 4; ++j) { xv[r][j] = *(const f32x4*)(xin + (size_t)(r0 + r) * D + 256 * j + 4 * lane); yv[r][j] = *(const v2u*)(ymix + (size_t)(r0 + r) * D + 256 * j + 4 * lane); } };
    int rowb = blockIdx.x * BR;
    if (rowb < M) request(rowb + wave * RB);
    __syncthreads();
    for (; rowb < M; rowb += F.G * BR) {
        const int row0 = rowb + wave * RB; const int b = row0 >> 13;
        const LAS float* vl = VEC + 4 * lane; const LAS float* vg1 = vl + (2 + 3 * b) * 1024;
        f32x4 h[RB][4];
#pragma unroll
        for (int j = 0; j < 4; ++j) { const f32x4 g1 = *(const LAS f32x4*)(vg1 + 256 * j);
#pragma unroll
            for (int r = 0; r < RB; ++r) { const v2u a = yv[r][j]; h[r][j] = xv[r][j] * ALPHA + (1.f + g1) * (f32x4){bflo(a.x), bfhi(a.x), bflo(a.y), bfhi(a.y)}; } }
        { const int nb = rowb + F.G * BR; if (nb < M) request(nb + wave * RB); }
#pragma unroll
        for (int r = 0; r < RB; ++r) { float s = 0.f;
#pragma unroll
            for (int j = 0; j < 4; ++j) s += (h[r][j].x + h[r][j].y) + (h[r][j].z + h[r][j].w);
            const float mean = wave_sum(s) * (1.f / D); float q = 0.f;
#pragma unroll
            for (int j = 0; j < 4; ++j) { h[r][j] = h[r][j] - mean; q += (h[r][j].x * h[r][j].x + h[r][j].y * h[r][j].y) + (h[r][j].z * h[r][j].z + h[r][j].w * h[r][j].w); }
            const float rstd = 1.f / sqrtf(wave_sum(q) * (1.f / D) + LN_EPS);
#pragma unroll
            for (int j = 0; j < 4; ++j) h[r][j] = h[r][j] * rstd * *(const LAS f32x4*)(vl + 256 * j) + *(const LAS f32x4*)(vl + 1024 + 256 * j); }
#pragma unroll
        for (int r = 0; r < RB; ++r) {
#pragma unroll
            for (int j = 0; j < 4; ++j) ST_NT((f32x4*)((DRY ? (float*)(F.ws + WS_END) : xres) + (size_t)(row0 + r) * D + 256 * j + 4 * lane), h[r][j]);
#pragma unroll
            for (int j = 0; j < 4; ++j) h[r][j] = h[r][j] * (1.f + *(const LAS f32x4*)(vg1 + 1024 + 256 * j)) + *(const LAS f32x4*)(vg1 + 2048 + 256 * j);
            store_row_bf16(H + (size_t)(row0 + r) * D, h[r], lane); }
#pragma unroll
        for (int r = 0; r < RB; ++r)
#pragma unroll
            for (int j = 0; j < 4; ++j) *(LAS f32x4*)(HS + (wave * RB + r) * HSP + 256 * j + 4 * lane) = h[r][j];
        __syncthreads();
        flush();
        if (lrow0 >= 0) route_rows(lrow0);
        f32x4 lacc[3];
#pragma unroll
        for (int ct = 0; ct < 3; ++ct) lacc[ct] = (f32x4){0.f, 0.f, 0.f, 0.f};
#pragma unroll
        for (int mi = 0; mi < 8; ++mi) { const f32x4 a0 = *(const LAS f32x4*)(HS + fr * HSP + 16 * (8 * wave + mi) + 4 * fq);
#pragma unroll
            for (int i = 0; i < 4; ++i)
#pragma unroll
                for (int ct = 0; ct < 3; ++ct) lacc[ct] = __builtin_amdgcn_mfma_f32_16x16x4f32(a0[i], b4[mi][ct][i], lacc[ct], 0, 0, 0); }
#pragma unroll
        for (int ct = 0; ct < 3; ++ct) *(LAS f32x4*)(PS + ((wave * 3 + ct) * 64 + lane) * 4) = lacc[ct];
        __syncthreads();
#pragma unroll
        for (int i = 0; i < 2; ++i) { const int idx = tid + 512 * i;
            if (idx < 768) { const int j = idx & 3, ln = (idx >> 2) & 63, ct = idx >> 8; const int off = (ct * 64 + ln) * 4 + j; float v = 0.f;
#pragma unroll
                for (int ks = 0; ks < 8; ++ks) v += PS[off + ks * 768];
                const int rowl = 4 * (ln >> 4) + j, col = 16 * ct + (ln & 15);
                if (col < 36) LG[rowl * 40 + col] = v + VEC[8192 + col]; } }
        lrow0 = row0;
    }
    __syncthreads();
    flush();
    if (lrow0 >= 0) route_rows(lrow0);
    flush();
}
template <int NR> __device__ __forceinline__ void gates_rows_lds(const f32x4 (&h)[NR][4], const LAS float* W, const float* bg, float* grow0, int lane) {
    float p[NR][8];
#pragma unroll
    for (int g = 0; g < 8; ++g) { f32x4 w[4];
#pragma unroll
        for (int j = 0; j < 4; ++j) w[j] = *(const LAS f32x4*)(W + g * D + 256 * j + 4 * lane);
#pragma unroll
        for (int r = 0; r < NR; ++r) { float s = 0.f;
#pragma unroll
            for (int j = 0; j < 4; ++j) s += (h[r][j].x * w[j].x + h[r][j].y * w[j].y) + (h[r][j].z * w[j].z + h[r][j].w * w[j].w);
            p[r][g] = wave_sum(s) + bg[g]; } }
    if (lane == 0) {
#pragma unroll
        for (int r = 0; r < NR; ++r) { *(f32x4*)(grow0 + r * 8) = (f32x4){p[r][0], p[r][1], p[r][2], p[r][3]}; *(f32x4*)(grow0 + r * 8 + 4) = (f32x4){p[r][4], p[r][5], p[r][6], p[r][7]}; } }
}
template <bool DRY> __device__ __forceinline__ void phase_r2(Frame& F, int l) {
    const int tid = opaque_tid(), lane = tid & 63, wave = __builtin_amdgcn_readfirstlane(tid >> 6), gw = blockIdx.x * NWAVES + wave, NGW = F.G * NWAVES;
    const float* mod = (const float*)(F.ws + WS_MOD); bf16* H = (bf16*)(F.ws + WS_H); const bf16* Y = (const bf16*)(F.ws + WS_Y); bf16* XB = (bf16*)(F.ws + WS_YA);
    float* gates = (float*)(F.ws + WS_GATES); const float* WG = (const float*)(F.ws + WS_WG);
    const unsigned* route = (const unsigned*)(F.ws + WS_ROUTE);
    float* const xres = (float*)(F.ws + WS_X); float* const xdst = (l == DEPTH - 1) ? F.out : xres;
    constexpr int RB = 2;
    const bool has_next = l < DEPTH - 1, has_gates = l + 1 < NA;
    LAS float* VEC = (LAS float*)F.lds;
    LAS float* WGS = VEC + 8192;
    {
        const int ln = has_next ? l + 1 : l;
        const float* const m0 = mod + (size_t)(l * 2 + 0) * 6144; const float* const m1 = mod + (size_t)(l * 2 + 1) * 6144;
        const float* const n0 = mod + (size_t)(ln * 2 + 0) * 6144; const float* const n1 = mod + (size_t)(ln * 2 + 1) * 6144;
        const float* const p0 = F.ln_g + (size_t)(l * 2 + 1) * D; const float* const p1 = F.ln_b + (size_t)(l * 2 + 1) * D;
        const float* const p2 = m0 + 5120; const float* const p3 = m1 + 5120; const float* const p4 = n0 + 1024; const float* const p5 = n0; const float* const p6 = n1 + 1024; const float* const p7 = n1;
        const bool hi = tid >= 256; const int e = (tid & 255) * 4;
        const f32x4 a = *(const f32x4*)((hi ? p1 : p0) + e), b = *(const f32x4*)((hi ? p3 : p2) + e), c = *(const f32x4*)((hi ? p5 : p4) + e), d = *(const f32x4*)((hi ? p7 : p6) + e);
        LAS float* dst = VEC + (hi ? 1024 : 0) + e;
        *(LAS f32x4*)(dst) = a; *(LAS f32x4*)(dst + 2048) = b; *(LAS f32x4*)(dst + 4096) = c; *(LAS f32x4*)(dst + 6144) = d;
        if (has_gates) { const float* wn = WG + (size_t)(l + 1) * 8 * D + tid * 4;
#pragma unroll
            for (int k = 0; k < 4; ++k) *(LAS f32x4*)(WGS + tid * 4 + 2048 * k) = *(const f32x4*)(wn + 2048 * k); }
    }
    int excl;
    { const int cn = lane < 32 ? (int)__hip_atomic_load(F.ctl + CW_CNT + (l * 32 + lane) * 64, RLX_AGENT) : 0; const int nb = (cn + 255) >> 8; int inc = nb;
#pragma unroll
      for (int o = 1; o < 32; o <<= 1) { const int t = lane_up(inc, o, lane); if (lane >= o) inc += t; }
      excl = inc - nb; }
    __syncthreads();
    v4u q0 = (v4u){0u, 0u, 0u, 0u}; v2u q1 = (v2u){0u, 0u};
    auto load_route = [&](int rowa) { const size_t rr = (size_t)(rowa + (lane < RB ? lane : 0)) * 8; q0 = *(const v4u*)(route + rr); q1 = *(const v2u*)(route + rr + 4); };
    f32x4 xv[RB][4]; v2u ya[RB][4], yc[RB][4]; float w0[RB], w1[RB];
    auto request = [&](int rowa) {
        const unsigned q0x = q0.x, q0y = q0.y, q0z = q0.z, q0w = q0.w, q1x = q1.x, q1y = q1.y;
#pragma unroll
        for (int r = 0; r < RB; ++r) {
            const int e0 = __builtin_amdgcn_readlane((int)q0x, r), p0 = __builtin_amdgcn_readlane((int)q0y, r), e1 = __builtin_amdgcn_readlane((int)q0z, r), p1 = __builtin_amdgcn_readlane((int)q0w, r);
            w0[r] = u2f((unsigned)__builtin_amdgcn_readlane((int)q1x, r)); w1[r] = u2f((unsigned)__builtin_amdgcn_readlane((int)q1y, r));
            const int s0 = __builtin_amdgcn_readlane(excl, e0) * 256 + p0, s1 = __builtin_amdgcn_readlane(excl, e1) * 256 + p1;
#pragma unroll
            for (int j = 0; j < 4; ++j) { xv[r][j] = *(const f32x4*)(xres + (size_t)(rowa + r) * D + 256 * j + 4 * lane);
                ya[r][j] = *(const v2u*)(Y + (size_t)s0 * D + 256 * j + 4 * lane); yc[r][j] = *(const v2u*)(Y + (size_t)s1 * D + 256 * j + 4 * lane); } } };
    const int step = NGW * RB;
    int row0 = gw * RB;
    if (row0 < M) { load_route(row0); request(row0); if (row0 + step < M) load_route(row0 + step); }
    const float* bg = F.a_b_gate + (has_gates ? (l + 1) * 8 : 0);
    for (; row0 < M; row0 += step) {
        const int b = row0 >> 13; const LAS float* vl = VEC + 4 * lane;
        f32x4 v[RB][4];
#pragma unroll
        for (int j = 0; j < 4; ++j) { const f32x4 g2 = *(const LAS f32x4*)(vl + (2 + b) * 1024 + 256 * j);
#pragma unroll
            for (int r = 0; r < RB; ++r) { const v2u a = ya[r][j], c = yc[r][j];
                const f32x4 y = (f32x4){bflo(a.x), bfhi(a.x), bflo(a.y), bfhi(a.y)} * w0[r] + (f32x4){bflo(c.x), bfhi(c.x), bflo(c.y), bfhi(c.y)} * w1[r];
                v[r][j] = xv[r][j] * ALPHA + (1.f + g2) * y; } }
        if (row0 + step < M) { request(row0 + step); if (row0 + 2 * step < M) load_route(row0 + 2 * step); }
#pragma unroll
        for (int r = 0; r < RB; ++r) { float s = 0.f;
#pragma unroll
            for (int j = 0; j < 4; ++j) s += (v[r][j].x + v[r][j].y) + (v[r][j].z + v[r][j].w);
            const float mean = wave_sum(s) * (1.f / D); float q = 0.f;
#pragma unroll
            for (int j = 0; j < 4; ++j) { v[r][j] = v[r][j] - mean; q += (v[r][j].x * v[r][j].x + v[r][j].y * v[r][j].y) + (v[r][j].z * v[r][j].z + v[r][j].w * v[r][j].w); }
            const float rstd = 1.f / sqrtf(wave_sum(q) * (1.f / D) + LN_EPS);
#pragma unroll
            for (int j = 0; j < 4; ++j) v[r][j] = v[r][j] * rstd * *(const LAS f32x4*)(vl + 256 * j) + *(const LAS f32x4*)(vl + 1024 + 256 * j); }
#pragma unroll
        for (int r = 0; r < RB; ++r) { const int row = row0 + r;
#pragma unroll
            for (int j = 0; j < 4; ++j) ST_NT((f32x4*)((DRY ? (float*)(F.ws + WS_END) : xdst) + (size_t)row * D + 256 * j + 4 * lane), v[r][j]);
            if (l == NA - 1) store_row_bf16(XB + (size_t)row * D, v[r], lane);
            if (has_next) {
#pragma unroll
                for (int j = 0; j < 4; ++j) v[r][j] = v[r][j] * (1.f + *(const LAS f32x4*)(vl + (4 + 2 * b) * 1024 + 256 * j)) + *(const LAS f32x4*)(vl + (5 + 2 * b) * 1024 + 256 * j);
                store_row_bf16(H + (size_t)row * D, v[r], lane);
            } }
        if (has_gates) gates_rows_lds<RB>(v, WGS, bg, gates + (size_t)row0 * 8, lane);
    }
}

typedef short bf16x8 __attribute__((ext_vector_type(8)));
#define MFMA16(a, b, c) __builtin_amdgcn_mfma_f32_16x16x32_bf16((a), (b), (c), 0, 0, 0)
constexpr int RS = 136;
template <bool MAXOP> __device__ __forceinline__ float block_scan256(float v, LAS float* scr, int lane, int wave) {
#pragma unroll
    for (int o = 1; o < 64; o <<= 1) { const float t = lane_up(v, o, lane); if (lane >= o) v = MAXOP ? fmaxf(v, t) : v + t; }
    if (lane == 63 && wave < 4) scr[wave] = v;
    __syncthreads();
    float add = MAXOP ? -3.0e38f : 0.f;
#pragma unroll
    for (int w = 0; w < 3; ++w) if (w < wave) add = MAXOP ? fmaxf(add, scr[w]) : add + scr[w];
    v = MAXOP ? fmaxf(v, add) : v + add;
    __syncthreads();
    return v;
}
__device__ __forceinline__ bf16x8 lds_frag16(const LAS bf16* p) { return __builtin_bit_cast(bf16x8, *(const LAS v4u*)p); }
template <int O0, int O1, int O2, int O3, int O4, int O5, int O6, int O7>
__device__ __forceinline__ void tr_read8(unsigned a, v2u& r0, v2u& r1, v2u& r2, v2u& r3, v2u& r4, v2u& r5, v2u& r6, v2u& r7) {
    asm volatile("ds_read_b64_tr_b16 %0, %8 offset:%9\n\tds_read_b64_tr_b16 %1, %8 offset:%10\n\tds_read_b64_tr_b16 %2, %8 offset:%11\n\tds_read_b64_tr_b16 %3, %8 offset:%12\n\t"
                 "ds_read_b64_tr_b16 %4, %8 offset:%13\n\tds_read_b64_tr_b16 %5, %8 offset:%14\n\tds_read_b64_tr_b16 %6, %8 offset:%15\n\tds_read_b64_tr_b16 %7, %8 offset:%16\n\t"
                 "s_waitcnt lgkmcnt(0)"
                 : "=&v"(r0), "=&v"(r1), "=&v"(r2), "=&v"(r3), "=&v"(r4), "=&v"(r5), "=&v"(r6), "=&v"(r7)
                 : "v"(a), "i"(O0), "i"(O1), "i"(O2), "i"(O3), "i"(O4), "i"(O5), "i"(O6), "i"(O7) : "memory");
}
__device__ __forceinline__ bf16x8 frag_lh(v2u lo, v2u hi) { return __builtin_bit_cast(bf16x8, (v4u){lo.x, lo.y, hi.x, hi.y}); }

__device__ __forceinline__ void ml_a(Frame& F) {
    const int tid = opaque_tid(), lane = tid & 63, wave = __builtin_amdgcn_readfirstlane(tid >> 6), fr = lane & 15, fq = lane >> 4;
    LAS unsigned char* KWb = F.lds;
    LAS unsigned char* VRb = F.lds + 18432;
    constexpr int KPB = 288, VPB = 544;
    const unsigned krd = (unsigned)(__UINTPTR_TYPE__)KWb + (4 * fq + (fr >> 2)) * KPB + (lane & 3) * 8;
    const unsigned vrd = (unsigned)(__UINTPTR_TYPE__)VRb + (4 * fq + (fr >> 2)) * VPB + (lane & 3) * 8 + wave * 64;
    const bf16x8 ones = __builtin_bit_cast(bf16x8, (v4u){0x3f803f80u, 0x3f803f80u, 0x3f803f80u, 0x3f803f80u});
    LAS float* wv = (LAS float*)(F.lds + 55296);
    LAS float* scr = (LAS float*)(F.lds + 56320);
    const bf16* proj = (const bf16*)(F.ws + WS_PROJ); const float* gates = (const float*)(F.ws + WS_GATES);
    float* Bv = (float*)(F.ws + WS_MLS); float* Mloc = Bv + 256; float* dn = (float*)(F.ws + WS_MLS + 65536); float* dC = (float*)(F.ws + WS_DC);
    for (int u = blockIdx.x; u < 256; u += F.G) {
        const int bh = u >> 5, c = u & 31, b = bh >> 2, h = bh & 3, t0 = b * SEQ + c * CH;
        v4u kreg[2], vreg[4];
        auto request = [&](int sb) { const bf16* rows = proj + (size_t)(t0 + sb * 64) * NPROJ;
#pragma unroll
            for (int i = 0; i < 2; ++i) { const int p = tid + 512 * i, s = p >> 4, part = p & 15; kreg[i] = *(const v4u*)(rows + (size_t)s * NPROJ + 512 + h * DQK + part * 8); }
#pragma unroll
            for (int i = 0; i < 4; ++i) { const int p = tid + 512 * i, s = p >> 5, part = p & 31; vreg[i] = *(const v4u*)(rows + (size_t)s * NPROJ + 1024 + h * DV + part * 8); } };
        request(0);
        float ip = 0.f, lf = 0.f;
        if (tid < 256) { ip = gates[(size_t)(t0 + tid) * 8 + h]; lf = logsigmoidf_(gates[(size_t)(t0 + tid) * 8 + 4 + h]); }
        const float bs = block_scan256<false>(lf, scr, lane, wave);
        const float as = tid < 256 ? ip - bs : -3.0e38f;
        const float wm = wave_max(as); if (lane == 0) scr[wave] = wm;
        __syncthreads();
        float mloc = scr[0];
#pragma unroll
        for (int w = 1; w < 8; ++w) mloc = fmaxf(mloc, scr[w]);
        if (tid < 256) wv[tid] = expf(as - mloc);
        if (tid == 255) { Bv[u] = bs; Mloc[u] = mloc; }
        f32x4 acc[2][8];
#pragma unroll
        for (int i = 0; i < 2; ++i)
#pragma unroll
            for (int j = 0; j < 8; ++j) acc[i][j] = (f32x4){0.f, 0.f, 0.f, 0.f};
        f32x4 dn4 = (f32x4){0.f, 0.f, 0.f, 0.f};
#pragma unroll 1
        for (int sb = 0; sb < 4; ++sb) {
            __syncthreads();
#pragma unroll
            for (int i = 0; i < 2; ++i) { const int p = tid + 512 * i, s = p >> 4, part = p & 15; v4u a = kreg[i]; const float w = wv[sb * 64 + s];
                a.x = pk2(bflo(a.x) * w, bfhi(a.x) * w); a.y = pk2(bflo(a.y) * w, bfhi(a.y) * w); a.z = pk2(bflo(a.z) * w, bfhi(a.z) * w); a.w = pk2(bflo(a.w) * w, bfhi(a.w) * w);
                *(LAS v4u*)(KWb + s * KPB + part * 16) = a; }
#pragma unroll
            for (int i = 0; i < 4; ++i) { const int p = tid + 512 * i, s = p >> 5, part = p & 31; *(LAS v4u*)(VRb + s * VPB + part * 16) = vreg[i]; }
            __syncthreads();
            if (sb < 3) request(sb + 1);
            v2u va[8];
            tr_read8<0, 16 * VPB, 32, 16 * VPB + 32, 32 * VPB, 48 * VPB, 32 * VPB + 32, 48 * VPB + 32>(vrd, va[0], va[1], va[2], va[3], va[4], va[5], va[6], va[7]);
#define ML_A_STEP(KS, HF) { v2u kb[8]; constexpr int KO = (KS) * 32 * KPB + (HF) * 128; \
                tr_read8<KO, KO + 16 * KPB, KO + 32, KO + 16 * KPB + 32, KO + 64, KO + 16 * KPB + 64, KO + 96, KO + 16 * KPB + 96>(krd, kb[0], kb[1], kb[2], kb[3], kb[4], kb[5], kb[6], kb[7]); \
                const bf16x8 a0 = frag_lh(va[4 * (KS)], va[4 * (KS) + 1]), a1 = frag_lh(va[4 * (KS) + 2], va[4 * (KS) + 3]); \
                _Pragma("unroll") for (int d4 = 0; d4 < 4; ++d4) { const int dt = 4 * (HF) + d4; const bf16x8 bb = frag_lh(kb[2 * d4], kb[2 * d4 + 1]); \
                    acc[0][dt] = MFMA16(a0, bb, acc[0][dt]); acc[1][dt] = MFMA16(a1, bb, acc[1][dt]); if (dt == wave) dn4 = MFMA16(ones, bb, dn4); } }
            ML_A_STEP(0, 0) ML_A_STEP(0, 1) ML_A_STEP(1, 0) ML_A_STEP(1, 1)
#undef ML_A_STEP
        }
        float* dCu = dC + (size_t)u * 32768;
#pragma unroll
        for (int i = 0; i < 2; ++i) { float* const bp = dCu + (size_t)((32 * wave + 16 * i + 4 * fq) * 128 + fr);
#pragma unroll
            for (int dt = 0; dt < 8; ++dt)
#pragma unroll
                for (int j = 0; j < 4; ++j) bp[j * 128 + 16 * dt] = acc[i][dt][j]; }
        if (fq == 0) dn[u * 128 + 16 * wave + fr] = dn4[0];
        __syncthreads();
    }
}
__device__ __forceinline__ void ml_scan(Frame& F) {
    const int tid = opaque_tid(), lane = tid & 63; (void)lane;
    const float* Bv = (const float*)(F.ws + WS_MLS); const float* Mloc = Bv + 256; float* Min = (float*)(F.ws + WS_MLS) + 512;
    const float* dn = (const float*)(F.ws + WS_MLS + 65536); float* nin = (float*)(F.ws + WS_MLS + 262144);
    const float* dC = (const float*)(F.ws + WS_DC); unsigned* CinT = (unsigned*)(F.ws + WS_CIN);
    LAS float* sB = (LAS float*)F.lds; LAS float* sM = sB + 32; LAS float* f1 = sB + 64; LAS float* f2 = sB + 96; LAS float* ms = sB + 128;
    for (int it0 = blockIdx.x * (NWAVES * 64); it0 < 8 * 16384; it0 += F.G * NWAVES * 64) {
        const int bh = it0 >> 14, e2 = (it0 & 16383) + tid;
        f32x2 d[NCH];
#pragma unroll
        for (int c = 0; c < NCH; ++c) d[c] = *(const f32x2*)(dC + (size_t)(bh * NCH + c) * 32768 + 2 * e2);
        __syncthreads();
        if (tid < NCH) { sB[tid] = Bv[bh * NCH + tid]; sM[tid] = Mloc[bh * NCH + tid]; }
        __syncthreads();
        if (tid == 0) { float m = 0.f;
            for (int c = 0; c < NCH; ++c) { const float ml = sM[c], mm = fmaxf(m, ml); ms[c] = m; f1[c] = expf(m - mm); f2[c] = expf(ml - mm); m = sB[c] + mm; } }
        __syncthreads();
        f32x2 C = (f32x2){0.f, 0.f};
#pragma unroll
        for (int c = 0; c < NCH; ++c) { CinT[(size_t)(bh * NCH + c) * 16384 + e2] = pk2(C.x, C.y); C = C * f1[c] + d[c] * f2[c]; }
        if ((it0 & 16383) == 0) {
            if (tid < 128) { float n = 0.f;
                for (int c = 0; c < NCH; ++c) { nin[(bh * NCH + c) * 128 + tid] = n; n = n * f1[c] + dn[(bh * NCH + c) * 128 + tid] * f2[c]; } }
            if (tid < NCH) Min[bh * NCH + tid] = ms[tid];
        }
    }
}
__device__ __forceinline__ void ml_c(Frame& F, int l) {
    const int tid = opaque_tid(), lane = tid & 63, wave = __builtin_amdgcn_readfirstlane(tid >> 6), fr = lane & 15, fq = lane >> 4;
    LAS bf16* CT = (LAS bf16*)(F.lds);
    LAS bf16* KB = (LAS bf16*)(F.lds + 69632);
    LAS unsigned char* VRb = F.lds + 87040;
    constexpr int VPB = 544;
    LAS float* eav = (LAS float*)(F.lds + 123904);
    LAS float* etv = eav + 256;
    LAS float* iwv = eav + 512;
    LAS float* thv = eav + 768;
    LAS bf16* NB = (LAS bf16*)(F.lds + 128000);
    LAS float* scr = (LAS float*)(F.lds + 128256);
    const bf16* proj = (const bf16*)(F.ws + WS_PROJ); const float* gates = (const float*)(F.ws + WS_GATES);
    const float* Min = (const float*)(F.ws + WS_MLS) + 512; const float* nin = (const float*)(F.ws + WS_MLS + 262144); const bf16* CinT = (const bf16*)(F.ws + WS_CIN);
    bf16* YA = (bf16*)(F.ws + WS_YA);
    const bf16x8 ones = __builtin_bit_cast(bf16x8, (v4u){0x3f803f80u, 0x3f803f80u, 0x3f803f80u, 0x3f803f80u});
    for (int u = blockIdx.x; u < 256; u += F.G) {
        const int bh = u >> 5, c = u & 31, b = bh >> 2, h = bh & 3, t0 = b * SEQ + c * CH;
        v4u cin[8];
        { const bf16* src = CinT + (size_t)u * 32768;
#pragma unroll
          for (int i = 0; i < 8; ++i) { const int p = tid + 512 * i, v = p >> 4, part = p & 15; cin[i] = *(const v4u*)(src + v * 128 + part * 8); } }
        float ip = 0.f, lf = 0.f;
        if (tid < 256) { ip = gates[(size_t)(t0 + tid) * 8 + h]; lf = logsigmoidf_(gates[(size_t)(t0 + tid) * 8 + 4 + h]); }
        const float bs = block_scan256<false>(lf, scr, lane, wave);
        const float as = tid < 256 ? ip - bs : -3.0e38f;
        const float pm = block_scan256<true>(as, scr, lane, wave);
        const float wm = wave_max(as); if (lane == 0) scr[wave] = wm;
        __syncthreads();
        float mloc = scr[0];
#pragma unroll
        for (int w = 1; w < 8; ++w) mloc = fmaxf(mloc, scr[w]);
        const float m_in = Min[u];
        if (tid < 256) { const float mt = bs + fmaxf(m_in, pm); eav[tid] = expf(as - mloc); etv[tid] = expf(bs + mloc - mt); iwv[tid] = expf(bs + m_in - mt); thv[tid] = expf(-mt); }
        if (tid < 64) { const f32x2 n2 = *(const f32x2*)(nin + u * 128 + 2 * tid); ((LAS unsigned*)NB)[tid] = pk2(n2.x, n2.y); }
#pragma unroll
        for (int i = 0; i < 8; ++i) { const int p = tid + 512 * i, v = p >> 4, part = p & 15; *(LAS v4u*)(CT + v * RS + part * 8) = cin[i]; }
        __syncthreads();
#pragma unroll 1
        for (int pass = 0; pass < 2; ++pass) {
            const int tt = pass == 0 ? 15 - wave : wave, nsb = pass == 0 ? 4 : 2;
            const int tmax = 16 * tt + 15, tq = 16 * tt + fr; const size_t row = (size_t)(t0 + tq);
            bf16x8 qf[4];
#pragma unroll
            for (int ks = 0; ks < 4; ++ks) qf[ks] = __builtin_bit_cast(bf16x8, *(const v4u*)(proj + row * NPROJ + h * DQK + 32 * ks + 8 * fq));
            f32x4 acc[17];
#pragma unroll
            for (int vt = 0; vt < 17; ++vt) acc[vt] = (f32x4){0.f, 0.f, 0.f, 0.f};
#pragma unroll
            for (int ks = 0; ks < 4; ++ks) {
#pragma unroll
                for (int vt = 0; vt < 16; ++vt) { acc[vt] = MFMA16(lds_frag16(CT + (16 * vt + fr) * RS + 32 * ks + 8 * fq), qf[ks], acc[vt]);
                    if ((vt & 3) == 3) __builtin_amdgcn_sched_barrier(0); }
                acc[16] = MFMA16(lds_frag16(NB + 32 * ks + 8 * fq), qf[ks], acc[16]);
            }
            { const float iw = iwv[tq];
#pragma unroll
              for (int vt = 0; vt < 17; ++vt) acc[vt] *= iw; }
            const float et = etv[tq];
            v4u kreg[2], vreg[4];
            auto request = [&](int sb) { const bf16* rows = proj + (size_t)(t0 + sb * 64) * NPROJ;
#pragma unroll
                for (int i = 0; i < 2; ++i) { const int p = tid + 512 * i, s = p >> 4, part = p & 15; kreg[i] = *(const v4u*)(rows + (size_t)s * NPROJ + 512 + h * DQK + part * 8); }
#pragma unroll
                for (int i = 0; i < 4; ++i) { const int p = tid + 512 * i, s = p >> 5, part = p & 31; vreg[i] = *(const v4u*)(rows + (size_t)s * NPROJ + 1024 + h * DV + part * 8); } };
            request(0);
#pragma unroll 1
            for (int sb = 0; sb < nsb; ++sb) {
                __syncthreads();
#pragma unroll
                for (int i = 0; i < 2; ++i) { const int p = tid + 512 * i, s = p >> 4, part = p & 15; *(LAS v4u*)(KB + s * RS + part * 8) = kreg[i]; }
#pragma unroll
                for (int i = 0; i < 4; ++i) { const int p = tid + 512 * i, s = p >> 5, part = p & 31; *(LAS v4u*)(VRb + s * VPB + part * 16) = vreg[i]; }
                __syncthreads();
                if (sb + 1 < nsb) request(sb + 1);
#pragma unroll
                for (int sp = 0; sp < 2; ++sp) {
                    const int s0 = sb * 64 + 32 * sp;
                    if (s0 <= tmax) {
                        f32x4 sa = (f32x4){0.f, 0.f, 0.f, 0.f}, sc = (f32x4){0.f, 0.f, 0.f, 0.f};
#pragma unroll
                        for (int ks = 0; ks < 4; ++ks) { sa = MFMA16(lds_frag16(KB + (32 * sp + fr) * RS + 32 * ks + 8 * fq), qf[ks], sa);
                                                         sc = MFMA16(lds_frag16(KB + (32 * sp + 16 + fr) * RS + 32 * ks + 8 * fq), qf[ks], sc); }
                        float p[8];
#pragma unroll
                        for (int j = 0; j < 4; ++j) { const int sA = s0 + 4 * fq + j, sB = sA + 16;
                            p[j] = sA <= tq ? sa[j] * eav[sA] * et : 0.f; p[4 + j] = sB <= tq ? sc[j] * eav[sB] * et : 0.f; }
                        const bf16x8 pf = __builtin_bit_cast(bf16x8, (v4u){pk2(p[0], p[1]), pk2(p[2], p[3]), pk2(p[4], p[5]), pk2(p[6], p[7])});
                        const unsigned va = (unsigned)(__UINTPTR_TYPE__)VRb + (32 * sp + 4 * fq + (fr >> 2)) * VPB + (lane & 3) * 8;
#define ML_C_PV4(G) { v2u l0, h0, l1, h1, l2, h2, l3, h3; constexpr int VO = 128 * (G); \
                        tr_read8<VO, VO + 16 * VPB, VO + 32, VO + 16 * VPB + 32, VO + 64, VO + 16 * VPB + 64, VO + 96, VO + 16 * VPB + 96>(va, l0, h0, l1, h1, l2, h2, l3, h3); \
                        acc[4 * (G)] = MFMA16(frag_lh(l0, h0), pf, acc[4 * (G)]); acc[4 * (G) + 1] = MFMA16(frag_lh(l1, h1), pf, acc[4 * (G) + 1]); \
                        acc[4 * (G) + 2] = MFMA16(frag_lh(l2, h2), pf, acc[4 * (G) + 2]); acc[4 * (G) + 3] = MFMA16(frag_lh(l3, h3), pf, acc[4 * (G) + 3]); __builtin_amdgcn_sched_barrier(0); }
                        ML_C_PV4(0) ML_C_PV4(1) ML_C_PV4(2) ML_C_PV4(3)
#undef ML_C_PV4
                        acc[16] = MFMA16(ones, pf, acc[16]);
                    }
                }
            }
            v2u ogr[16];
#pragma unroll
            for (int vt = 0; vt < 16; ++vt) ogr[vt] = *(const v2u*)(proj + row * NPROJ + 2048 + h * DV + 4 * fq + 16 * vt);
            const float dnm = 1.f / fmaxf(fabsf(acc[16][0]), thv[tq]);
            float s1 = 0.f;
#pragma unroll
            for (int vt = 0; vt < 16; ++vt) { acc[vt] *= dnm; s1 += (acc[vt][0] + acc[vt][1]) + (acc[vt][2] + acc[vt][3]); }
            s1 += lane_xor(s1, 16, lane); s1 += lane_xor(s1, 32, lane);
            const float mean = s1 * (1.f / DV); float s2 = 0.f;
#pragma unroll
            for (int vt = 0; vt < 16; ++vt) { acc[vt] -= mean; s2 += (acc[vt][0] * acc[vt][0] + acc[vt][1] * acc[vt][1]) + (acc[vt][2] * acc[vt][2] + acc[vt][3] * acc[vt][3]); }
            s2 += lane_xor(s2, 16, lane); s2 += lane_xor(s2, 32, lane);
            const float rstd = 1.f / sqrtf(s2 * (1.f / DV) + A_NORM_EPS);
            const float* ng = F.a_norm_g + l * 1024 + h * DV + 4 * fq; bf16* yp = YA + row * D + h * DV + 4 * fq;
#pragma unroll
            for (int vt = 0; vt < 16; ++vt) { const v2u og = ogr[vt]; const f32x4 g = *(const f32x4*)(ng + 16 * vt);
                const float y0 = acc[vt][0] * rstd * g.x * sigmoidf_(bflo(og.x)), y1 = acc[vt][1] * rstd * g.y * sigmoidf_(bfhi(og.x)),
                            y2 = acc[vt][2] * rstd * g.z * sigmoidf_(bflo(og.y)), y3 = acc[vt][3] * rstd * g.w * sigmoidf_(bfhi(og.y));
                *(v2u*)(yp + 16 * vt) = (v2u){pk2(y0, y1), pk2(y2, y3)}; }
        }
        __syncthreads();
    }
}

__device__ __forceinline__ void att_mfma(Frame& F) {
    const int tid = opaque_tid(), lane = tid & 63, wave = __builtin_amdgcn_readfirstlane(tid >> 6), fr = lane & 15, fq = lane >> 4;
    constexpr int NK = 384, KP = 72, VPB = 160;
    LAS bf16* Ks = (LAS bf16*)(F.lds); LAS unsigned char* Vs = F.lds + NK * KP * 2;
    const bf16* Q = (const bf16*)(F.ws + WS_Q); const bf16* KV = (const bf16*)(F.ws + WS_KV);
    bf16* OG = (bf16*)(F.ws + WS_OG); float* LSE = (float*)(F.ws + WS_LSE);
    const bf16x8 ones = __builtin_bit_cast(bf16x8, (v4u){0x3f803f80u, 0x3f803f80u, 0x3f803f80u, 0x3f803f80u});
    constexpr int NU = 1536;
    const unsigned vrd = (unsigned)(__UINTPTR_TYPE__)Vs + (4 * fq + (fr >> 2)) * VPB + (lane & 3) * 8;
    auto decode = [&](int u, int& g, int& b, int& h, int& r, int& rho, int& n2) { g = u >> 9; const int rem = u & 511; b = rem >> 8; h = (rem >> 5) & 7; const int rn = rem & 31;
        r = g == 0 ? 1 : (g == 1 ? 4 : 16); const int nb2 = 32 / r; rho = rn / nb2; n2 = rn % nb2; };
    v4u kreg[6], vreg[6]; bf16x8 qf[2][2];
    auto request = [&](int u) { int g, b, h, r, rho, n2; decode(u, g, b, h, r, rho, n2);
        const bf16* kvb = KV + (size_t)b * SEQ * NKV + g * 512 + h * 64;
#pragma unroll
        for (int i = 0; i < 6; ++i) { const int p = tid + 512 * i, kj = p >> 3, part = p & 7; const int isub = (2 * n2 - 1) * 128 + kj;
            kreg[i] = (v4u){0u, 0u, 0u, 0u}; vreg[i] = (v4u){0u, 0u, 0u, 0u};
            if (isub >= 0) { const bf16* kr = kvb + ((size_t)isub * r + rho) * NKV + part * 8; kreg[i] = *(const v4u*)kr; vreg[i] = *(const v4u*)(kr + 1536); } }
#pragma unroll
        for (int i = 0; i < 2; ++i) { const size_t tq = (size_t)b * SEQ + (size_t)(n2 * 256 + 16 * (wave + 8 * i) + fr) * r + rho;
#pragma unroll
            for (int ks = 0; ks < 2; ++ks) qf[i][ks] = __builtin_bit_cast(bf16x8, *(const v4u*)(Q + tq * NQ + g * 512 + h * 64 + 32 * ks + 8 * fq)); } };
    const int ustep = (F.G % 8 == 0) ? F.G / 8 : F.G; const int ubase = (F.G % 8 == 0) ? (int)(blockIdx.x % 8) * (NU / 8) : 0, uend = (F.G % 8 == 0) ? ubase + NU / 8 : NU;
    int u = ubase + ((F.G % 8 == 0) ? (int)(blockIdx.x / 8) : (int)blockIdx.x);
    if (u < uend) request(u);
    for (; u < uend; u += ustep) {
        int g, b, h, r, rho, n2; decode(u, g, b, h, r, rho, n2);
        __syncthreads();
#pragma unroll
        for (int i = 0; i < 6; ++i) { const int p = tid + 512 * i, kj = p >> 3, part = p & 7; *(LAS v4u*)(Ks + kj * KP + part * 8) = kreg[i]; *(LAS v4u*)(Vs + kj * VPB + part * 16) = vreg[i]; }
        bf16x8 q[2][2];
#pragma unroll
        for (int i = 0; i < 2; ++i) { q[i][0] = qf[i][0]; q[i][1] = qf[i][1]; }
        __syncthreads();
        if (u + ustep < uend) request(u + ustep);
#pragma unroll
        for (int i = 0; i < 2; ++i) {
            const int tt = wave + 8 * i, qi = 16 * tt + fr;
            const size_t tokq = (size_t)b * SEQ + (size_t)(n2 * 256 + qi) * r + rho;
            const int pi0 = tt >> 1;
            f32x4 sc[5][2];
#pragma unroll
            for (int pi = 0; pi < 5; ++pi)
#pragma unroll
                for (int st = 0; st < 2; ++st) { const int tile = 2 * (pi0 + pi) + st; f32x4 a = (f32x4){0.f, 0.f, 0.f, 0.f};
                    a = MFMA16(lds_frag16(Ks + (16 * tile + fr) * KP + 8 * fq), q[i][0], a); a = MFMA16(lds_frag16(Ks + (16 * tile + fr) * KP + 32 + 8 * fq), q[i][1], a);
                    sc[pi][st] = a; }
            const float NEG = -__builtin_inff();
#pragma unroll
            for (int st = 0; st < 2; ++st)
#pragma unroll
                for (int j = 0; j < 4; ++j) { const int k0 = 32 * pi0 + 16 * st + 4 * fq + j; sc[0][st][j] = k0 >= qi ? sc[0][st][j] : NEG; sc[4][st][j] = k0 + 128 <= qi + 128 ? sc[4][st][j] : NEG; }
            if (n2 == 0) {
#pragma unroll
                for (int pi = 0; pi < 5; ++pi)
#pragma unroll
                    for (int st = 0; st < 2; ++st)
#pragma unroll
                        for (int j = 0; j < 4; ++j) { const int kj = 32 * (pi0 + pi) + 16 * st + 4 * fq + j; sc[pi][st][j] = kj >= 128 ? sc[pi][st][j] : NEG; }
            }
            float mx = NEG;
#pragma unroll
            for (int pi = 0; pi < 5; ++pi)
#pragma unroll
                for (int st = 0; st < 2; ++st)
#pragma unroll
                    for (int j = 0; j < 4; ++j) mx = fmaxf(mx, sc[pi][st][j]);
            mx = fmaxf(mx, lane_xor(mx, 16, lane)); mx = fmaxf(mx, lane_xor(mx, 32, lane));
            f32x4 acc[4], den = (f32x4){0.f, 0.f, 0.f, 0.f};
#pragma unroll
            for (int vt = 0; vt < 4; ++vt) acc[vt] = (f32x4){0.f, 0.f, 0.f, 0.f};
#pragma unroll
            for (int pi = 0; pi < 5; ++pi) { float p[8];
#pragma unroll
                for (int j = 0; j < 4; ++j) { p[j] = __builtin_amdgcn_exp2f(sc[pi][0][j] - mx); p[4 + j] = __builtin_amdgcn_exp2f(sc[pi][1][j] - mx); }
                const bf16x8 pf = __builtin_bit_cast(bf16x8, (v4u){pk2(p[0], p[1]), pk2(p[2], p[3]), pk2(p[4], p[5]), pk2(p[6], p[7])});
                { v2u l0, h0, l1, h1, l2, h2, l3, h3;
                  tr_read8<0, 16 * VPB, 32, 16 * VPB + 32, 64, 16 * VPB + 64, 96, 16 * VPB + 96>(vrd + 32 * (pi0 + pi) * VPB, l0, h0, l1, h1, l2, h2, l3, h3);
                  acc[0] = MFMA16(frag_lh(l0, h0), pf, acc[0]); acc[1] = MFMA16(frag_lh(l1, h1), pf, acc[1]); acc[2] = MFMA16(frag_lh(l2, h2), pf, acc[2]); acc[3] = MFMA16(frag_lh(l3, h3), pf, acc[3]); }
                den = MFMA16(ones, pf, den); }
            const float lsum = den[0], inv = 1.f / lsum;
            bf16* op = OG + ((size_t)g * M + tokq) * BW + h * 64 + 4 * fq;
#pragma unroll
            for (int vt = 0; vt < 4; ++vt) *(v2u*)(op + 16 * vt) = (v2u){pk2(acc[vt][0] * inv, acc[vt][1] * inv), pk2(acc[vt][2] * inv, acc[vt][3] * inv)};
            if (fq == 0) LSE[((size_t)g * M + tokq) * 8 + h] = (mx + __builtin_amdgcn_logf(lsum)) * 0.6931471805599453f;
        }
    }
}
__device__ __forceinline__ void att_combine(Frame& F) {
    const int gt = blockIdx.x * (NWAVES * 64) + opaque_tid(), NGT = F.G * NWAVES * 64;
    const bf16* OG = (const bf16*)(F.ws + WS_OG); const float* LSE = (const float*)(F.ws + WS_LSE); bf16* YA = (bf16*)(F.ws + WS_YA);
    for (int it = gt; it < M * 64; it += NGT) {
        const int tok = it >> 6, h = (it >> 3) & 7, pc = it & 7;
        const float l0 = LSE[(size_t)tok * 8 + h], l1 = LSE[((size_t)M + tok) * 8 + h], l2 = LSE[((size_t)2 * M + tok) * 8 + h];
        const float mx = fmaxf(l0, fmaxf(l1, l2)); float w0 = expf(l0 - mx), w1 = expf(l1 - mx), w2 = expf(l2 - mx); const float inv = 1.f / (w0 + w1 + w2); w0 *= inv; w1 *= inv; w2 *= inv;
        const size_t off = (size_t)tok * BW + h * 64 + pc * 8;
        const v4u a = *(const v4u*)(OG + off), c = *(const v4u*)(OG + (size_t)M * BW + off), d = *(const v4u*)(OG + (size_t)2 * M * BW + off);
        v4u o;
        o.x = pk2(w0 * bflo(a.x) + w1 * bflo(c.x) + w2 * bflo(d.x), w0 * bfhi(a.x) + w1 * bfhi(c.x) + w2 * bfhi(d.x));
        o.y = pk2(w0 * bflo(a.y) + w1 * bflo(c.y) + w2 * bflo(d.y), w0 * bfhi(a.y) + w1 * bfhi(c.y) + w2 * bfhi(d.y));
        o.z = pk2(w0 * bflo(a.z) + w1 * bflo(c.z) + w2 * bflo(d.z), w0 * bfhi(a.z) + w1 * bfhi(c.z) + w2 * bfhi(d.z));
        o.w = pk2(w0 * bflo(a.w) + w1 * bflo(c.w) + w2 * bflo(d.w), w0 * bfhi(a.w) + w1 * bfhi(c.w) + w2 * bfhi(d.w));
        __builtin_nontemporal_store(o, (v4u*)(YA + off));
    }
}

constexpr int NPHASE = 2 + 9 * DEPTH;
struct Args { const void* in[21]; float* out; unsigned char* ws; int ph_lo, ph_hi; };
__device__ __forceinline__ void moe_table(Frame& F, int l) {
    LAS int* tab = (LAS int*)(F.lds + LDSCTL_OFF + 64);
    const int tid = opaque_tid();
    if (tid < 64) { const int lane = tid & 63; const int cn = lane < 32 ? (int)__hip_atomic_load(F.ctl + CW_CNT + (l * 32 + lane) * 64, RLX_AGENT) : 0; const int nb = (cn + 255) >> 8; int inc = nb;
#pragma unroll
        for (int o = 1; o < 32; o <<= 1) { const int t = lane_up(inc, o, lane); if (lane >= o) inc += t; }
        if (lane < 32) { tab[lane] = inc - nb; tab[33 + lane] = cn; } if (lane == 31) tab[32] = inc; }
    __syncthreads();
}
__global__ void __launch_bounds__(NWAVES * 64, 2) fwd(Args args) {
    extern __shared__ __attribute__((aligned(16))) unsigned char lds[];
    Frame F;
    F.lds = (LAS unsigned char*)lds; F.ws = args.ws; F.ctl = (unsigned*)(args.ws + WS_CTL);
    F.wave = __builtin_amdgcn_readfirstlane((int)threadIdx.x >> 6); asm volatile("" : "+s"(F.wave)); F.tid = hw_tid(F.wave); F.lane = F.tid & 63; F.G = gridDim.x;
    F.x = (const float*)args.in[0]; F.c = (const float*)args.in[1]; F.pos = (const int*)args.in[2]; F.ada_w = (const float*)args.in[3]; F.ada_b = (const float*)args.in[4];
    F.ln_g = (const float*)args.in[5]; F.ln_b = (const float*)args.in[6]; F.a_w_in = (const float*)args.in[7]; F.a_b_gate = (const float*)args.in[8]; F.a_norm_g = (const float*)args.in[9];
    F.a_w_out = (const float*)args.in[10]; F.b_w_kv = (const float*)args.in[11]; F.b_w_q = (const float*)args.in[12]; F.b_w_o = (const float*)args.in[13];
    F.w_r1 = (const float*)args.in[14]; F.b_r1 = (const float*)args.in[15]; F.w_r2 = (const float*)args.in[16]; F.b_r2 = (const float*)args.in[17];
    F.w_gate = (const float*)args.in[18]; F.w_up = (const float*)args.in[19]; F.w_down = (const float*)args.in[20]; F.out = args.out;
    for (int u = F.tid; u < (LDS_BYTES - LDSCTL_OFF) / 4; u += NWAVES * 64) ((LAS unsigned*)(F.lds + LDSCTL_OFF))[u] = 0u;
    __syncthreads();
    const int lo = args.ph_lo, hi = args.ph_hi;
    XcdBarrier bar; bar.bar = F.ctl + CW_BAR; bar.x = 0; bar.st = nullptr; bar.w = F.wave;
    if (hi - lo > 1) bar = xcd_barrier_post(F.ctl + CW_BAR, (volatile LAS unsigned*)(F.lds + LDSCTL_OFF), F.wave);
#define IN(k) (lo <= (k) && (k) < hi)
#define SEAM(k) do { if ((k) + 1 < hi) xcd_barrier(bar); } while (0)
    const int c0 = (int)blockIdx.x;
    const int vcu = (F.G % 8 == 0) ? (int)(blockIdx.x % 8) * (F.G / 8) + (int)(blockIdx.x / 8) : (int)blockIdx.x;

    if (IN(0)) { pro_a(F); SEAM(0); }
    if (IN(1)) { pro_b(F); SEAM(1); }
    for (int l = 0; l < DEPTH; ++l) {
        const int pb = 2 + 9 * l;
        if (l < NA) {
            if (IN(pb + 0)) {
                pg8::Gemm g{(const bf16*)(F.ws + WS_H), (const bf16*)(F.ws + WS_WIN) + (size_t)l * NPROJ * D, M, NPROJ, D}; pg8::StaticOrder S; S.init(M, NPROJ, F.G, c0);
                pg8::EpiBf16S E{(bf16*)(F.ws + WS_PROJ), NPROJ, 2, 4, 0.08838834764831845f};
                pg8::gemm_phase<pg8::EpiBf16S, pg8::StaticOrder, true>(F.lds, g, S, E, F.wave);
                SEAM(pb + 0);
            }
            if (IN(pb + 1)) { ml_a(F); SEAM(pb + 1); }
            if (IN(pb + 2)) { ml_scan(F); SEAM(pb + 2); }
            if (IN(pb + 3)) { ml_c(F, l); SEAM(pb + 3); }
            if (IN(pb + 4)) {
                pg8::Gemm g{(const bf16*)(F.ws + WS_YA), (const bf16*)(F.ws + WS_WOUT) + (size_t)l * D * D, M, D, D}; pg8::StaticOrder S; S.init(M, D, F.G, c0);
                pg8::EpiBf16S E{(bf16*)(F.ws + WS_YMIX), D, 0, 0, 1.f};
                pg8::gemm_phase<pg8::EpiBf16S, pg8::StaticOrder, false>(F.lds, g, S, E, F.wave);
                SEAM(pb + 4);
            }
        } else {
            if (IN(pb + 0)) {
                if (l == NA) {
                    pg8::Gemm g{(const bf16*)(F.ws + WS_YA), (const bf16*)(F.ws + WS_WKV), M, NKV, D}; pg8::StaticOrder S; S.init(M, NKV, F.G, c0);
                    pg8::EpiRope E{(bf16*)(F.ws + WS_KV), NKV, 6, (const float*)(F.ws + WS_ROPE), 1.0f};
                    pg8::gemm_phase<pg8::EpiRope, pg8::StaticOrder, true>(F.lds, g, S, E, F.wave);
                }
                {
                    pg8::Gemm g{(const bf16*)(F.ws + WS_H), (const bf16*)(F.ws + WS_WQ) + (size_t)(l - NA) * NQ * D, M, NQ, D}; pg8::StaticOrder S; S.init(M, NQ, F.G, c0);
                    pg8::EpiRope E{(bf16*)(F.ws + WS_Q), NQ, 6, (const float*)(F.ws + WS_ROPE), 0.125f * 1.4426950408889634f};
                    pg8::gemm_phase<pg8::EpiRope, pg8::StaticOrder, true>(F.lds, g, S, E, F.wave);
                }
                SEAM(pb + 0);
            }
            if (IN(pb + 1)) { att_mfma(F); SEAM(pb + 1); }
            if (IN(pb + 2)) { att_combine(F); SEAM(pb + 2); }
            if (IN(pb + 4)) {
                pg8::Gemm g{(const bf16*)(F.ws + WS_YA), (const bf16*)(F.ws + WS_WO) + (size_t)(l - NA) * D * BW, M, D, BW}; pg8::StaticOrder S; S.init(M, D, F.G, c0);
                pg8::EpiBf16S E{(bf16*)(F.ws + WS_YMIX), D, 0, 0, 1.f};
                pg8::gemm_phase<pg8::EpiBf16S, pg8::StaticOrder, false>(F.lds, g, S, E, F.wave);
                SEAM(pb + 4);
            }
        }
        if (IN(pb + 5)) { phase_r1<false>(F, l); SEAM(pb + 5); }
        if (IN(pb + 6)) {
            moe_table(F, l);
            pg8::Gemm g{(const bf16*)(F.ws + WS_H), nullptr, 0, 512, D};
            pg8::MoeOrder S{(const LAS int*)(F.lds + LDSCTL_OFF + 64), (const int*)(F.ws + WS_LIST), (const bf16*)(F.ws + WS_WGU) + (size_t)l * NE * 512 * D, (size_t)512 * D, 2, F.G, vcu, 1};
            pg8::EpiGU E{(bf16*)(F.ws + WS_ACT)};
            pg8::gemm_phase<pg8::EpiGU, pg8::MoeOrder, true>(F.lds, g, S, E, F.wave);
            if (l + 1 < DEPTH) { __syncthreads(); tail_fill<4>(F, l + 1, ((const LAS int*)(F.lds + LDSCTL_OFF + 64))[32] * 2, vcu); }
            SEAM(pb + 6);
        }
        if (IN(pb + 7)) {
            if (!IN(pb + 6)) moe_table(F, l);
            pg8::Gemm g{(const bf16*)(F.ws + WS_ACT), nullptr, 0, D, MH};
            pg8::MoeOrder S{(const LAS int*)(F.lds + LDSCTL_OFF + 64), (const int*)(F.ws + WS_LIST), (const bf16*)(F.ws + WS_WD) + (size_t)l * NE * D * MH, (size_t)D * MH, 4, F.G, vcu, 0};
            pg8::EpiBf16S E{(bf16*)(F.ws + WS_Y), D, 0, 0, 1.f};
            pg8::gemm_phase<pg8::EpiBf16S, pg8::MoeOrder, true>(F.lds, g, S, E, F.wave);
            if (l + 1 < DEPTH) { __syncthreads(); const int tu = ((const LAS int*)(F.lds + LDSCTL_OFF + 64))[32] * 4;
                if (l == 0) tail_fill<1>(F, 0, tu, vcu); else if (l == 1) tail_fill<2>(F, 0, tu, vcu); else tail_fill<3>(F, 0, tu, vcu); }
            SEAM(pb + 7);
        }
        if (IN(pb + 8)) { phase_r2<false>(F, l); SEAM(pb + 8); }
    }
#undef IN
#undef SEAM
}

extern "C" void kernel_launch(void* const* d_in, const int* in_sizes, int n_in, void* d_out, int out_size, void* d_ws, size_t ws_size, hipStream_t stream) {
    static int grid = 0;
    if (grid == 0) {
        if (n_in != 21 || in_sizes[0] != M * D || out_size != M * D || ws_size < WS_END) { fprintf(stderr, "kernel_launch: unexpected shapes (n_in %d, in0 %d, out %d, ws %zu < %zu); nothing launched\n", n_in, n_in > 0 ? in_sizes[0] : -1, out_size, ws_size, (size_t)WS_END); grid = -1; return; }
        int dev = 0, cus = 0, per_cu = 0;
        if (hipGetDevice(&dev) != hipSuccess || hipDeviceGetAttribute(&cus, hipDeviceAttributeMultiprocessorCount, dev) != hipSuccess) { grid = -1; return; }
        if (hipFuncSetAttribute((const void*)fwd, hipFuncAttributeMaxDynamicSharedMemorySize, LDS_BYTES) != hipSuccess) { fprintf(stderr, "kernel_launch: hipFuncSetAttribute failed\n"); grid = -1; return; }
        if (hipOccupancyMaxActiveBlocksPerMultiprocessor(&per_cu, (const void*)fwd, NWAVES * 64, LDS_BYTES) != hipSuccess || per_cu < 1) fprintf(stderr, "kernel_launch: occupancy query reports %d workgroups per CU\n", per_cu);
        (void)hipGetLastError();
        grid = cus;
    }
    if (grid < 0) return;
    if (hipMemsetAsync((char*)d_ws + WS_CTL, 0, CTL_ZERO_BYTES, stream) != hipSuccess) return;
    Args a{};
    for (int i = 0; i < 21; ++i) a.in[i] = d_in[i];
    a.out = (float*)d_out; a.ws = (unsigned char*)d_ws;
#if MK_N_LAUNCHES == 1
    a.ph_lo = 0; a.ph_hi = NPHASE;
    hipLaunchKernelGGL(fwd, dim3(grid), dim3(NWAVES * 64), LDS_BYTES, stream, a);
#else
    for (int p = 0; p < NPHASE; ++p) { a.ph_lo = p; a.ph_hi = p + 1; hipLaunchKernelGGL(fwd, dim3(grid), dim3(NWAVES * 64), LDS_BYTES, stream, a); }
#endif
}
```

```cpp
#include <hip/hip_runtime.h>
#include <cstdio>
#include <cstdint>

#ifndef MK_N_LAUNCHES
#define MK_N_LAUNCHES 1
#endif

__device__ __forceinline__ int hw_tid(int wave_s) {
    unsigned z = 0u; asm volatile("" : "+s"(z));
    const unsigned lane = __builtin_amdgcn_mbcnt_hi(~0u, __builtin_amdgcn_mbcnt_lo(~0u, z));
    int t = (int)(((unsigned)wave_s << 6) | lane); asm volatile("" : "+v"(t)); return t;
}
namespace pg8 {
#define PG8_LAS __attribute__((address_space(3)))
typedef unsigned short bf16_t;
typedef short bf16x8 __attribute__((ext_vector_type(8)));
typedef float f32x4 __attribute__((ext_vector_type(4)));
typedef float f32x2 __attribute__((ext_vector_type(2)));
typedef unsigned u32x4 __attribute__((ext_vector_type(4)));
typedef unsigned u32x2 __attribute__((ext_vector_type(2)));
constexpr int BM = 256, BK = 64, HALF = 128, HTB = HALF * BK * 2  , STAGE_BYTES = 8 * HTB, NXCD = 8, WGM = 8;

__host__ __device__ __forceinline__ int lds_byte(int r, int c) { const int st = (r >> 4) * 2 + (c >> 5), rr = r & 15, cc = c & 31, ob = rr * 64 + cc * 2; return st * 1024 + (ob ^ (((ob >> 9) & 1) << 5)); }
__host__ __device__ __forceinline__ void stage_rc(int b, int& R, int& C) { const int st = b / 1024, sb = b % 1024, swz = sb ^ (((sb >> 9) & 1) << 5); R = (st >> 1) * 16 + swz / 64; C = (st & 1) * 32 + (swz % 64) / 2; }
__host__ __device__ __forceinline__ int perm32(int rho) { const int n = rho >> 4, i = rho & 15; return 8 * (i >> 2) + 4 * n + (i & 3); }

struct Unit { int pm, pn, ex, jb; };
struct Gemm { const bf16_t* A; const bf16_t* Bt; int M, N, K; };

struct StaticOrder {
    int nM, nN, nwg, G, c;
    __device__ void init(int M, int N, int G_, int c_) { nM = M / BM; nN = N / BM; nwg = nM * nN; G = G_; c = c_; }
    __device__ bool next(int i, Unit& u) const {
        const long L = (long)i * G + c; if (L >= nwg) return false;
        int wgid = (int)L; { const int q = nwg / NXCD, r = nwg % NXCD, xcd = wgid % NXCD, off = wgid / NXCD; wgid = (xcd < r ? xcd * (q + 1) : r * (q + 1) + (xcd - r) * q) + off; }
        const int nig = WGM * nN, gid = wgid / nig, fm = gid * WGM, gsz = (nM - fm) < WGM ? (nM - fm) : WGM;
        u.pm = fm + ((wgid % nig) % gsz); u.pn = (wgid % nig) / gsz; u.ex = 0; u.jb = 0; return true;
    }
    __device__ __forceinline__ const char* b_ptr(const Gemm& g, const Unit& u) const { return (const char*)g.Bt + (size_t)u.pn * BM * g.K * 2; }
    __device__ __forceinline__ unsigned a_off(const Gemm& g, const Unit& u, int h, int R, int C) const { return (unsigned)((u.pm * BM + h * HALF + R) * g.K + C) * 2u; }
};

struct MoeOrder {
    const PG8_LAS int* tab; const int* list; const bf16_t* W; size_t wstride; int ntn, G, c, gather;
    __device__ bool next(int i, Unit& u) const {
        const int L = i * G + c; const int total = tab[32] * ntn; if (L >= total) return false;
        const int rb = L / ntn; u.pn = L - rb * ntn;
        unsigned z = 0u; asm volatile("" : "+s"(z));
        const unsigned ln = __builtin_amdgcn_mbcnt_hi(~0u, __builtin_amdgcn_mbcnt_lo(~0u, z));
        const unsigned long long m = __ballot(rb >= tab[ln & 31u]);
        const int e = __builtin_popcount((unsigned)m) - 1;
        u.pm = rb; u.ex = e; u.jb = rb - tab[e]; return true;
    }
    __device__ __forceinline__ const char* b_ptr(const Gemm& g, const Unit& u) const { return (const char*)(W + (size_t)u.ex * wstride) + (size_t)u.pn * BM * g.K * 2; }
    __device__ __forceinline__ unsigned a_off(const Gemm& g, const Unit& u, int h, int R, int C) const {
        if (gather) { const int p = u.jb * BM + h * HALF + R; const int cnt = tab[33 + u.ex]; const int tok = list[u.ex * 16384 + (p < cnt ? p : 0)]; return (unsigned)(tok * g.K + C) * 2u; }
        return (unsigned)((u.pm * BM + h * HALF + R) * g.K + C) * 2u;
    }
};

__device__ __forceinline__ unsigned cvt_pk_bf16(float lo, float hi) { unsigned r; asm volatile("v_cvt_pk_bf16_f32 %0, %1, %2" : "=v"(r) : "v"(lo), "v"(hi)); return r; }

struct EpiF32 {
    static constexpr bool PERM = false;
    float* C; int ldc;
    __device__ __forceinline__ void operator()(const f32x4 (&acc)[2][2][4][2], const Unit& u, int wr, int wc, int fr, int fq) const {
        const int row0 = u.pm * BM + wr * 64 + fr, col0 = u.pn * BM + wc * 32 + 4 * fq;
#pragma unroll
        for (int ai = 0; ai < 2; ++ai)
#pragma unroll
            for (int m = 0; m < 4; ++m) { float* rowp = C + (size_t)(row0 + ai * HALF + m * 16) * ldc + col0;
#pragma unroll
                for (int bj = 0; bj < 2; ++bj)
#pragma unroll
                    for (int n = 0; n < 2; ++n) *(f32x4*)(rowp + bj * HALF + n * 16) = acc[ai][bj][m][n]; }
    }
};
struct EpiBf16S {
    static constexpr bool PERM = true;
    bf16_t* O; int ldc; int pn_lo, pn_hi; float scale;
    __device__ __forceinline__ void operator()(const f32x4 (&acc)[2][2][4][2], const Unit& u, int wr, int wc, int fr, int fq) const {
        const int row0 = u.pm * BM + wr * 64 + fr, col0 = u.pn * BM + wc * 32 + 8 * fq;
        const float sc = (u.pn >= pn_lo && u.pn < pn_hi) ? scale : 1.f;
#pragma unroll
        for (int ai = 0; ai < 2; ++ai)
#pragma unroll
            for (int m = 0; m < 4; ++m) { bf16_t* rowp = O + (size_t)(row0 + ai * HALF + m * 16) * ldc + col0;
#pragma unroll
                for (int bj = 0; bj < 2; ++bj) { const f32x4 v0 = acc[ai][bj][m][0] * sc, v1 = acc[ai][bj][m][1] * sc;
                    u32x4 w; w.x = cvt_pk_bf16(v0[0], v0[1]); w.y = cvt_pk_bf16(v0[2], v0[3]); w.z = cvt_pk_bf16(v1[0], v1[1]); w.w = cvt_pk_bf16(v1[2], v1[3]);
                    *(u32x4*)(rowp + bj * HALF) = w; } }
    }
};
struct EpiRope {
    static constexpr bool PERM = true;
    bf16_t* O; int ldc; int rope_tiles; const float* cs; float oscale;
    __device__ __forceinline__ void operator()(const f32x4 (&acc)[2][2][4][2], const Unit& u, int wr, int wc, int fr, int fq) const {
        const int row0 = u.pm * BM + wr * 64 + fr, col0 = u.pn * BM + wc * 32 + 8 * fq;
        const bool rope = u.pn < rope_tiles; const int i0 = 16 * (wc & 1) + 4 * fq;
#pragma unroll
        for (int ai = 0; ai < 2; ++ai)
#pragma unroll
            for (int m = 0; m < 4; ++m) { const int row = row0 + ai * HALF + m * 16; bf16_t* rowp = O + (size_t)row * ldc + col0;
                f32x4 t0 = (f32x4){1.f, 0.f, 1.f, 0.f}, t1 = (f32x4){1.f, 0.f, 1.f, 0.f};
                if (rope) { const f32x4* tp = (const f32x4*)(cs + ((size_t)row * 32 + i0) * 2); t0 = tp[0]; t1 = tp[1]; }
#pragma unroll
                for (int bj = 0; bj < 2; ++bj) { const f32x4 v0 = acc[ai][bj][m][0], v1 = acc[ai][bj][m][1];
                    const float a0 = v0[0] * t0[0] - v0[1] * t0[1], a1 = v0[1] * t0[0] + v0[0] * t0[1], a2 = v0[2] * t0[2] - v0[3] * t0[3], a3 = v0[3] * t0[2] + v0[2] * t0[3];
                    const float b0 = v1[0] * t1[0] - v1[1] * t1[1], b1 = v1[1] * t1[0] + v1[0] * t1[1], b2 = v1[2] * t1[2] - v1[3] * t1[3], b3 = v1[3] * t1[2] + v1[2] * t1[3];
                    u32x4 w; w.x = cvt_pk_bf16(a0 * oscale, a1 * oscale); w.y = cvt_pk_bf16(a2 * oscale, a3 * oscale); w.z = cvt_pk_bf16(b0 * oscale, b1 * oscale); w.w = cvt_pk_bf16(b2 * oscale, b3 * oscale);
                    *(u32x4*)(rowp + bj * HALF) = w; } }
    }
};
struct EpiGU {
    static constexpr bool PERM = true;
    bf16_t* O;
    __device__ __forceinline__ void operator()(const f32x4 (&acc)[2][2][4][2], const Unit& u, int wr, int wc, int fr, int fq) const {
        const int row0 = u.pm * BM + wr * 64 + fr, col0 = u.pn * HALF + wc * 32 + 8 * fq;
#pragma unroll
        for (int ai = 0; ai < 2; ++ai)
#pragma unroll
            for (int m = 0; m < 4; ++m) { bf16_t* rowp = O + (size_t)(row0 + ai * HALF + m * 16) * 256 + col0;
                float r[8];
#pragma unroll
                for (int n = 0; n < 2; ++n)
#pragma unroll
                    for (int j = 0; j < 4; ++j) { const float gt = acc[ai][0][m][n][j], up = acc[ai][1][m][n][j]; r[n * 4 + j] = gt * __builtin_amdgcn_rcpf(1.f + __expf(-gt)) * up; }
                u32x4 w; w.x = cvt_pk_bf16(r[0], r[1]); w.y = cvt_pk_bf16(r[2], r[3]); w.z = cvt_pk_bf16(r[4], r[5]); w.w = cvt_pk_bf16(r[6], r[7]);
                *(u32x4*)rowp = w; }
    }
};

template <class Epi, class Sched, bool ALIGN_EPI>
__device__ __forceinline__ void gemm_phase(PG8_LAS unsigned char* lds, const Gemm g, const Sched& S, const Epi& E, int wave_s) {
    const int tid = hw_tid(wave_s);
    const int wid = __builtin_amdgcn_readfirstlane(tid >> 6), lane = tid & 63, wr = wid >> 2, wc = wid & 3, fr = lane & 15, fq = lane >> 4;
    const int K = g.K, nt = K / BK;
    int sR[2], sC[2]; unsigned voffB[2];
#pragma unroll
    for (int i = 0; i < 2; ++i) { int R, C; stage_rc(tid * 16 + i * 8192, R, C); sR[i] = R; sC[i] = C; const int Rb = Epi::PERM ? ((R & ~31) + perm32(R & 31)) : R; voffB[i] = (unsigned)(Rb * K + C) * 2u; }
    const unsigned kstep = (unsigned)(BK * 2);
    const size_t hstep = (size_t)HALF * K * 2;
    const unsigned ldsw = (unsigned)wid * 1024u;
    const int aoff = lds_byte(wr * 64 + fr, fq * 8), boff = lds_byte(wc * 32 + fr, fq * 8);
    const char* const Ab = (const char*)g.A;
#define PG8_SA(b, h) (((b) * 2 + (h)) * HTB)
#define PG8_SB(b, h) ((4 + (b) * 2 + (h)) * HTB)
#define PG8_STAGEB(bufoff, gbase) do { _Pragma("unroll") for (int _i = 0; _i < 2; ++_i) \
        __builtin_amdgcn_global_load_lds((const unsigned*)((const char*)(gbase) + voffB[_i]), (PG8_LAS unsigned*)(lds + (bufoff) + ldsw + _i * 8192), 16, 0, 0); } while (0)
#define PG8_STAGEA(bufoff, o0, o1) do { \
        __builtin_amdgcn_global_load_lds((const unsigned*)(Ab + (o0)), (PG8_LAS unsigned*)(lds + (bufoff) + ldsw), 16, 0, 0); \
        __builtin_amdgcn_global_load_lds((const unsigned*)(Ab + (o1)), (PG8_LAS unsigned*)(lds + (bufoff) + ldsw + 8192), 16, 0, 0); } while (0)
#define PG8_LDA(dst, b, h) do { _Pragma("unroll") for (int m = 0; m < 4; ++m) _Pragma("unroll") for (int k = 0; k < 2; ++k) dst[m][k] = *(const PG8_LAS bf16x8*)(lds + PG8_SA(b, h) + aoff + m * 2048 + k * 1024); } while (0)
#define PG8_LDB(dst, b, h) do { _Pragma("unroll") for (int n = 0; n < 2; ++n) _Pragma("unroll") for (int k = 0; k < 2; ++k) dst[n][k] = *(const PG8_LAS bf16x8*)(lds + PG8_SB(b, h) + boff + n * 2048 + k * 1024); } while (0)
#define PG8_MMA(ai, bj, At, Bt) do { __builtin_amdgcn_s_setprio(1); _Pragma("unroll") for (int m = 0; m < 4; ++m) _Pragma("unroll") for (int n = 0; n < 2; ++n) _Pragma("unroll") for (int k = 0; k < 2; ++k) \
        acc[ai][bj][m][n] = __builtin_amdgcn_mfma_f32_16x16x32_bf16(Bt[n][k], At[m][k], acc[ai][bj][m][n], 0, 0, 0); __builtin_amdgcn_s_setprio(0); } while (0)
#define PG8_WAIT_V(n) asm volatile("s_waitcnt vmcnt(" #n ")" ::: "memory")
#define PG8_WAIT_L(n) asm volatile("s_waitcnt lgkmcnt(" #n ")" ::: "memory")
#define PG8_BAR __builtin_amdgcn_s_barrier()
#define PG8_SCHED __builtin_amdgcn_sched_barrier(0)
    Unit cur, nxt; int ui = 0;
    if (!S.next(0, cur)) return;
    f32x4 acc[2][2][4][2];
#pragma unroll
    for (int a = 0; a < 2; ++a)
#pragma unroll
        for (int b = 0; b < 2; ++b)
#pragma unroll
            for (int m = 0; m < 4; ++m)
#pragma unroll
                for (int n = 0; n < 2; ++n) acc[a][b][m][n] = (f32x4){0.f, 0.f, 0.f, 0.f};
    bf16x8 At[4][2], B0[2][2], B1[2][2];
    unsigned vA00, vA01, vA10, vA11;
    vA00 = S.a_off(g, cur, 0, sR[0], sC[0]); vA01 = S.a_off(g, cur, 0, sR[1], sC[1]); vA10 = S.a_off(g, cur, 1, sR[0], sC[0]); vA11 = S.a_off(g, cur, 1, sR[1], sC[1]);
    const char* cB = S.b_ptr(g, cur);
    PG8_STAGEB(PG8_SB(0, 0), cB); PG8_STAGEB(PG8_SB(0, 1), cB + hstep); PG8_STAGEA(PG8_SA(0, 0), vA00, vA01); PG8_STAGEA(PG8_SA(0, 1), vA10, vA11);
    if (wr == 1) PG8_BAR;
    PG8_WAIT_V(2); PG8_BAR;
    PG8_STAGEB(PG8_SB(1, 0), cB + kstep); PG8_STAGEA(PG8_SA(1, 0), vA00 + kstep, vA01 + kstep); PG8_STAGEB(PG8_SB(1, 1), cB + hstep + kstep);
    PG8_WAIT_V(6); PG8_BAR;
    for (;;) {
        const bool has_next = S.next(ui + 1, nxt);
        const char* nB = has_next ? S.b_ptr(g, nxt) : cB;
        unsigned nA00 = vA00, nA01 = vA01, nA10 = vA10, nA11 = vA11;
        if (has_next) { nA00 = S.a_off(g, nxt, 0, sR[0], sC[0]); nA01 = S.a_off(g, nxt, 0, sR[1], sC[1]); nA10 = S.a_off(g, nxt, 1, sR[0], sC[0]); nA11 = S.a_off(g, nxt, 1, sR[1], sC[1]); }
#pragma unroll 1
        for (int t = 0; t < nt; t += 2) {
            const bool last = (t == nt - 2);
            const unsigned k1 = (unsigned)(t + 1) * kstep;
            const unsigned k2 = last ? 0u : (unsigned)(t + 2) * kstep, k3 = k2 + kstep;
            const char* b2 = last ? nB : cB + (size_t)(t + 2) * kstep; const char* b3 = b2 + kstep;
            const unsigned s00 = (last ? nA00 : vA00), s01 = (last ? nA01 : vA01), s10 = (last ? nA10 : vA10), s11 = (last ? nA11 : vA11);
            PG8_LDB(B0, 0, 0); PG8_LDB(B1, 0, 1); PG8_SCHED; PG8_LDA(At, 0, 0); PG8_STAGEA(PG8_SA(1, 1), vA10 + k1, vA11 + k1);
            PG8_WAIT_V(8); PG8_WAIT_L(0); PG8_BAR; PG8_MMA(0, 0, At, B0); PG8_MMA(0, 1, At, B1); PG8_BAR; PG8_SCHED;
            PG8_LDA(At, 0, 1); PG8_STAGEB(PG8_SB(0, 0), b2); PG8_STAGEB(PG8_SB(0, 1), b2 + hstep); PG8_STAGEA(PG8_SA(0, 0), s00 + k2, s01 + k2);
            PG8_WAIT_V(8); PG8_WAIT_L(0); PG8_BAR; PG8_MMA(1, 0, At, B0); PG8_MMA(1, 1, At, B1); PG8_BAR; PG8_SCHED;
            PG8_LDB(B0, 1, 0); PG8_LDB(B1, 1, 1); PG8_SCHED; PG8_LDA(At, 1, 0); PG8_STAGEA(PG8_SA(0, 1), s10 + k2, s11 + k2);
            PG8_WAIT_V(8); PG8_WAIT_L(0); PG8_BAR; PG8_MMA(0, 0, At, B0); PG8_MMA(0, 1, At, B1); PG8_BAR; PG8_SCHED;
            PG8_LDA(At, 1, 1); PG8_STAGEB(PG8_SB(1, 0), b3); PG8_STAGEB(PG8_SB(1, 1), b3 + hstep); PG8_STAGEA(PG8_SA(1, 0), s00 + k3, s01 + k3);
            PG8_WAIT_V(8); PG8_WAIT_L(0); PG8_BAR; PG8_MMA(1, 0, At, B0); PG8_MMA(1, 1, At, B1); PG8_BAR; PG8_SCHED;
        }
        if constexpr (ALIGN_EPI) { if (wr == 0) PG8_BAR; }
        E(acc, cur, wr, wc, fr, fq);
        if (!has_next) break;
#pragma unroll
        for (int a = 0; a < 2; ++a)
#pragma unroll
            for (int b = 0; b < 2; ++b)
#pragma unroll
                for (int m = 0; m < 4; ++m)
#pragma unroll
                    for (int n = 0; n < 2; ++n) acc[a][b][m][n] = (f32x4){0.f, 0.f, 0.f, 0.f};
        cur = nxt; cB = nB; vA00 = nA00; vA01 = nA01; vA10 = nA10; vA11 = nA11; ++ui;
        if constexpr (ALIGN_EPI) { if (wr == 1) PG8_BAR; }
    }
    PG8_WAIT_V(0);
    if constexpr (!ALIGN_EPI) { if (wr == 0) PG8_BAR; }
    PG8_BAR;
#undef PG8_SA
#undef PG8_SB
#undef PG8_STAGEA
#undef PG8_STAGEB
#undef PG8_LDA
#undef PG8_LDB
#undef PG8_MMA
#undef PG8_WAIT_V
#undef PG8_WAIT_L
#undef PG8_BAR
#undef PG8_SCHED
}
}

constexpr int NWAVES = 8;
constexpr int BATCH = 2, SEQ = 8192, D = 1024, M = BATCH * SEQ, DEPTH = 4, NA = 2;
constexpr float ALPHA = 1.681792830507429f;
constexpr float LN_EPS = 1e-5f, A_NORM_EPS = 1e-6f;
constexpr int AH = 4, DQK = 128, DV = 256, APROJ = 3080, NPROJ = 3072;
constexpr int CH = 256, NCH = SEQ / CH;
constexpr int BG = 3, BH = 8, HD = 64, BW = 512, NQ = 1536, NKV = 3072;
constexpr int NE = 32, EG = 8, MH = 256;
constexpr int MAXRB = 160;

constexpr size_t MiB = 1u << 20;
constexpr size_t WS_CTL = 0, CTL_ZERO_BYTES = 128 * 1024;
constexpr size_t WS_MOD = 1 * MiB;
constexpr size_t WS_ROPE = 2 * MiB;
constexpr size_t WS_WR = 6 * MiB;
constexpr size_t WS_WG = 6 * MiB + 768 * 1024;
constexpr size_t WS_GATES = 7 * MiB;
constexpr size_t WS_ROUTE = 8 * MiB;
constexpr size_t WS_LIST = 9 * MiB;
constexpr size_t WS_MLS = 11 * MiB;
constexpr size_t WS_WIN = 12 * MiB, WS_WOUT = 24 * MiB, WS_WKV = 28 * MiB, WS_WQ = 34 * MiB, WS_WO = 40 * MiB, WS_WGU = 42 * MiB, WS_WD = 170 * MiB;
constexpr size_t WS_H = 234 * MiB;
constexpr size_t WS_YA = 266 * MiB;
constexpr size_t WS_S0 = 298 * MiB;
constexpr size_t WS_PROJ = WS_S0, WS_DC = WS_S0 + 96 * MiB, WS_CIN = WS_S0 + 128 * MiB;
constexpr size_t WS_Q = WS_S0, WS_OG = WS_S0 + 48 * MiB, WS_LSE = WS_S0 + 96 * MiB, WS_KV = WS_S0 + 112 * MiB;
constexpr size_t WS_YMIX = WS_S0;
constexpr size_t WS_Y = WS_S0, WS_ACT = WS_S0 + 80 * MiB;
constexpr size_t WS_X = WS_S0 + 208 * MiB;
constexpr size_t WS_END = WS_X + 64 * MiB;
constexpr int CW_BAR = 4096;
constexpr int CW_CNT = 16384;

constexpr int RING_BYTES = 131072;
constexpr int LDSCTL_OFF = 145408;
constexpr int LDS_BYTES = 147456;

#define GAS __attribute__((address_space(1)))
#define LAS __attribute__((address_space(3)))
typedef unsigned short bf16;
typedef unsigned v4u __attribute__((ext_vector_type(4)));
typedef unsigned v2u __attribute__((ext_vector_type(2)));
typedef float f32x4 __attribute__((ext_vector_type(4)));
typedef float f32x2 __attribute__((ext_vector_type(2)));
#define RLX_AGENT __ATOMIC_RELAXED, __HIP_MEMORY_SCOPE_AGENT
#ifndef ST_NT
#define ST_NT(p, v) __builtin_nontemporal_store((v), (p))
#endif
__device__ __forceinline__ unsigned f2bf(float f) { unsigned u = __builtin_bit_cast(unsigned, f); return (u + 0x7fffu + ((u >> 16) & 1u)) >> 16; }
typedef __bf16 bf16n2 __attribute__((ext_vector_type(2)));
__device__ __forceinline__ unsigned pk2(float lo, float hi) { bf16n2 v; v.x = (__bf16)lo; v.y = (__bf16)hi; return __builtin_bit_cast(unsigned, v); }
__device__ __forceinline__ float u2f(unsigned w) { return __builtin_bit_cast(float, w); }
__device__ __forceinline__ unsigned f2u(float f) { return __builtin_bit_cast(unsigned, f); }
__device__ __forceinline__ float bflo(unsigned w) { return __builtin_bit_cast(float, w << 16); }
__device__ __forceinline__ float bfhi(unsigned w) { return __builtin_bit_cast(float, w & 0xffff0000u); }
__device__ __forceinline__ float bf2f(bf16 v) { return __builtin_bit_cast(float, (unsigned)v << 16); }
template <int CTRL> __device__ __forceinline__ float dpp_mov(float v) { return __builtin_bit_cast(float, __builtin_amdgcn_update_dpp(0, __builtin_bit_cast(int, v), CTRL, 0xF, 0xF, true)); }
__device__ __forceinline__ float rdlane(float v, int l) { return __builtin_bit_cast(float, __builtin_amdgcn_readlane(__builtin_bit_cast(int, v), l)); }
__device__ __forceinline__ float quad_sum(float v) { v += dpp_mov<0xB1>(v); v += dpp_mov<0x4E>(v); return v; }
__device__ __forceinline__ float quad_max(float v) { v = fmaxf(v, dpp_mov<0xB1>(v)); v = fmaxf(v, dpp_mov<0x4E>(v)); return v; }
__device__ __forceinline__ float row16_sum(float v) { v += dpp_mov<0xB1>(v); v += dpp_mov<0x4E>(v); v += dpp_mov<0x141>(v); v += dpp_mov<0x140>(v); return v; }
__device__ __forceinline__ float row16_max(float v) { v = fmaxf(v, dpp_mov<0xB1>(v)); v = fmaxf(v, dpp_mov<0x4E>(v)); v = fmaxf(v, dpp_mov<0x141>(v)); v = fmaxf(v, dpp_mov<0x140>(v)); return v; }
__device__ __forceinline__ float wave_sum(float v) { v = row16_sum(v); return (rdlane(v, 0) + rdlane(v, 16)) + (rdlane(v, 32) + rdlane(v, 48)); }
__device__ __forceinline__ float wave_max(float v) { v = row16_max(v); return fmaxf(fmaxf(rdlane(v, 0), rdlane(v, 16)), fmaxf(rdlane(v, 32), rdlane(v, 48))); }
#define opaque_tid() hw_tid(F.wave)
__device__ __forceinline__ float sigmoidf_(float x) { return __builtin_amdgcn_rcpf(1.f + __expf(-x)); }
__device__ __forceinline__ float logsigmoidf_(float x) { return fminf(x, 0.f) - __logf(1.f + __expf(-fabsf(x))); }
__device__ __forceinline__ float lane_xor(float v, int m, int lane) { return __builtin_bit_cast(float, __builtin_amdgcn_ds_bpermute((lane ^ m) << 2, __builtin_bit_cast(int, v))); }
__device__ __forceinline__ float lane_up(float v, int o, int lane) { return __builtin_bit_cast(float, __builtin_amdgcn_ds_bpermute(((lane - o) & 63) << 2, __builtin_bit_cast(int, v))); }
__device__ __forceinline__ int lane_up(int v, int o, int lane) { return __builtin_amdgcn_ds_bpermute(((lane - o) & 63) << 2, v); }
__device__ __forceinline__ int lane_get(int v, int src) { return __builtin_amdgcn_ds_bpermute(src << 2, v); }

#define XB_TMO      128
#define XB_XCNT(j)  (256  + 64 * (j))
#define XB_XSUB(j)  (1280 + 64 * (j))
#define XB_XGEN(j)  (2304 + 64 * (j))
#define XB_TOP      3328
#define XB_TOPGEN   3392
#define XCD_BAR_WORDS 3456
#define XB_SPIN_CAP (1u << 18)

__device__ __forceinline__ unsigned xb_ld(unsigned* p)              { return __hip_atomic_load(p, __ATOMIC_RELAXED, __HIP_MEMORY_SCOPE_AGENT); }
__device__ __forceinline__ unsigned xb_add(unsigned* p, unsigned v) { return __hip_atomic_fetch_add(p, v, __ATOMIC_RELAXED, __HIP_MEMORY_SCOPE_AGENT); }
__device__ __forceinline__ unsigned xb_xcc_id() { return (unsigned)__builtin_amdgcn_s_getreg((3 << 11) | 20) & 0xFu; }
#define XB_SPIN(cond, bar) do { unsigned _sp = 0; while (cond) { __builtin_amdgcn_s_sleep(1); \
    if ((++_sp & 255u) == 0u) { if (xb_ld(&(bar)[XB_TMO])) break; if (_sp > XB_SPIN_CAP) { atomicAdd(&(bar)[XB_TMO], 1u); break; } } } } while (0)

struct XcdBarrier {
    unsigned* bar; unsigned x;
    volatile LAS unsigned* st;
    int w;
};
__device__ __forceinline__ XcdBarrier xcd_barrier_post(unsigned* bar, volatile LAS unsigned* st, int wave_s) {
    XcdBarrier b; b.bar = bar; b.x = xb_xcc_id(); b.st = st; b.w = wave_s;
    if (hw_tid(wave_s) == 0) (void)xb_add(&bar[XB_XCNT(b.x)], 1u);
    return b;
}
__device__ __forceinline__ void xcd_barrier_complete(unsigned* bar, unsigned x, unsigned& nloc, unsigned& nx) {
    const unsigned G = gridDim.x * gridDim.y * gridDim.z;
    unsigned sum, cnt, mine, sp = 0u;
    for (;;) {
        sum = 0u; cnt = 0u; mine = 0u;
#pragma unroll
        for (unsigned j = 0; j < 16; ++j) { const unsigned c = xb_ld(&bar[XB_XCNT(j)]); sum += c; cnt += (c > 0u) ? 1u : 0u; mine = (j == x) ? c : mine; }
        if (sum == G) break;
        __builtin_amdgcn_s_sleep(1);
        if ((++sp & 255u) == 0u) { if (xb_ld(&bar[XB_TMO])) break; if (sp > XB_SPIN_CAP) { atomicAdd(&bar[XB_TMO], 1u); break; } }
    }
    nloc = mine > 0u ? mine : 1u; nx = cnt > 0u ? cnt : 1u;
}
__device__ __forceinline__ void xcd_barrier(const XcdBarrier& b) {
    asm volatile("s_waitcnt vmcnt(0)" ::: "memory");
    __syncthreads();
    if (hw_tid(b.w) == 0) {
        unsigned* bar = b.bar;
        __builtin_amdgcn_s_waitcnt(0);
        unsigned nloc = b.st[0], nx = b.st[1];
        if (nloc == 0u) { xcd_barrier_complete(bar, b.x, nloc, nx); b.st[0] = nloc; b.st[1] = nx; }
        const unsigned old = xb_add(&bar[XB_XSUB(b.x)], 1u);
        const unsigned gen = old / nloc;
        if (old + 1u == (gen + 1u) * nloc) {
            __builtin_amdgcn_fence(__ATOMIC_RELEASE, "agent");
            asm volatile("s_waitcnt vmcnt(0)" ::: "memory");
            const unsigned og = xb_add(&bar[XB_TOP], 1u);
            const unsigned tg = og / nx;
            if (og + 1u == (tg + 1u) * nx) xb_add(&bar[XB_TOPGEN], 1u);
            else XB_SPIN(xb_ld(&bar[XB_TOPGEN]) == tg, bar);
            __builtin_amdgcn_fence(__ATOMIC_ACQUIRE, "agent");
            xb_add(&bar[XB_XGEN(b.x)], 1u);
            asm volatile("s_waitcnt vmcnt(0)" ::: "memory");
        } else {
            XB_SPIN(xb_ld(&bar[XB_XGEN(b.x)]) == gen, bar);
            __builtin_amdgcn_fence(__ATOMIC_ACQUIRE, "agent");
            asm volatile("s_waitcnt vmcnt(0)" ::: "memory");
        }
    }
    __syncthreads();
}

struct Frame {
    LAS unsigned char* lds;
    unsigned* ctl;
    unsigned char* ws;
    int tid, lane, wave, G;
    const float *x, *c; const int* pos; const float *ada_w, *ada_b, *ln_g, *ln_b, *a_w_in, *a_b_gate, *a_norm_g, *a_w_out, *b_w_kv, *b_w_q, *b_w_o,
                *w_r1, *b_r1, *w_r2, *b_r2, *w_gate, *w_up, *w_down;
    float* out;
};

__device__ __forceinline__ int rowmap(int mode, int n) {
    if (mode == 1 || (mode == 2 && n < 1536)) { const int e = n & 63; return (n & ~63) + 2 * (e & 31) + (e >> 5); }
    if (mode == 3) return ((n >> 7) << 8) + (n & 127);
    if (mode == 4) return ((n >> 7) << 8) + 128 + (n & 127);
    return n;
}
__device__ __forceinline__ void transpose_load(const float* W, int ldw, int k0, int n0, f32x4 (&t)[8], int lane) {
#pragma unroll
    for (int i = 0; i < 8; ++i) t[i] = *(const f32x4*)(W + (size_t)(k0 + 8 * i + (lane >> 3)) * ldw + n0 + 4 * (lane & 7));
}
__device__ __forceinline__ void transpose_store(const f32x4 (&t)[8], int k0, int n0, bf16* WT, int ldk, int mode, LAS float* scr, int lane) {
#pragma unroll
    for (int i = 0; i < 8; ++i) { LAS float* d = scr + (8 * i + (lane >> 3)) * 33 + 4 * (lane & 7); d[0] = t[i].x; d[1] = t[i].y; d[2] = t[i].z; d[3] = t[i].w; }
    asm volatile("s_waitcnt lgkmcnt(0)" ::: "memory");
    const int c = lane & 7;
#pragma unroll
    for (int j = 0; j < 4; ++j) { const int n = (lane >> 3) + 8 * j; const LAS float* s = scr + (8 * c) * 33 + n;
        v4u o; o.x = pk2(s[0 * 33], s[1 * 33]); o.y = pk2(s[2 * 33], s[3 * 33]); o.z = pk2(s[4 * 33], s[5 * 33]); o.w = pk2(s[6 * 33], s[7 * 33]);
        *(v4u*)(WT + (size_t)rowmap(mode, n0 + n) * ldk + k0 + 8 * c) = o; }
    asm volatile("s_waitcnt lgkmcnt(0)" ::: "memory");
}
struct TItem { const float* W; bf16* WT; int ldw, k0, n0, ldk, mode; };
__device__ __forceinline__ TItem conv_item(Frame& F, int kind, int l, int r) {
    TItem t; t.mode = 0;
    const float* const wg = F.w_gate; const float* const wu = F.w_up;
    if (kind == 0) { t.W = F.a_w_in + (size_t)l * D * APROJ; t.ldw = APROJ; t.k0 = 64 * (r / 96); t.n0 = 32 * (r % 96); t.WT = (bf16*)(F.ws + WS_WIN) + (size_t)l * NPROJ * D; t.ldk = D; }
    else if (kind == 1) { t.W = F.a_w_out + (size_t)l * D * D; t.ldw = D; t.k0 = 64 * (r / 32); t.n0 = 32 * (r % 32); t.WT = (bf16*)(F.ws + WS_WOUT) + (size_t)l * D * D; t.ldk = D; }
    else if (kind == 2) { t.W = F.b_w_kv; t.ldw = NKV; t.k0 = 64 * (r / 96); t.n0 = 32 * (r % 96); t.WT = (bf16*)(F.ws + WS_WKV); t.ldk = D; t.mode = 2; }
    else if (kind == 3) { t.W = F.b_w_q + (size_t)l * D * NQ; t.ldw = NQ; t.k0 = 64 * (r / 48); t.n0 = 32 * (r % 48); t.WT = (bf16*)(F.ws + WS_WQ) + (size_t)l * NQ * D; t.ldk = D; t.mode = 1; }
    else if (kind == 4) { t.W = F.b_w_o + (size_t)l * BW * D; t.ldw = D; t.k0 = 64 * (r / 32); t.n0 = 32 * (r % 32); t.WT = (bf16*)(F.ws + WS_WO) + (size_t)l * D * BW; t.ldk = BW; }
    else { const int sub = r >> 12, q = r & 4095, le = l * NE + (q >> 7), rr = q & 127;
        if (sub < 2) { t.W = (sub == 0 ? wg : wu) + (size_t)le * D * MH; t.ldw = MH; t.k0 = 64 * (rr / 8); t.n0 = 32 * (rr % 8); t.WT = (bf16*)(F.ws + WS_WGU) + (size_t)le * 512 * D; t.ldk = D; t.mode = 3 + sub; }
        else { t.W = F.w_down + (size_t)le * MH * D; t.ldw = D; t.k0 = 64 * (rr / 32); t.n0 = 32 * (rr % 32); t.WT = (bf16*)(F.ws + WS_WD) + (size_t)le * D * MH; t.ldk = MH; } }
    return t;
}
template <int STAGE> __device__ __forceinline__ int stage_count() { return STAGE == 0 ? 1536 + 512 + 12288 : STAGE == 1 ? 1536 + 512 : STAGE == 2 ? 1536 + 768 + 256 : STAGE == 3 ? 768 + 256 : 12288; }
template <int STAGE> __device__ __forceinline__ TItem stage_item(Frame& F, int r, int l) {
    if (STAGE == 0) { if (r < 1536) return conv_item(F, 0, 0, r); r -= 1536; if (r < 512) return conv_item(F, 1, 0, r); return conv_item(F, 5, 0, r - 512); }
    if (STAGE == 1) { if (r < 1536) return conv_item(F, 0, 1, r); return conv_item(F, 1, 1, r - 1536); }
    if (STAGE == 2) { if (r < 1536) return conv_item(F, 2, 0, r); r -= 1536; if (r < 768) return conv_item(F, 3, 0, r); return conv_item(F, 4, 0, r - 768); }
    if (STAGE == 3) { if (r < 768) return conv_item(F, 3, 1, r); return conv_item(F, 4, 1, r - 768); }
    return conv_item(F, 5, l, r);
}
template <int STAGE> __device__ __forceinline__ void conv_run(Frame& F, int l, int gw, int NGW, int lane, int wave) {
    LAS float* scr = (LAS float*)(F.lds + wave * 16384);
    const int NITEMS = stage_count<STAGE>();
    f32x4 cur[8], nxt[8];
    int it = gw;
    if (it < NITEMS) { const TItem t = stage_item<STAGE>(F, it, l); transpose_load(t.W, t.ldw, t.k0, t.n0, cur, lane); }
#pragma unroll 1
    for (; it < NITEMS; it += NGW) {
        const TItem t = stage_item<STAGE>(F, it, l);
        const bool more = it + NGW < NITEMS;
        if (more) { const TItem tn = stage_item<STAGE>(F, it + NGW, l); transpose_load(tn.W, tn.ldw, tn.k0, tn.n0, nxt, lane); }
        transpose_store(cur, t.k0, t.n0, t.WT, t.ldk, t.mode, scr, lane);
        if (more) {
#pragma unroll
            for (int j = 0; j < 8; ++j) cur[j] = nxt[j]; }
    }
}
__device__ __forceinline__ void gemv_run(Frame& F, int tid, int lane, int wave) {
    LAS float* red = (LAS float*)F.lds;
    LAS float* sc = (LAS float*)(F.lds + 8192);
    float* mod = (float*)(F.ws + WS_MOD);
    for (int i = tid; i < 2 * D; i += NWAVES * 64) { const float c = F.c[i]; sc[i] = c / (1.f + expf(-c)); }
    __syncthreads();
    for (int it = blockIdx.x; it < 4 * 64; it += F.G) {
        const int l = it >> 6, n0 = (it & 63) * 96;
        const float* W = F.ada_w + (size_t)l * D * 6144 + n0 + 2 * (lane < 48 ? lane : 0);
        float a00 = 0.f, a01 = 0.f, a10 = 0.f, a11 = 0.f;
        const int k0 = wave * 128;
#pragma unroll 1
        for (int kb = k0; kb < k0 + 128; kb += 32) {
            f32x2 w[32];
#pragma unroll
            for (int k = 0; k < 32; ++k) w[k] = *(const f32x2*)(W + (size_t)(kb + k) * 6144);
#pragma unroll
            for (int k = 0; k < 32; ++k) { const float c0 = sc[kb + k], c1 = sc[D + kb + k]; a00 += c0 * w[k].x; a01 += c0 * w[k].y; a10 += c1 * w[k].x; a11 += c1 * w[k].y; }
        }
        if (lane < 48) { red[(wave * 2 + 0) * 96 + 2 * lane] = a00; red[(wave * 2 + 0) * 96 + 2 * lane + 1] = a01;
                         red[(wave * 2 + 1) * 96 + 2 * lane] = a10; red[(wave * 2 + 1) * 96 + 2 * lane + 1] = a11; }
        __syncthreads();
        if (tid < 192) { const int b = tid / 96, nn = tid % 96; float s = 0.f;
#pragma unroll
            for (int w8 = 0; w8 < 8; ++w8) s += red[(w8 * 2 + b) * 96 + nn];
            mod[(size_t)(l * 2 + b) * 6144 + n0 + nn] = s + F.ada_b[l * 6144 + n0 + nn]; }
        __syncthreads();
    }
}
__device__ __forceinline__ void rope_table(Frame& F, int gt, int NGT) {
    float* cs = (float*)(F.ws + WS_ROPE);
    const float inv = powf(10000.f, -(float)(gt & 31) * 2.0f / 64.0f);
    for (int i = gt; i < M * 32; i += NGT) { const int tok = i >> 5;
        const float ang = (float)F.pos[tok] * inv;
        const double a = (double)ang; const double n = rint(a * 0.15915494309189535); const float r = (float)(a - n * 6.283185307179586);
        *(f32x2*)(cs + 2 * (size_t)i) = (f32x2){cosf(r), sinf(r)}; }
}
template <int STAGE> __device__ __forceinline__ void tail_fill(Frame& F, int l, int total_units, int vcu) {
    const int tid = opaque_tid(), lane = tid & 63, wave = __builtin_amdgcn_readfirstlane(tid >> 6);
    const int maxu = (total_units + F.G - 1) / F.G; int cut = total_units - (maxu - 1) * F.G; if (cut < 0 || F.G - cut < F.G / 2) cut = 0;
    if (vcu >= cut) {
        const int j = vcu - cut, n = F.G - cut;
        if (STAGE == 4) conv_run<STAGE>(F, l, j * NWAVES + wave, n * NWAVES, lane, wave);
        else {
            conv_run<STAGE>(F, l, j * NWAVES + wave, n * NWAVES, lane, wave);
            if (STAGE == 1) rope_table(F, j * (NWAVES * 64) + tid, n * (NWAVES * 64));
        }
    }
}
__device__ __forceinline__ void pro_a(Frame& F) {
    const int tid = opaque_tid(), lane = tid & 63, wave = __builtin_amdgcn_readfirstlane(tid >> 6);
    gemv_run(F, tid, lane, wave);
    conv_run<0>(F, 0, blockIdx.x * NWAVES + wave, F.G * NWAVES, lane, wave);
    {
        const int gt = blockIdx.x * (NWAVES * 64) + tid, NGT = F.G * NWAVES * 64;
        float* WR = (float*)(F.ws + WS_WR); float* WG = (float*)(F.ws + WS_WG);
        for (int i = gt; i < 4 * 48 * D; i += NGT) { const int l = i / (48 * D), c = (i / D) % 48, k = i % D;
            WR[i] = c < 4 ? F.w_r1[(size_t)(l * D + k) * 4 + c] : (c < 36 ? F.w_r2[(size_t)(l * D + k) * 32 + (c - 4)] : 0.f); }
        for (int i = gt; i < 2 * 8 * D; i += NGT) { const int l = i / (8 * D), j = (i / D) % 8, k = i % D; WG[i] = F.a_w_in[(size_t)(l * D + k) * APROJ + NPROJ + j]; }
    }
}

__device__ __forceinline__ void ln_row(f32x4 (&v)[4], const float* lng, const float* lnb, int lane) {
    float s = 0.f;
#pragma unroll
    for (int j = 0; j < 4; ++j) s += (v[j].x + v[j].y) + (v[j].z + v[j].w);
    const float mean = wave_sum(s) * (1.f / D); float q = 0.f;
#pragma unroll
    for (int j = 0; j < 4; ++j) { v[j] = v[j] - mean; q += (v[j].x * v[j].x + v[j].y * v[j].y) + (v[j].z * v[j].z + v[j].w * v[j].w); }
    const float rstd = 1.f / sqrtf(wave_sum(q) * (1.f / D) + LN_EPS);
#pragma unroll
    for (int j = 0; j < 4; ++j) { const f32x4 g = *(const f32x4*)(lng + 256 * j + 4 * lane), b = *(const f32x4*)(lnb + 256 * j + 4 * lane); v[j] = v[j] * rstd * g + b; }
}
__device__ __forceinline__ void modulate(const f32x4 (&v)[4], f32x4 (&h)[4], const float* sc, const float* sh, int lane) {
#pragma unroll
    for (int j = 0; j < 4; ++j) { const f32x4 s = *(const f32x4*)(sc + 256 * j + 4 * lane), t = *(const f32x4*)(sh + 256 * j + 4 * lane); h[j] = v[j] * (1.f + s) + t; }
}
__device__ __forceinline__ void store_row_bf16(bf16* dst, const f32x4 (&h)[4], int lane) {
#pragma unroll
    for (int j = 0; j < 4; ++j) { v2u o; o.x = pk2(h[j].x, h[j].y); o.y = pk2(h[j].z, h[j].w); ST_NT((v2u*)(dst + 256 * j + 4 * lane), o); }
}
__device__ __forceinline__ void gates_row(const f32x4 (&h)[4], const float* WGl, const float* bg, float* grow, int lane) {
    float p[8];
#pragma unroll
    for (int g = 0; g < 8; ++g) { float s = 0.f;
        if ((g & 1) == 0) asm volatile("" ::: "memory");
#pragma unroll
        for (int j = 0; j < 4; ++j) { const f32x4 w = *(const f32x4*)(WGl + g * D + 256 * j + 4 * lane); s += (h[j].x * w.x + h[j].y * w.y) + (h[j].z * w.z + h[j].w * w.w); }
        p[g] = wave_sum(s) + bg[g]; }
    if (lane == 0) { *(f32x4*)grow = (f32x4){p[0], p[1], p[2], p[3]}; *(f32x4*)(grow + 4) = (f32x4){p[4], p[5], p[6], p[7]}; }
}
template <int NR> __device__ __forceinline__ void gates_rows(const f32x4 (&h)[NR][4], const float* WGl, const float* bg, float* grow0, int lane) {
    float p[NR][8];
#pragma unroll
    for (int g = 0; g < 8; ++g) { f32x4 w[4];
#pragma unroll
        for (int j = 0; j < 4; ++j) w[j] = *(const f32x4*)(WGl + g * D + 256 * j + 4 * lane);
#pragma unroll
        for (int r = 0; r < NR; ++r) { float s = 0.f;
#pragma unroll
            for (int j = 0; j < 4; ++j) s += (h[r][j].x * w[j].x + h[r][j].y * w[j].y) + (h[r][j].z * w[j].z + h[r][j].w * w[j].w);
            p[r][g] = wave_sum(s) + bg[g]; } }
    if (lane == 0) {
#pragma unroll
        for (int r = 0; r < NR; ++r) { *(f32x4*)(grow0 + r * 8) = (f32x4){p[r][0], p[r][1], p[r][2], p[r][3]}; *(f32x4*)(grow0 + r * 8 + 4) = (f32x4){p[r][4], p[r][5], p[r][6], p[r][7]}; } }
}
constexpr int RW = 4;
__device__ __forceinline__ void pro_b(Frame& F) {
    const int tid = opaque_tid(), lane = tid & 63, wave = __builtin_amdgcn_readfirstlane(tid >> 6), gw = blockIdx.x * NWAVES + wave, NGW = F.G * NWAVES; (void)tid;
    const float* mod = (const float*)(F.ws + WS_MOD); bf16* H = (bf16*)(F.ws + WS_H); float* gates = (float*)(F.ws + WS_GATES); const float* WG = (const float*)(F.ws + WS_WG);
    for (int row0 = gw * RW; row0 < M; row0 += NGW * RW) {
        const int b = row0 >> 13; const float* mb = mod + (size_t)(0 * 2 + b) * 6144;
        f32x4 h[RW][4];
#pragma unroll
        for (int r = 0; r < RW; ++r)
#pragma unroll
            for (int j = 0; j < 4; ++j) h[r][j] = *(const f32x4*)(F.x + (size_t)(row0 + r) * D + 256 * j + 4 * lane);
#pragma unroll
        for (int r = 0; r < RW; ++r) { store_row_bf16((bf16*)(F.ws + WS_X) + (size_t)(row0 + r) * D, h[r], lane);
            modulate(h[r], h[r], mb + 1024, mb, lane); store_row_bf16(H + (size_t)(row0 + r) * D, h[r], lane); }
        gates_rows<RW>(h, WG, F.a_b_gate, gates + (size_t)row0 * 8, lane);
    }
}
template <bool DRY> __device__ __forceinline__ void phase_r1(Frame& F, int l) {
    const int tid = opaque_tid(), lane = tid & 63, wave = __builtin_amdgcn_readfirstlane(tid >> 6), fr = lane & 15, fq = lane >> 4;
    const float* mod = (const float*)(F.ws + WS_MOD); bf16* H = (bf16*)(F.ws + WS_H); const bf16* ymix = (const bf16*)(F.ws + WS_YMIX);
    const float* WR = (const float*)(F.ws + WS_WR) + (size_t)l * 48 * D;
    unsigned* cnt = F.ctl + CW_CNT + l * 32 * 64;     int* list = (int*)(F.ws + WS_LIST); unsigned* route = (unsigned*)(F.ws + WS_ROUTE);
    bf16* const xres = (bf16*)(F.ws + WS_X);
    constexpr int HSP = 1028, RB = 2, BR = NWAVES * RB;
    LAS float* HS = (LAS float*)F.lds; LAS float* PS = (LAS float*)(F.lds + 100864); LAS float* LG = (LAS float*)(F.lds + 125440);
    LAS float* VEC = (LAS float*)(F.lds + 67584);
    {
        const float* const m0 = mod + (size_t)(l * 2 + 0) * 6144; const float* const m1 = mod + (size_t)(l * 2 + 1) * 6144;
        const float* const p0 = F.ln_g + (size_t)(l * 2 + 0) * D; const float* const p1 = F.ln_b + (size_t)(l * 2 + 0) * D;
        const float* const p2 = m0 + 2048; const float* const p3 = m0 + 4096; const float* const p4 = m0 + 3072; const float* const p5 = m1 + 2048; const float* const p6 = m1 + 4096; const float* const p7 = m1 + 3072;
        const bool hi = tid >= 256; const int e = (tid & 255) * 4;
        const f32x4 a = *(const f32x4*)((hi ? p1 : p0) + e), b = *(const f32x4*)((hi ? p3 : p2) + e), c = *(const f32x4*)((hi ? p5 : p4) + e), d = *(const f32x4*)((hi ? p7 : p6) + e);
        LAS float* dst = VEC + (hi ? 1024 : 0) + e;
        *(LAS f32x4*)(dst) = a; *(LAS f32x4*)(dst + 2048) = b; *(LAS f32x4*)(dst + 4096) = c; *(LAS f32x4*)(dst + 6144) = d;
        if (tid < 36) VEC[8192 + tid] = tid < 4 ? F.b_r1[l * 4 + tid] : F.b_r2[l * 32 + tid - 4];
    }
    f32x4 b4[8][3];
#pragma unroll
    for (int mi = 0; mi < 8; ++mi)
#pragma unroll
        for (int ct = 0; ct < 3; ++ct) b4[mi][ct] = *(const f32x4*)(WR + (size_t)(16 * ct + fr) * D + 16 * (8 * wave + mi) + 4 * fq);
    int pe = 0, prow0 = -1; unsigned pp0 = 0u, pp1 = 0u; float pw0 = 0.f, pw1 = 0.f;
    auto flush = [&]() { if (prow0 >= 0 && lane < RB) { const int prow = prow0 + lane, pe0 = pe & 255, pe1 = pe >> 8; list[pe0 * 16384 + (int)pp0] = prow; list[pe1 * 16384 + (int)pp1] = prow;
            *(v4u*)(route + (size_t)prow * 8) = (v4u){(unsigned)pe0, pp0, (unsigned)pe1, pp1}; *(v2u*)(route + (size_t)prow * 8 + 4) = (v2u){f2u(pw0), f2u(pw1)}; } prow0 = -1; };
    auto route_rows = [&](int r0) {
        if (lane < RB) {
            const LAS float* lg = LG + (wave * RB + lane) * 40;
            const float l10 = lg[0], l11 = lg[1], l12 = lg[2], l13 = lg[3];
            int gi = 0; float mx = l10;
            if (l11 > mx) { mx = l11; gi = 1; }
            if (l12 > mx) { mx = l12; gi = 2; }
            if (l13 > mx) { mx = l13; gi = 3; }
            const float pg = 1.f / (expf(l10 - mx) + expf(l11 - mx) + expf(l12 - mx) + expf(l13 - mx));
            int j0 = 0; float v0 = lg[4 + gi * 8];
            for (int j = 1; j < 8; ++j) { const float t = lg[4 + gi * 8 + j]; if (t > v0) { v0 = t; j0 = j; } }
            int j1 = -1; float v1 = -3.0e38f;
            for (int j = 0; j < 8; ++j) { const float t = lg[4 + gi * 8 + j]; if (j != j0 && t > v1) { v1 = t; j1 = j; } }
            const float ee = expf(v1 - v0);
            pw0 = pg / (1.f + ee); pw1 = pg * ee / (1.f + ee); const int pe0 = gi * 8 + j0, pe1 = gi * 8 + j1; pe = pe0 | (pe1 << 8);
            pp0 = __hip_atomic_fetch_add(cnt + pe0 * 64, DRY ? 0u : 1u, RLX_AGENT); pp1 = __hip_atomic_fetch_add(cnt + pe1 * 64, DRY ? 0u : 1u, RLX_AGENT);
        }
        prow0 = r0; };
    int lrow0 = -1;
    v2u xv[RB][4], yv[RB][4];
    auto request = [&](int r0) {
#pragma unroll
        for (int r = 0; r < RB; ++r)
#pragma unroll
            for (int j = 0; j < 4; ++j) { xv[r][j] = *(const v2u*)(xres + (size_t)(r0 + r) * D + 256 * j + 4 * lane); yv[r][j] = *(const v2u*)(ymix + (size_t)(r0 + r) * D + 256 * j + 4 * lane); } };
    int rowb = blockIdx.x * BR;
    if (rowb < M) request(rowb + wave * RB);
    __syncthreads();
    for (; rowb < M; rowb += F.G * BR) {
        const int row0 = rowb + wave * RB; const int b = row0 >> 13;
        const LAS float* vl = VEC + 4 * lane; const LAS float* vg1 = vl + (2 + 3 * b) * 1024;
        f32x4 h[RB][4];
#pragma unroll
        for (int j = 0; j < 4; ++j) { const f32x4 g1 = *(const LAS f32x4*)(vg1 + 256 * j);
#pragma unroll
            for (int r = 0; r < RB; ++r) { const v2u a = yv[r][j], x = xv[r][j]; h[r][j] = (f32x4){bflo(x.x), bfhi(x.x), bflo(x.y), bfhi(x.y)} * ALPHA + (1.f + g1) * (f32x4){bflo(a.x), bfhi(a.x), bflo(a.y), bfhi(a.y)}; } }
        { const int nb = rowb + F.G * BR; if (nb < M) request(nb + wave * RB); }
#pragma unroll
        for (int r = 0; r < RB; ++r) { float s = 0.f;
#pragma unroll
            for (int j = 0; j < 4; ++j) s += (h[r][j].x + h[r][j].y) + (h[r][j].z + h[r][j].w);
            const float mean = wave_sum(s) * (1.f / D); float q = 0.f;
#pragma unroll
            for (int j = 0; j < 4; ++j) { h[r][j] = h[r][j] - mean; q += (h[r][j].x * h[r][j].x + h[r][j].y * h[r][j].y) + (h[r][j].z * h[r][j].z + h[r][j].w * h[r][j].w); }
            const float rstd = 1.f / sqrtf(wave_sum(q) * (1.f / D) + LN_EPS);
#pragma unroll
            for (int j = 0; j < 4; ++j) h[r][j] = h[r][j] * rstd * *(const LAS f32x4*)(vl + 256 * j) + *(const LAS f32x4*)(vl + 1024 + 256 * j); }
#pragma unroll
        for (int r = 0; r < RB; ++r) {
            store_row_bf16(xres + (size_t)(row0 + r) * D, h[r], lane);
#pragma unroll
            for (int j = 0; j < 4; ++j) h[r][j] = h[r][j] * (1.f + *(const LAS f32x4*)(vg1 + 1024 + 256 * j)) + *(const LAS f32x4*)(vg1 + 2048 + 256 * j);
            store_row_bf16(H + (size_t)(row0 + r) * D, h[r], lane); }
#pragma unroll
        for (int r = 0; r < RB; ++r)
#pragma unroll
            for (int j = 0; j < 4; ++j) *(LAS f32x4*)(HS + (wave * RB + r) * HSP + 256 * j + 4 * lane) = h[r][j];
        __syncthreads();
        flush();
        if (lrow0 >= 0) route_rows(lrow0);
        f32x4 lacc[3];
#pragma unroll
        for (int ct = 0; ct < 3; ++ct) lacc[ct] = (f32x4){0.f, 0.f, 0.f, 0.f};
#pragma unroll
        for (int mi = 0; mi < 8; ++mi) { const f32x4 a0 = *(const LAS f32x4*)(HS + fr * HSP + 16 * (8 * wave + mi) + 4 * fq);
#pragma unroll
            for (int i = 0; i < 4; ++i)
#pragma unroll
                for (int ct = 0; ct < 3; ++ct) lacc[ct] = __builtin_amdgcn_mfma_f32_16x16x4f32(a0[i], b4[mi][ct][i], lacc[ct], 0, 0, 0); }
#pragma unroll
        for (int ct = 0; ct < 3; ++ct) *(LAS f32x4*)(PS + ((wave * 3 + ct) * 64 + lane) * 4) = lacc[ct];
        __syncthreads();
#pragma unroll
        for (int i = 0; i < 2; ++i) { const int idx = tid + 512 * i;
            if (idx < 768) { const int j = idx & 3, ln = (idx >> 2) & 63, ct = idx >> 8; const int off = (ct * 64 + ln) * 4 + j; float v = 0.f;
#pragma unroll
                for (int ks = 0; ks < 8; ++ks) v += PS[off + ks * 768];
                const int rowl = 4 * (ln >> 4) + j, col = 16 * ct + (ln & 15);
                if (col < 36) LG[rowl * 40 + col] = v + VEC[8192 + col]; } }
        lrow0 = row0;
    }
    __syncthreads();
    flush();
    if (lrow0 >= 0) route_rows(lrow0);
    flush();
}
template <int NR> __device__ __forceinline__ void gates_rows_lds(const f32x4 (&h)[NR][4], const LAS float* W, const float* bg, float* grow0, int lane) {
    float p[NR][8];
#pragma unroll
    for (int g = 0; g < 8; ++g) { f32x4 w[4];
#pragma unroll
        for (int j = 0; j < 4; ++j) w[j] = *(const LAS f32x4*)(W + g * D + 256 * j + 4 * lane);
#pragma unroll
        for (int r = 0; r < NR; ++r) { float s = 0.f;
#pragma unroll
            for (int j = 0; j < 4; ++j) s += (h[r][j].x * w[j].x + h[r][j].y * w[j].y) + (h[r][j].z * w[j].z + h[r][j].w * w[j].w);
            p[r][g] = wave_sum(s) + bg[g]; } }
    if (lane == 0) {
#pragma unroll
        for (int r = 0; r < NR; ++r) { *(f32x4*)(grow0 + r * 8) = (f32x4){p[r][0], p[r][1], p[r][2], p[r][3]}; *(f32x4*)(grow0 + r * 8 + 4) = (f32x4){p[r][4], p[r][5], p[r][6], p[r][7]}; } }
}
template <bool DRY> __device__ __forceinline__ void phase_r2(Frame& F, int l) {
    const int tid = opaque_tid(), lane = tid & 63, wave = __builtin_amdgcn_readfirstlane(tid >> 6), gw = blockIdx.x * NWAVES + wave, NGW = F.G * NWAVES;
    const float* mod = (const float*)(F.ws + WS_MOD); bf16* H = (bf16*)(F.ws + WS_H); const bf16* Y = (const bf16*)(F.ws + WS_Y);
    float* gates = (float*)(F.ws + WS_GATES); const float* WG = (const float*)(F.ws + WS_WG);
    const unsigned* route = (const unsigned*)(F.ws + WS_ROUTE);
    bf16* const xres = (bf16*)(F.ws + WS_X);
    constexpr int RB = 2;
    const bool has_next = l < DEPTH - 1, has_gates = l + 1 < NA;
    LAS float* VEC = (LAS float*)F.lds;
    LAS float* WGS = VEC + 8192;
    {
        const int ln = has_next ? l + 1 : l;
        const float* const m0 = mod + (size_t)(l * 2 + 0) * 6144; const float* const m1 = mod + (size_t)(l * 2 + 1) * 6144;
        const float* const n0 = mod + (size_t)(ln * 2 + 0) * 6144; const float* const n1 = mod + (size_t)(ln * 2 + 1) * 6144;
        const float* const p0 = F.ln_g + (size_t)(l * 2 + 1) * D; const float* const p1 = F.ln_b + (size_t)(l * 2 + 1) * D;
        const float* const p2 = m0 + 5120; const float* const p3 = m1 + 5120; const float* const p4 = n0 + 1024; const float* const p5 = n0; const float* const p6 = n1 + 1024; const float* const p7 = n1;
        const bool hi = tid >= 256; const int e = (tid & 255) * 4;
        const f32x4 a = *(const f32x4*)((hi ? p1 : p0) + e), b = *(const f32x4*)((hi ? p3 : p2) + e), c = *(const f32x4*)((hi ? p5 : p4) + e), d = *(const f32x4*)((hi ? p7 : p6) + e);
        LAS float* dst = VEC + (hi ? 1024 : 0) + e;
        *(LAS f32x4*)(dst) = a; *(LAS f32x4*)(dst + 2048) = b; *(LAS f32x4*)(dst + 4096) = c; *(LAS f32x4*)(dst + 6144) = d;
        if (has_gates) { const float* wn = WG + (size_t)(l + 1) * 8 * D + tid * 4;
#pragma unroll
            for (int k = 0; k < 4; ++k) *(LAS f32x4*)(WGS + tid * 4 + 2048 * k) = *(const f32x4*)(wn + 2048 * k); }
    }
    int excl;
    { const int cn = lane < 32 ? (int)__hip_atomic_load(F.ctl + CW_CNT + (l * 32 + lane) * 64, RLX_AGENT) : 0; const int nb = (cn + 255) >> 8; int inc = nb;
#pragma unroll
      for (int o = 1; o < 32; o <<= 1) { const int t = lane_up(inc, o, lane); if (lane >= o) inc += t; }
      excl = inc - nb; }
    __syncthreads();
    v4u q0 = (v4u){0u, 0u, 0u, 0u}; v2u q1 = (v2u){0u, 0u};
    auto load_route = [&](int rowa) { const size_t rr = (size_t)(rowa + (lane < RB ? lane : 0)) * 8; q0 = *(const v4u*)(route + rr); q1 = *(const v2u*)(route + rr + 4); };
    v2u xv[RB][4], ya[RB][4], yc[RB][4]; float w0[RB], w1[RB];
    auto request = [&](int rowa) {
        const unsigned q0x = q0.x, q0y = q0.y, q0z = q0.z, q0w = q0.w, q1x = q1.x, q1y = q1.y;
#pragma unroll
        for (int r = 0; r < RB; ++r) {
            const int e0 = __builtin_amdgcn_readlane((int)q0x, r), p0 = __builtin_amdgcn_readlane((int)q0y, r), e1 = __builtin_amdgcn_readlane((int)q0z, r), p1 = __builtin_amdgcn_readlane((int)q0w, r);
            w0[r] = u2f((unsigned)__builtin_amdgcn_readlane((int)q1x, r)); w1[r] = u2f((unsigned)__builtin_amdgcn_readlane((int)q1y, r));
            const int s0 = __builtin_amdgcn_readlane(excl, e0) * 256 + p0, s1 = __builtin_amdgcn_readlane(excl, e1) * 256 + p1;
#pragma unroll
            for (int j = 0; j < 4; ++j) { xv[r][j] = *(const v2u*)(xres + (size_t)(rowa + r) * D + 256 * j + 4 * lane);
                ya[r][j] = *(const v2u*)(Y + (size_t)s0 * D + 256 * j + 4 * lane); yc[r][j] = *(const v2u*)(Y + (size_t)s1 * D + 256 * j + 4 * lane); } } };
    const int step = NGW * RB;
    int row0 = gw * RB;
    if (row0 < M) { load_route(row0); request(row0); if (row0 + step < M) load_route(row0 + step); }
    const float* bg = F.a_b_gate + (has_gates ? (l + 1) * 8 : 0);
    for (; row0 < M; row0 += step) {
        const int b = row0 >> 13; const LAS float* vl = VEC + 4 * lane;
        f32x4 v[RB][4];
#pragma unroll
        for (int j = 0; j < 4; ++j) { const f32x4 g2 = *(const LAS f32x4*)(vl + (2 + b) * 1024 + 256 * j);
#pragma unroll
            for (int r = 0; r < RB; ++r) { const v2u a = ya[r][j], c = yc[r][j];
                const f32x4 y = (f32x4){bflo(a.x), bfhi(a.x), bflo(a.y), bfhi(a.y)} * w0[r] + (f32x4){bflo(c.x), bfhi(c.x), bflo(c.y), bfhi(c.y)} * w1[r];
                const v2u x = xv[r][j]; v[r][j] = (f32x4){bflo(x.x), bfhi(x.x), bflo(x.y), bfhi(x.y)} * ALPHA + (1.f + g2) * y; } }
        if (row0 + step < M) { request(row0 + step); if (row0 + 2 * step < M) load_route(row0 + 2 * step); }
#pragma unroll
        for (int r = 0; r < RB; ++r) { float s = 0.f;
#pragma unroll
            for (int j = 0; j < 4; ++j) s += (v[r][j].x + v[r][j].y) + (v[r][j].z + v[r][j].w);
            const float mean = wave_sum(s) * (1.f / D); float q = 0.f;
#pragma unroll
            for (int j = 0; j < 4; ++j) { v[r][j] = v[r][j] - mean; q += (v[r][j].x * v[r][j].x + v[r][j].y * v[r][j].y) + (v[r][j].z * v[r][j].z + v[r][j].w * v[r][j].w); }
            const float rstd = 1.f / sqrtf(wave_sum(q) * (1.f / D) + LN_EPS);
#pragma unroll
            for (int j = 0; j < 4; ++j) v[r][j] = v[r][j] * rstd * *(const LAS f32x4*)(vl + 256 * j) + *(const LAS f32x4*)(vl + 1024 + 256 * j); }
#pragma unroll
        for (int r = 0; r < RB; ++r) { const int row = row0 + r;
            if (l == DEPTH - 1) {
#pragma unroll
                for (int j = 0; j < 4; ++j) ST_NT((f32x4*)(F.out + (size_t)row * D + 256 * j + 4 * lane), v[r][j]); }
            else store_row_bf16(xres + (size_t)row * D, v[r], lane);
            if (has_next) {
#pragma unroll
                for (int j = 0; j < 4; ++j) v[r][j] = v[r][j] * (1.f + *(const LAS f32x4*)(vl + (4 + 2 * b) * 1024 + 256 * j)) + *(const LAS f32x4*)(vl + (5 + 2 * b) * 1024 + 256 * j);
                store_row_bf16(H + (size_t)row * D, v[r], lane);
            } }
        if (has_gates) gates_rows_lds<RB>(v, WGS, bg, gates + (size_t)row0 * 8, lane);
    }
}

typedef short bf16x8 __attribute__((ext_vector_type(8)));
#define MFMA16(a, b, c) __builtin_amdgcn_mfma_f32_16x16x32_bf16((a), (b), (c), 0, 0, 0)
constexpr int RS = 136;
template <bool MAXOP> __device__ __forceinline__ float block_scan256(float v, LAS float* scr, int lane, int wave) {
#pragma unroll
    for (int o = 1; o < 64; o <<= 1) { const float t = lane_up(v, o, lane); if (lane >= o) v = MAXOP ? fmaxf(v, t) : v + t; }
    if (lane == 63 && wave < 4) scr[wave] = v;
    __syncthreads();
    float add = MAXOP ? -3.0e38f : 0.f;
#pragma unroll
    for (int w = 0; w < 3; ++w) if (w < wave) add = MAXOP ? fmaxf(add, scr[w]) : add + scr[w];
    v = MAXOP ? fmaxf(v, add) : v + add;
    __syncthreads();
    return v;
}
__device__ __forceinline__ bf16x8 lds_frag16(const LAS bf16* p) { return __builtin_bit_cast(bf16x8, *(const LAS v4u*)p); }
template <int O0, int O1, int O2, int O3, int O4, int O5, int O6, int O7>
__device__ __forceinline__ void tr_read8(unsigned a, v2u& r0, v2u& r1, v2u& r2, v2u& r3, v2u& r4, v2u& r5, v2u& r6, v2u& r7) {
    asm volatile("ds_read_b64_tr_b16 %0, %8 offset:%9\n\tds_read_b64_tr_b16 %1, %8 offset:%10\n\tds_read_b64_tr_b16 %2, %8 offset:%11\n\tds_read_b64_tr_b16 %3, %8 offset:%12\n\t"
                 "ds_read_b64_tr_b16 %4, %8 offset:%13\n\tds_read_b64_tr_b16 %5, %8 offset:%14\n\tds_read_b64_tr_b16 %6, %8 offset:%15\n\tds_read_b64_tr_b16 %7, %8 offset:%16\n\t"
                 "s_waitcnt lgkmcnt(0)"
                 : "=&v"(r0), "=&v"(r1), "=&v"(r2), "=&v"(r3), "=&v"(r4), "=&v"(r5), "=&v"(r6), "=&v"(r7)
                 : "v"(a), "i"(O0), "i"(O1), "i"(O2), "i"(O3), "i"(O4), "i"(O5), "i"(O6), "i"(O7) : "memory");
}
__device__ __forceinline__ bf16x8 frag_lh(v2u lo, v2u hi) { return __builtin_bit_cast(bf16x8, (v4u){lo.x, lo.y, hi.x, hi.y}); }

__device__ __forceinline__ void ml_a(Frame& F) {
    const int tid = opaque_tid(), lane = tid & 63, wave = __builtin_amdgcn_readfirstlane(tid >> 6), fr = lane & 15, fq = lane >> 4;
    LAS unsigned char* KWb = F.lds;
    LAS unsigned char* VRb = F.lds + 18432;
    constexpr int KPB = 288, VPB = 544;
    const unsigned krd = (unsigned)(__UINTPTR_TYPE__)KWb + (4 * fq + (fr >> 2)) * KPB + (lane & 3) * 8;
    const unsigned vrd = (unsigned)(__UINTPTR_TYPE__)VRb + (4 * fq + (fr >> 2)) * VPB + (lane & 3) * 8 + wave * 64;
    const bf16x8 ones = __builtin_bit_cast(bf16x8, (v4u){0x3f803f80u, 0x3f803f80u, 0x3f803f80u, 0x3f803f80u});
    LAS float* wv = (LAS float*)(F.lds + 55296);
    LAS float* scr = (LAS float*)(F.lds + 56320);
    const bf16* proj = (const bf16*)(F.ws + WS_PROJ); const float* gates = (const float*)(F.ws + WS_GATES);
    float* Bv = (float*)(F.ws + WS_MLS); float* Mloc = Bv + 256; float* dn = (float*)(F.ws + WS_MLS + 65536); float* dC = (float*)(F.ws + WS_DC);
    for (int u = blockIdx.x; u < 256; u += F.G) {
        const int bh = u >> 5, c = u & 31, b = bh >> 2, h = bh & 3, t0 = b * SEQ + c * CH;
        v4u kreg[2], vreg[4];
        auto request = [&](int sb) { const bf16* rows = proj + (size_t)(t0 + sb * 64) * NPROJ;
#pragma unroll
            for (int i = 0; i < 2; ++i) { const int p = tid + 512 * i, s = p >> 4, part = p & 15; kreg[i] = *(const v4u*)(rows + (size_t)s * NPROJ + 512 + h * DQK + part * 8); }
#pragma unroll
            for (int i = 0; i < 4; ++i) { const int p = tid + 512 * i, s = p >> 5, part = p & 31; vreg[i] = *(const v4u*)(rows + (size_t)s * NPROJ + 1024 + h * DV + part * 8); } };
        request(0);
        float ip = 0.f, lf = 0.f;
        if (tid < 256) { ip = gates[(size_t)(t0 + tid) * 8 + h]; lf = logsigmoidf_(gates[(size_t)(t0 + tid) * 8 + 4 + h]); }
        const float bs = block_scan256<false>(lf, scr, lane, wave);
        const float as = tid < 256 ? ip - bs : -3.0e38f;
        const float wm = wave_max(as); if (lane == 0) scr[wave] = wm;
        __syncthreads();
        float mloc = scr[0];
#pragma unroll
        for (int w = 1; w < 8; ++w) mloc = fmaxf(mloc, scr[w]);
        if (tid < 256) wv[tid] = expf(as - mloc);
        if (tid == 255) { Bv[u] = bs; Mloc[u] = mloc; }
        f32x4 acc[2][8];
#pragma unroll
        for (int i = 0; i < 2; ++i)
#pragma unroll
            for (int j = 0; j < 8; ++j) acc[i][j] = (f32x4){0.f, 0.f, 0.f, 0.f};
        f32x4 dn4 = (f32x4){0.f, 0.f, 0.f, 0.f};
#pragma unroll 1
        for (int sb = 0; sb < 4; ++sb) {
            __syncthreads();
#pragma unroll
            for (int i = 0; i < 2; ++i) { const int p = tid + 512 * i, s = p >> 4, part = p & 15; v4u a = kreg[i]; const float w = wv[sb * 64 + s];
                a.x = pk2(bflo(a.x) * w, bfhi(a.x) * w); a.y = pk2(bflo(a.y) * w, bfhi(a.y) * w); a.z = pk2(bflo(a.z) * w, bfhi(a.z) * w); a.w = pk2(bflo(a.w) * w, bfhi(a.w) * w);
                *(LAS v4u*)(KWb + s * KPB + part * 16) = a; }
#pragma unroll
            for (int i = 0; i < 4; ++i) { const int p = tid + 512 * i, s = p >> 5, part = p & 31; *(LAS v4u*)(VRb + s * VPB + part * 16) = vreg[i]; }
            __syncthreads();
            if (sb < 3) request(sb + 1);
            v2u va[8];
            tr_read8<0, 16 * VPB, 32, 16 * VPB + 32, 32 * VPB, 48 * VPB, 32 * VPB + 32, 48 * VPB + 32>(vrd, va[0], va[1], va[2], va[3], va[4], va[5], va[6], va[7]);
#define ML_A_STEP(KS, HF) { v2u kb[8]; constexpr int KO = (KS) * 32 * KPB + (HF) * 128; \
                tr_read8<KO, KO + 16 * KPB, KO + 32, KO + 16 * KPB + 32, KO + 64, KO + 16 * KPB + 64, KO + 96, KO + 16 * KPB + 96>(krd, kb[0], kb[1], kb[2], kb[3], kb[4], kb[5], kb[6], kb[7]); \
                const bf16x8 a0 = frag_lh(va[4 * (KS)], va[4 * (KS) + 1]), a1 = frag_lh(va[4 * (KS) + 2], va[4 * (KS) + 3]); \
                _Pragma("unroll") for (int d4 = 0; d4 < 4; ++d4) { const int dt = 4 * (HF) + d4; const bf16x8 bb = frag_lh(kb[2 * d4], kb[2 * d4 + 1]); \
                    acc[0][dt] = MFMA16(a0, bb, acc[0][dt]); acc[1][dt] = MFMA16(a1, bb, acc[1][dt]); if (dt == wave) dn4 = MFMA16(ones, bb, dn4); } }
            ML_A_STEP(0, 0) ML_A_STEP(0, 1) ML_A_STEP(1, 0) ML_A_STEP(1, 1)
#undef ML_A_STEP
        }
        float* dCu = dC + (size_t)u * 32768;
#pragma unroll
        for (int i = 0; i < 2; ++i) { float* const bp = dCu + (size_t)((32 * wave + 16 * i + 4 * fq) * 128 + fr);
#pragma unroll
            for (int dt = 0; dt < 8; ++dt)
#pragma unroll
                for (int j = 0; j < 4; ++j) bp[j * 128 + 16 * dt] = acc[i][dt][j]; }
        if (fq == 0) dn[u * 128 + 16 * wave + fr] = dn4[0];
        __syncthreads();
    }
}
__device__ __forceinline__ void ml_scan(Frame& F) {
    const int tid = opaque_tid(), lane = tid & 63; (void)lane;
    const float* Bv = (const float*)(F.ws + WS_MLS); const float* Mloc = Bv + 256; float* Min = (float*)(F.ws + WS_MLS) + 512;
    const float* dn = (const float*)(F.ws + WS_MLS + 65536); float* nin = (float*)(F.ws + WS_MLS + 262144);
    const float* dC = (const float*)(F.ws + WS_DC); unsigned* CinT = (unsigned*)(F.ws + WS_CIN);
    LAS float* sB = (LAS float*)F.lds; LAS float* sM = sB + 32; LAS float* f1 = sB + 64; LAS float* f2 = sB + 96; LAS float* ms = sB + 128;
    for (int it0 = blockIdx.x * (NWAVES * 64); it0 < 8 * 16384; it0 += F.G * NWAVES * 64) {
        const int bh = it0 >> 14, e2 = (it0 & 16383) + tid;
        f32x2 d[NCH];
#pragma unroll
        for (int c = 0; c < NCH; ++c) d[c] = *(const f32x2*)(dC + (size_t)(bh * NCH + c) * 32768 + 2 * e2);
        __syncthreads();
        if (tid < NCH) { sB[tid] = Bv[bh * NCH + tid]; sM[tid] = Mloc[bh * NCH + tid]; }
        __syncthreads();
        if (tid == 0) { float m = 0.f;
            for (int c = 0; c < NCH; ++c) { const float ml = sM[c], mm = fmaxf(m, ml); ms[c] = m; f1[c] = expf(m - mm); f2[c] = expf(ml - mm); m = sB[c] + mm; } }
        __syncthreads();
        f32x2 C = (f32x2){0.f, 0.f};
#pragma unroll
        for (int c = 0; c < NCH; ++c) { CinT[(size_t)(bh * NCH + c) * 16384 + e2] = pk2(C.x, C.y); C = C * f1[c] + d[c] * f2[c]; }
        if ((it0 & 16383) == 0) {
            if (tid < 128) { float n = 0.f;
                for (int c = 0; c < NCH; ++c) { nin[(bh * NCH + c) * 128 + tid] = n; n = n * f1[c] + dn[(bh * NCH + c) * 128 + tid] * f2[c]; } }
            if (tid < NCH) Min[bh * NCH + tid] = ms[tid];
        }
    }
}
__device__ __forceinline__ void ml_c(Frame& F, int l) {
    const int tid = opaque_tid(), lane = tid & 63, wave = __builtin_amdgcn_readfirstlane(tid >> 6), fr = lane & 15, fq = lane >> 4;
    LAS bf16* CT = (LAS bf16*)(F.lds);
    LAS bf16* KB = (LAS bf16*)(F.lds + 69632);
    LAS unsigned char* VRb = F.lds + 87040;
    constexpr int VPB = 544;
    LAS float* eav = (LAS float*)(F.lds + 123904);
    LAS float* etv = eav + 256;
    LAS float* iwv = eav + 512;
    LAS float* thv = eav + 768;
    LAS bf16* NB = (LAS bf16*)(F.lds + 128000);
    LAS float* scr = (LAS float*)(F.lds + 128256);
    const bf16* proj = (const bf16*)(F.ws + WS_PROJ); const float* gates = (const float*)(F.ws + WS_GATES);
    const float* Min = (const float*)(F.ws + WS_MLS) + 512; const float* nin = (const float*)(F.ws + WS_MLS + 262144); const bf16* CinT = (const bf16*)(F.ws + WS_CIN);
    bf16* YA = (bf16*)(F.ws + WS_YA);
    const bf16x8 ones = __builtin_bit_cast(bf16x8, (v4u){0x3f803f80u, 0x3f803f80u, 0x3f803f80u, 0x3f803f80u});
    for (int u = blockIdx.x; u < 256; u += F.G) {
        const int bh = u >> 5, c = u & 31, b = bh >> 2, h = bh & 3, t0 = b * SEQ + c * CH;
        v4u cin[8];
        { const bf16* src = CinT + (size_t)u * 32768;
#pragma unroll
          for (int i = 0; i < 8; ++i) { const int p = tid + 512 * i, v = p >> 4, part = p & 15; cin[i] = *(const v4u*)(src + v * 128 + part * 8); } }
        float ip = 0.f, lf = 0.f;
        if (tid < 256) { ip = gates[(size_t)(t0 + tid) * 8 + h]; lf = logsigmoidf_(gates[(size_t)(t0 + tid) * 8 + 4 + h]); }
        const float bs = block_scan256<false>(lf, scr, lane, wave);
        const float as = tid < 256 ? ip - bs : -3.0e38f;
        const float pm = block_scan256<true>(as, scr, lane, wave);
        const float wm = wave_max(as); if (lane == 0) scr[wave] = wm;
        __syncthreads();
        float mloc = scr[0];
#pragma unroll
        for (int w = 1; w < 8; ++w) mloc = fmaxf(mloc, scr[w]);
        const float m_in = Min[u];
        if (tid < 256) { const float mt = bs + fmaxf(m_in, pm); eav[tid] = expf(as - mloc); etv[tid] = expf(bs + mloc - mt); iwv[tid] = expf(bs + m_in - mt); thv[tid] = expf(-mt); }
        if (tid < 64) { const f32x2 n2 = *(const f32x2*)(nin + u * 128 + 2 * tid); ((LAS unsigned*)NB)[tid] = pk2(n2.x, n2.y); }
#pragma unroll
        for (int i = 0; i < 8; ++i) { const int p = tid + 512 * i, v = p >> 4, part = p & 15; *(LAS v4u*)(CT + v * RS + part * 8) = cin[i]; }
        __syncthreads();
#pragma unroll 1
        for (int pass = 0; pass < 2; ++pass) {
            const int tt = pass == 0 ? 15 - wave : wave, nsb = pass == 0 ? 4 : 2;
            const int tmax = 16 * tt + 15, tq = 16 * tt + fr; const size_t row = (size_t)(t0 + tq);
            bf16x8 qf[4];
#pragma unroll
            for (int ks = 0; ks < 4; ++ks) qf[ks] = __builtin_bit_cast(bf16x8, *(const v4u*)(proj + row * NPROJ + h * DQK + 32 * ks + 8 * fq));
            f32x4 acc[17];
#pragma unroll
            for (int vt = 0; vt < 17; ++vt) acc[vt] = (f32x4){0.f, 0.f, 0.f, 0.f};
#pragma unroll
            for (int ks = 0; ks < 4; ++ks) {
#pragma unroll
                for (int vt = 0; vt < 16; ++vt) { acc[vt] = MFMA16(lds_frag16(CT + (16 * vt + fr) * RS + 32 * ks + 8 * fq), qf[ks], acc[vt]);
                    if ((vt & 3) == 3) __builtin_amdgcn_sched_barrier(0); }
                acc[16] = MFMA16(lds_frag16(NB + 32 * ks + 8 * fq), qf[ks], acc[16]);
            }
            { const float iw = iwv[tq];
#pragma unroll
              for (int vt = 0; vt < 17; ++vt) acc[vt] *= iw; }
            const float et = etv[tq];
            v4u kreg[2], vreg[4];
            auto request = [&](int sb) { const bf16* rows = proj + (size_t)(t0 + sb * 64) * NPROJ;
#pragma unroll
                for (int i = 0; i < 2; ++i) { const int p = tid + 512 * i, s = p >> 4, part = p & 15; kreg[i] = *(const v4u*)(rows + (size_t)s * NPROJ + 512 + h * DQK + part * 8); }
#pragma unroll
                for (int i = 0; i < 4; ++i) { const int p = tid + 512 * i, s = p >> 5, part = p & 31; vreg[i] = *(const v4u*)(rows + (size_t)s * NPROJ + 1024 + h * DV + part * 8); } };
            request(0);
#pragma unroll 1
            for (int sb = 0; sb < nsb; ++sb) {
                __syncthreads();
#pragma unroll
                for (int i = 0; i < 2; ++i) { const int p = tid + 512 * i, s = p >> 4, part = p & 15; *(LAS v4u*)(KB + s * RS + part * 8) = kreg[i]; }
#pragma unroll
                for (int i = 0; i < 4; ++i) { const int p = tid + 512 * i, s = p >> 5, part = p & 31; *(LAS v4u*)(VRb + s * VPB + part * 16) = vreg[i]; }
                __syncthreads();
                if (sb + 1 < nsb) request(sb + 1);
#pragma unroll
                for (int sp = 0; sp < 2; ++sp) {
                    const int s0 = sb * 64 + 32 * sp;
                    if (s0 <= tmax) {
                        f32x4 sa = (f32x4){0.f, 0.f, 0.f, 0.f}, sc = (f32x4){0.f, 0.f, 0.f, 0.f};
#pragma unroll
                        for (int ks = 0; ks < 4; ++ks) { sa = MFMA16(lds_frag16(KB + (32 * sp + fr) * RS + 32 * ks + 8 * fq), qf[ks], sa);
                                                         sc = MFMA16(lds_frag16(KB + (32 * sp + 16 + fr) * RS + 32 * ks + 8 * fq), qf[ks], sc); }
                        float p[8];
#pragma unroll
                        for (int j = 0; j < 4; ++j) { const int sA = s0 + 4 * fq + j, sB = sA + 16;
                            p[j] = sA <= tq ? sa[j] * eav[sA] * et : 0.f; p[4 + j] = sB <= tq ? sc[j] * eav[sB] * et : 0.f; }
                        const bf16x8 pf = __builtin_bit_cast(bf16x8, (v4u){pk2(p[0], p[1]), pk2(p[2], p[3]), pk2(p[4], p[5]), pk2(p[6], p[7])});
                        const unsigned va = (unsigned)(__UINTPTR_TYPE__)VRb + (32 * sp + 4 * fq + (fr >> 2)) * VPB + (lane & 3) * 8;
#define ML_C_PV4(G) { v2u l0, h0, l1, h1, l2, h2, l3, h3; constexpr int VO = 128 * (G); \
                        tr_read8<VO, VO + 16 * VPB, VO + 32, VO + 16 * VPB + 32, VO + 64, VO + 16 * VPB + 64, VO + 96, VO + 16 * VPB + 96>(va, l0, h0, l1, h1, l2, h2, l3, h3); \
                        acc[4 * (G)] = MFMA16(frag_lh(l0, h0), pf, acc[4 * (G)]); acc[4 * (G) + 1] = MFMA16(frag_lh(l1, h1), pf, acc[4 * (G) + 1]); \
                        acc[4 * (G) + 2] = MFMA16(frag_lh(l2, h2), pf, acc[4 * (G) + 2]); acc[4 * (G) + 3] = MFMA16(frag_lh(l3, h3), pf, acc[4 * (G) + 3]); __builtin_amdgcn_sched_barrier(0); }
                        ML_C_PV4(0) ML_C_PV4(1) ML_C_PV4(2) ML_C_PV4(3)
#undef ML_C_PV4
                        acc[16] = MFMA16(ones, pf, acc[16]);
                    }
                }
            }
            v2u ogr[16];
#pragma unroll
            for (int vt = 0; vt < 16; ++vt) ogr[vt] = *(const v2u*)(proj + row * NPROJ + 2048 + h * DV + 4 * fq + 16 * vt);
            const float dnm = 1.f / fmaxf(fabsf(acc[16][0]), thv[tq]);
            float s1 = 0.f;
#pragma unroll
            for (int vt = 0; vt < 16; ++vt) { acc[vt] *= dnm; s1 += (acc[vt][0] + acc[vt][1]) + (acc[vt][2] + acc[vt][3]); }
            s1 += lane_xor(s1, 16, lane); s1 += lane_xor(s1, 32, lane);
            const float mean = s1 * (1.f / DV); float s2 = 0.f;
#pragma unroll
            for (int vt = 0; vt < 16; ++vt) { acc[vt] -= mean; s2 += (acc[vt][0] * acc[vt][0] + acc[vt][1] * acc[vt][1]) + (acc[vt][2] * acc[vt][2] + acc[vt][3] * acc[vt][3]); }
            s2 += lane_xor(s2, 16, lane); s2 += lane_xor(s2, 32, lane);
            const float rstd = 1.f / sqrtf(s2 * (1.f / DV) + A_NORM_EPS);
            const float* ng = F.a_norm_g + l * 1024 + h * DV + 4 * fq; bf16* yp = YA + row * D + h * DV + 4 * fq;
#pragma unroll
            for (int vt = 0; vt < 16; ++vt) { const v2u og = ogr[vt]; const f32x4 g = *(const f32x4*)(ng + 16 * vt);
                const float y0 = acc[vt][0] * rstd * g.x * sigmoidf_(bflo(og.x)), y1 = acc[vt][1] * rstd * g.y * sigmoidf_(bfhi(og.x)),
                            y2 = acc[vt][2] * rstd * g.z * sigmoidf_(bflo(og.y)), y3 = acc[vt][3] * rstd * g.w * sigmoidf_(bfhi(og.y));
                *(v2u*)(yp + 16 * vt) = (v2u){pk2(y0, y1), pk2(y2, y3)}; }
        }
        __syncthreads();
    }
}

__device__ __forceinline__ void att_mfma(Frame& F) {
    const int tid = opaque_tid(), lane = tid & 63, wave = __builtin_amdgcn_readfirstlane(tid >> 6), fr = lane & 15, fq = lane >> 4;
    constexpr int NK = 384, KP = 72, VPB = 160;
    LAS bf16* Ks = (LAS bf16*)(F.lds); LAS unsigned char* Vs = F.lds + NK * KP * 2;
    const bf16* Q = (const bf16*)(F.ws + WS_Q); const bf16* KV = (const bf16*)(F.ws + WS_KV);
    bf16* OG = (bf16*)(F.ws + WS_OG); float* LSE = (float*)(F.ws + WS_LSE);
    const bf16x8 ones = __builtin_bit_cast(bf16x8, (v4u){0x3f803f80u, 0x3f803f80u, 0x3f803f80u, 0x3f803f80u});
    constexpr int NU = 1536;
    const unsigned vrd = (unsigned)(__UINTPTR_TYPE__)Vs + (4 * fq + (fr >> 2)) * VPB + (lane & 3) * 8;
    auto decode = [&](int u, int& g, int& b, int& h, int& r, int& rho, int& n2) { g = u >> 9; const int rem = u & 511; b = rem >> 8; h = (rem >> 5) & 7; const int rn = rem & 31;
        r = g == 0 ? 1 : (g == 1 ? 4 : 16); const int nb2 = 32 / r; rho = rn / nb2; n2 = rn % nb2; };
    v4u kreg[6], vreg[6]; bf16x8 qf[2][2];
    auto request = [&](int u) { int g, b, h, r, rho, n2; decode(u, g, b, h, r, rho, n2);
        const bf16* kvb = KV + (size_t)b * SEQ * NKV + g * 512 + h * 64;
#pragma unroll
        for (int i = 0; i < 6; ++i) { const int p = tid + 512 * i, kj = p >> 3, part = p & 7; const int isub = (2 * n2 - 1) * 128 + kj;
            kreg[i] = (v4u){0u, 0u, 0u, 0u}; vreg[i] = (v4u){0u, 0u, 0u, 0u};
            if (isub >= 0) { const bf16* kr = kvb + ((size_t)isub * r + rho) * NKV + part * 8; kreg[i] = *(const v4u*)kr; vreg[i] = *(const v4u*)(kr + 1536); } }
#pragma unroll
        for (int i = 0; i < 2; ++i) { const size_t tq = (size_t)b * SEQ + (size_t)(n2 * 256 + 16 * (wave + 8 * i) + fr) * r + rho;
#pragma unroll
            for (int ks = 0; ks < 2; ++ks) qf[i][ks] = __builtin_bit_cast(bf16x8, *(const v4u*)(Q + tq * NQ + g * 512 + h * 64 + 32 * ks + 8 * fq)); } };
    const int ustep = (F.G % 8 == 0) ? F.G / 8 : F.G; const int ubase = (F.G % 8 == 0) ? (int)(blockIdx.x % 8) * (NU / 8) : 0, uend = (F.G % 8 == 0) ? ubase + NU / 8 : NU;
    int u = ubase + ((F.G % 8 == 0) ? (int)(blockIdx.x / 8) : (int)blockIdx.x);
    if (u < uend) request(u);
    for (; u < uend; u += ustep) {
        int g, b, h, r, rho, n2; decode(u, g, b, h, r, rho, n2);
        __syncthreads();
#pragma unroll
        for (int i = 0; i < 6; ++i) { const int p = tid + 512 * i, kj = p >> 3, part = p & 7; *(LAS v4u*)(Ks + kj * KP + part * 8) = kreg[i]; *(LAS v4u*)(Vs + kj * VPB + part * 16) = vreg[i]; }
        bf16x8 q[2][2];
#pragma unroll
        for (int i = 0; i < 2; ++i) { q[i][0] = qf[i][0]; q[i][1] = qf[i][1]; }
        __syncthreads();
        if (u + ustep < uend) request(u + ustep);
#pragma unroll
        for (int i = 0; i < 2; ++i) {
            const int tt = wave + 8 * i, qi = 16 * tt + fr;
            const size_t tokq = (size_t)b * SEQ + (size_t)(n2 * 256 + qi) * r + rho;
            const int pi0 = tt >> 1;
            f32x4 sc[5][2];
#pragma unroll
            for (int pi = 0; pi < 5; ++pi)
#pragma unroll
                for (int st = 0; st < 2; ++st) { const int tile = 2 * (pi0 + pi) + st; f32x4 a = (f32x4){0.f, 0.f, 0.f, 0.f};
                    a = MFMA16(lds_frag16(Ks + (16 * tile + fr) * KP + 8 * fq), q[i][0], a); a = MFMA16(lds_frag16(Ks + (16 * tile + fr) * KP + 32 + 8 * fq), q[i][1], a);
                    sc[pi][st] = a; }
            const float NEG = -__builtin_inff();
#pragma unroll
            for (int st = 0; st < 2; ++st)
#pragma unroll
                for (int j = 0; j < 4; ++j) { const int k0 = 32 * pi0 + 16 * st + 4 * fq + j; sc[0][st][j] = k0 >= qi ? sc[0][st][j] : NEG; sc[4][st][j] = k0 + 128 <= qi + 128 ? sc[4][st][j] : NEG; }
            if (n2 == 0) {
#pragma unroll
                for (int pi = 0; pi < 5; ++pi)
#pragma unroll
                    for (int st = 0; st < 2; ++st)
#pragma unroll
                        for (int j = 0; j < 4; ++j) { const int kj = 32 * (pi0 + pi) + 16 * st + 4 * fq + j; sc[pi][st][j] = kj >= 128 ? sc[pi][st][j] : NEG; }
            }
            float mx = NEG;
#pragma unroll
            for (int pi = 0; pi < 5; ++pi)
#pragma unroll
                for (int st = 0; st < 2; ++st)
#pragma unroll
                    for (int j = 0; j < 4; ++j) mx = fmaxf(mx, sc[pi][st][j]);
            mx = fmaxf(mx, lane_xor(mx, 16, lane)); mx = fmaxf(mx, lane_xor(mx, 32, lane));
            f32x4 acc[4], den = (f32x4){0.f, 0.f, 0.f, 0.f};
#pragma unroll
            for (int vt = 0; vt < 4; ++vt) acc[vt] = (f32x4){0.f, 0.f, 0.f, 0.f};
#pragma unroll
            for (int pi = 0; pi < 5; ++pi) { float p[8];
#pragma unroll
                for (int j = 0; j < 4; ++j) { p[j] = __builtin_amdgcn_exp2f(sc[pi][0][j] - mx); p[4 + j] = __builtin_amdgcn_exp2f(sc[pi][1][j] - mx); }
                const bf16x8 pf = __builtin_bit_cast(bf16x8, (v4u){pk2(p[0], p[1]), pk2(p[2], p[3]), pk2(p[4], p[5]), pk2(p[6], p[7])});
                { v2u l0, h0, l1, h1, l2, h2, l3, h3;
                  tr_read8<0, 16 * VPB, 32, 16 * VPB + 32, 64, 16 * VPB + 64, 96, 16 * VPB + 96>(vrd + 32 * (pi0 + pi) * VPB, l0, h0, l1, h1, l2, h2, l3, h3);
                  acc[0] = MFMA16(frag_lh(l0, h0), pf, acc[0]); acc[1] = MFMA16(frag_lh(l1, h1), pf, acc[1]); acc[2] = MFMA16(frag_lh(l2, h2), pf, acc[2]); acc[3] = MFMA16(frag_lh(l3, h3), pf, acc[3]); }
                den = MFMA16(ones, pf, den); }
            const float lsum = den[0], inv = 1.f / lsum;
            bf16* op = OG + ((size_t)g * M + tokq) * BW + h * 64 + 4 * fq;
#pragma unroll
            for (int vt = 0; vt < 4; ++vt) *(v2u*)(op + 16 * vt) = (v2u){pk2(acc[vt][0] * inv, acc[vt][1] * inv), pk2(acc[vt][2] * inv, acc[vt][3] * inv)};
            if (fq == 0) LSE[((size_t)g * M + tokq) * 8 + h] = (mx + __builtin_amdgcn_logf(lsum)) * 0.6931471805599453f;
        }
    }
}
__device__ __forceinline__ void att_combine(Frame& F) {
    const int gt = blockIdx.x * (NWAVES * 64) + opaque_tid(), NGT = F.G * NWAVES * 64;
    const bf16* OG = (const bf16*)(F.ws + WS_OG); const float* LSE = (const float*)(F.ws + WS_LSE); bf16* YA = (bf16*)(F.ws + WS_YA);
    for (int it = gt; it < M * 64; it += NGT) {
        const int tok = it >> 6, h = (it >> 3) & 7, pc = it & 7;
        const float l0 = LSE[(size_t)tok * 8 + h], l1 = LSE[((size_t)M + tok) * 8 + h], l2 = LSE[((size_t)2 * M + tok) * 8 + h];
        const float mx = fmaxf(l0, fmaxf(l1, l2)); float w0 = expf(l0 - mx), w1 = expf(l1 - mx), w2 = expf(l2 - mx); const float inv = 1.f / (w0 + w1 + w2); w0 *= inv; w1 *= inv; w2 *= inv;
        const size_t off = (size_t)tok * BW + h * 64 + pc * 8;
        const v4u a = *(const v4u*)(OG + off), c = *(const v4u*)(OG + (size_t)M * BW + off), d = *(const v4u*)(OG + (size_t)2 * M * BW + off);
        v4u o;
        o.x = pk2(w0 * bflo(a.x) + w1 * bflo(c.x) + w2 * bflo(d.x), w0 * bfhi(a.x) + w1 * bfhi(c.x) + w2 * bfhi(d.x));
        o.y = pk2(w0 * bflo(a.y) + w1 * bflo(c.y) + w2 * bflo(d.y), w0 * bfhi(a.y) + w1 * bfhi(c.y) + w2 * bfhi(d.y));
        o.z = pk2(w0 * bflo(a.z) + w1 * bflo(c.z) + w2 * bflo(d.z), w0 * bfhi(a.z) + w1 * bfhi(c.z) + w2 * bfhi(d.z));
        o.w = pk2(w0 * bflo(a.w) + w1 * bflo(c.w) + w2 * bflo(d.w), w0 * bfhi(a.w) + w1 * bfhi(c.w) + w2 * bfhi(d.w));
        __builtin_nontemporal_store(o, (v4u*)(YA + off));
    }
}

constexpr int NPHASE = 2 + 9 * DEPTH;
struct Args { const void* in[21]; float* out; unsigned char* ws; int ph_lo, ph_hi; };
__device__ __forceinline__ void moe_table(Frame& F, int l) {
    LAS int* tab = (LAS int*)(F.lds + LDSCTL_OFF + 64);
    const int tid = opaque_tid();
    if (tid < 64) { const int lane = tid & 63; const int cn = lane < 32 ? (int)__hip_atomic_load(F.ctl + CW_CNT + (l * 32 + lane) * 64, RLX_AGENT) : 0; const int nb = (cn + 255) >> 8; int inc = nb;
#pragma unroll
        for (int o = 1; o < 32; o <<= 1) { const int t = lane_up(inc, o, lane); if (lane >= o) inc += t; }
        if (lane < 32) { tab[lane] = inc - nb; tab[33 + lane] = cn; } if (lane == 31) tab[32] = inc; }
    __syncthreads();
}
__global__ void __launch_bounds__(NWAVES * 64, 2) fwd(Args args) {
    extern __shared__ __attribute__((aligned(16))) unsigned char lds[];
    Frame F;
    F.lds = (LAS unsigned char*)lds; F.ws = args.ws; F.ctl = (unsigned*)(args.ws + WS_CTL);
    F.wave = __builtin_amdgcn_readfirstlane((int)threadIdx.x >> 6); asm volatile("" : "+s"(F.wave)); F.tid = hw_tid(F.wave); F.lane = F.tid & 63; F.G = gridDim.x;
    F.x = (const float*)args.in[0]; F.c = (const float*)args.in[1]; F.pos = (const int*)args.in[2]; F.ada_w = (const float*)args.in[3]; F.ada_b = (const float*)args.in[4];
    F.ln_g = (const float*)args.in[5]; F.ln_b = (const float*)args.in[6]; F.a_w_in = (const float*)args.in[7]; F.a_b_gate = (const float*)args.in[8]; F.a_norm_g = (const float*)args.in[9];
    F.a_w_out = (const float*)args.in[10]; F.b_w_kv = (const float*)args.in[11]; F.b_w_q = (const float*)args.in[12]; F.b_w_o = (const float*)args.in[13];
    F.w_r1 = (const float*)args.in[14]; F.b_r1 = (const float*)args.in[15]; F.w_r2 = (const float*)args.in[16]; F.b_r2 = (const float*)args.in[17];
    F.w_gate = (const float*)args.in[18]; F.w_up = (const float*)args.in[19]; F.w_down = (const float*)args.in[20]; F.out = args.out;
    for (int u = F.tid; u < (LDS_BYTES - LDSCTL_OFF) / 4; u += NWAVES * 64) ((LAS unsigned*)(F.lds + LDSCTL_OFF))[u] = 0u;
    __syncthreads();
    const int lo = args.ph_lo, hi = args.ph_hi;
    XcdBarrier bar; bar.bar = F.ctl + CW_BAR; bar.x = 0; bar.st = nullptr; bar.w = F.wave;
    if (hi - lo > 1) bar = xcd_barrier_post(F.ctl + CW_BAR, (volatile LAS unsigned*)(F.lds + LDSCTL_OFF), F.wave);
#define IN(k) (lo <= (k) && (k) < hi)
#define SEAM(k) do { if ((k) + 1 < hi) xcd_barrier(bar); } while (0)
    const int c0 = (int)blockIdx.x;
    const int vcu = (F.G % 8 == 0) ? (int)(blockIdx.x % 8) * (F.G / 8) + (int)(blockIdx.x / 8) : (int)blockIdx.x;

    if (IN(0)) { pro_a(F); SEAM(0); }
    if (IN(1)) { pro_b(F); SEAM(1); }
    for (int l = 0; l < DEPTH; ++l) {
        const int pb = 2 + 9 * l;
        if (l < NA) {
            if (IN(pb + 0)) {
                pg8::Gemm g{(const bf16*)(F.ws + WS_H), (const bf16*)(F.ws + WS_WIN) + (size_t)l * NPROJ * D, M, NPROJ, D}; pg8::StaticOrder S; S.init(M, NPROJ, F.G, c0);
                pg8::EpiBf16S E{(bf16*)(F.ws + WS_PROJ), NPROJ, 2, 4, 0.08838834764831845f};
                pg8::gemm_phase<pg8::EpiBf16S, pg8::StaticOrder, true>(F.lds, g, S, E, F.wave);
                SEAM(pb + 0);
            }
            if (IN(pb + 1)) { ml_a(F); SEAM(pb + 1); }
            if (IN(pb + 2)) { ml_scan(F); SEAM(pb + 2); }
            if (IN(pb + 3)) { ml_c(F, l); SEAM(pb + 3); }
            if (IN(pb + 4)) {
                pg8::Gemm g{(const bf16*)(F.ws + WS_YA), (const bf16*)(F.ws + WS_WOUT) + (size_t)l * D * D, M, D, D}; pg8::StaticOrder S; S.init(M, D, F.G, c0);
                pg8::EpiBf16S E{(bf16*)(F.ws + WS_YMIX), D, 0, 0, 1.f};
                pg8::gemm_phase<pg8::EpiBf16S, pg8::StaticOrder, false>(F.lds, g, S, E, F.wave);
                SEAM(pb + 4);
            }
        } else {
            if (IN(pb + 0)) {
                if (l == NA) {
                    pg8::Gemm g{(const bf16*)(F.ws + WS_X), (const bf16*)(F.ws + WS_WKV), M, NKV, D}; pg8::StaticOrder S; S.init(M, NKV, F.G, c0);
                    pg8::EpiRope E{(bf16*)(F.ws + WS_KV), NKV, 6, (const float*)(F.ws + WS_ROPE), 1.0f};
                    pg8::gemm_phase<pg8::EpiRope, pg8::StaticOrder, true>(F.lds, g, S, E, F.wave);
                }
                {
                    pg8::Gemm g{(const bf16*)(F.ws + WS_H), (const bf16*)(F.ws + WS_WQ) + (size_t)(l - NA) * NQ * D, M, NQ, D}; pg8::StaticOrder S; S.init(M, NQ, F.G, c0);
                    pg8::EpiRope E{(bf16*)(F.ws + WS_Q), NQ, 6, (const float*)(F.ws + WS_ROPE), 0.125f * 1.4426950408889634f};
                    pg8::gemm_phase<pg8::EpiRope, pg8::StaticOrder, true>(F.lds, g, S, E, F.wave);
                }
                SEAM(pb + 0);
            }
            if (IN(pb + 1)) { att_mfma(F); SEAM(pb + 1); }
            if (IN(pb + 2)) { att_combine(F); SEAM(pb + 2); }
            if (IN(pb + 4)) {
                pg8::Gemm g{(const bf16*)(F.ws + WS_YA), (const bf16*)(F.ws + WS_WO) + (size_t)(l - NA) * D * BW, M, D, BW}; pg8::StaticOrder S; S.init(M, D, F.G, c0);
                pg8::EpiBf16S E{(bf16*)(F.ws + WS_YMIX), D, 0, 0, 1.f};
                pg8::gemm_phase<pg8::EpiBf16S, pg8::StaticOrder, false>(F.lds, g, S, E, F.wave);
                SEAM(pb + 4);
            }
        }
        if (IN(pb + 5)) { phase_r1<false>(F, l); SEAM(pb + 5); }
        if (IN(pb + 6)) {
            moe_table(F, l);
            pg8::Gemm g{(const bf16*)(F.ws + WS_H), nullptr, 0, 512, D};
            pg8::MoeOrder S{(const LAS int*)(F.lds + LDSCTL_OFF + 64), (const int*)(F.ws + WS_LIST), (const bf16*)(F.ws + WS_WGU) + (size_t)l * NE * 512 * D, (size_t)512 * D, 2, F.G, vcu, 1};
            pg8::EpiGU E{(bf16*)(F.ws + WS_ACT)};
            pg8::gemm_phase<pg8::EpiGU, pg8::MoeOrder, true>(F.lds, g, S, E, F.wave);
            if (l + 1 < DEPTH) { __syncthreads(); tail_fill<4>(F, l + 1, ((const LAS int*)(F.lds + LDSCTL_OFF + 64))[32] * 2, vcu); }
            SEAM(pb + 6);
        }
        if (IN(pb + 7)) {
            if (!IN(pb + 6)) moe_table(F, l);
            pg8::Gemm g{(const bf16*)(F.ws + WS_ACT), nullptr, 0, D, MH};
            pg8::MoeOrder S{(const LAS int*)(F.lds + LDSCTL_OFF + 64), (const int*)(F.ws + WS_LIST), (const bf16*)(F.ws + WS_WD) + (size_t)l * NE * D * MH, (size_t)D * MH, 4, F.G, vcu, 0};
            pg8::EpiBf16S E{(bf16*)(F.ws + WS_Y), D, 0, 0, 1.f};
            pg8::gemm_phase<pg8::EpiBf16S, pg8::MoeOrder, true>(F.lds, g, S, E, F.wave);
            if (l + 1 < DEPTH) { __syncthreads(); const int tu = ((const LAS int*)(F.lds + LDSCTL_OFF + 64))[32] * 4;
                if (l == 0) tail_fill<1>(F, 0, tu, vcu); else if (l == 1) tail_fill<2>(F, 0, tu, vcu); else tail_fill<3>(F, 0, tu, vcu); }
            SEAM(pb + 7);
        }
        if (IN(pb + 8)) { phase_r2<false>(F, l); SEAM(pb + 8); }
    }
#undef IN
#undef SEAM
}

extern "C" void kernel_launch(void* const* d_in, const int* in_sizes, int n_in, void* d_out, int out_size, void* d_ws, size_t ws_size, hipStream_t stream) {
    static int grid = 0;
    if (grid == 0) {
        if (n_in != 21 || in_sizes[0] != M * D || out_size != M * D || ws_size < WS_END) { fprintf(stderr, "kernel_launch: unexpected shapes (n_in %d, in0 %d, out %d, ws %zu < %zu); nothing launched\n", n_in, n_in > 0 ? in_sizes[0] : -1, out_size, ws_size, (size_t)WS_END); grid = -1; return; }
        int dev = 0, cus = 0, per_cu = 0;
        if (hipGetDevice(&dev) != hipSuccess || hipDeviceGetAttribute(&cus, hipDeviceAttributeMultiprocessorCount, dev) != hipSuccess) { grid = -1; return; }
        if (hipFuncSetAttribute((const void*)fwd, hipFuncAttributeMaxDynamicSharedMemorySize, LDS_BYTES) != hipSuccess) { fprintf(stderr, "kernel_launch: hipFuncSetAttribute failed\n"); grid = -1; return; }
        if (hipOccupancyMaxActiveBlocksPerMultiprocessor(&per_cu, (const void*)fwd, NWAVES * 64, LDS_BYTES) != hipSuccess || per_cu < 1) fprintf(stderr, "kernel_launch: occupancy query reports %d workgroups per CU\n", per_cu);
        (void)hipGetLastError();
        grid = cus;
    }
    if (grid < 0) return;
    if (hipMemsetAsync((char*)d_ws + WS_CTL, 0, CTL_ZERO_BYTES, stream) != hipSuccess) return;
    Args a{};
    for (int i = 0; i < 21; ++i) a.in[i] = d_in[i];
    a.out = (float*)d_out; a.ws = (unsigned char*)d_ws;
#if MK_N_LAUNCHES == 1
    a.ph_lo = 0; a.ph_hi = NPHASE;
    hipLaunchKernelGGL(fwd, dim3(grid), dim3(NWAVES * 64), LDS_BYTES, stream, a);
#else
    for (int p = 0; p < NPHASE; ++p) { a.ph_lo = p; a.ph_hi = p + 1; hipLaunchKernelGGL(fwd, dim3(grid), dim3(NWAVES * 64), LDS_BYTES, stream, a); }
#endif
}
```

```cpp
#include <hip/hip_runtime.h>
#include <cstdio>
#include <cstdint>

#ifndef MK_N_LAUNCHES
#define MK_N_LAUNCHES 1
#endif

__device__ __forceinline__ int hw_tid(int wave_s) {
    unsigned z = 0u; asm volatile("" : "+s"(z));
    const unsigned lane = __builtin_amdgcn_mbcnt_hi(~0u, __builtin_amdgcn_mbcnt_lo(~0u, z));
    int t = (int)(((unsigned)wave_s << 6) | lane); asm volatile("" : "+v"(t)); return t;
}
namespace pg8 {
#define PG8_LAS __attribute__((address_space(3)))
typedef unsigned short bf16_t;
typedef short bf16x8 __attribute__((ext_vector_type(8)));
typedef float f32x4 __attribute__((ext_vector_type(4)));
typedef float f32x2 __attribute__((ext_vector_type(2)));
typedef unsigned u32x4 __attribute__((ext_vector_type(4)));
typedef unsigned u32x2 __attribute__((ext_vector_type(2)));
constexpr int BM = 256, BK = 64, HALF = 128, HTB = HALF * BK * 2  , STAGE_BYTES = 8 * HTB, NXCD = 8, WGM = 8;

__host__ __device__ __forceinline__ int lds_byte(int r, int c) { const int st = (r >> 4) * 2 + (c >> 5), rr = r & 15, cc = c & 31, ob = rr * 64 + cc * 2; return st * 1024 + (ob ^ (((ob >> 9) & 1) << 5)); }
__host__ __device__ __forceinline__ void stage_rc(int b, int& R, int& C) { const int st = b / 1024, sb = b % 1024, swz = sb ^ (((sb >> 9) & 1) << 5); R = (st >> 1) * 16 + swz / 64; C = (st & 1) * 32 + (swz % 64) / 2; }
__host__ __device__ __forceinline__ int perm32(int rho) { const int n = rho >> 4, i = rho & 15; return 8 * (i >> 2) + 4 * n + (i & 3); }

struct Unit { int pm, pn, ex, jb; };
struct Gemm { const bf16_t* A; const bf16_t* Bt; int M, N, K; };

struct StaticOrder {
    int nM, nN, nwg, G, c;
    __device__ void init(int M, int N, int G_, int c_) { nM = M / BM; nN = N / BM; nwg = nM * nN; G = G_; c = c_; }
    __device__ bool next(int i, Unit& u) const {
        const long L = (long)i * G + c; if (L >= nwg) return false;
        int wgid = (int)L; { const int q = nwg / NXCD, r = nwg % NXCD, xcd = wgid % NXCD, off = wgid / NXCD; wgid = (xcd < r ? xcd * (q + 1) : r * (q + 1) + (xcd - r) * q) + off; }
        const int nig = WGM * nN, gid = wgid / nig, fm = gid * WGM, gsz = (nM - fm) < WGM ? (nM - fm) : WGM;
        u.pm = fm + ((wgid % nig) % gsz); u.pn = (wgid % nig) / gsz; u.ex = 0; u.jb = 0; return true;
    }
    __device__ __forceinline__ const char* b_ptr(const Gemm& g, const Unit& u) const { return (const char*)g.Bt + (size_t)u.pn * BM * g.K * 2; }
    __device__ __forceinline__ unsigned a_off(const Gemm& g, const Unit& u, int h, int R, int C) const { return (unsigned)((u.pm * BM + h * HALF + R) * g.K + C) * 2u; }
};

struct MoeOrder {
    const PG8_LAS int* tab; const int* list; const bf16_t* W; size_t wstride; int ntn, G, c, gather;
    __device__ bool next(int i, Unit& u) const {
        const int L = i * G + c; const int total = tab[32] * ntn; if (L >= total) return false;
        const int rb = L / ntn; u.pn = L - rb * ntn;
        unsigned z = 0u; asm volatile("" : "+s"(z));
        const unsigned ln = __builtin_amdgcn_mbcnt_hi(~0u, __builtin_amdgcn_mbcnt_lo(~0u, z));
        const unsigned long long m = __ballot(rb >= tab[ln & 31u]);
        const int e = __builtin_popcount((unsigned)m) - 1;
        u.pm = rb; u.ex = e; u.jb = rb - tab[e]; return true;
    }
    __device__ __forceinline__ const char* b_ptr(const Gemm& g, const Unit& u) const { return (const char*)(W + (size_t)u.ex * wstride) + (size_t)u.pn * BM * g.K * 2; }
    __device__ __forceinline__ unsigned a_off(const Gemm& g, const Unit& u, int h, int R, int C) const {
        if (gather) { const int p = u.jb * BM + h * HALF + R; const int cnt = tab[33 + u.ex]; const int tok = list[u.ex * 16384 + (p < cnt ? p : 0)]; return (unsigned)(tok * g.K + C) * 2u; }
        return (unsigned)((u.pm * BM + h * HALF + R) * g.K + C) * 2u;
    }
};

__device__ __forceinline__ unsigned cvt_pk_bf16(float lo, float hi) { unsigned r; asm volatile("v_cvt_pk_bf16_f32 %0, %1, %2" : "=v"(r) : "v"(lo), "v"(hi)); return r; }

struct EpiF32 {
    static constexpr bool PERM = false;
    float* C; int ldc;
    __device__ __forceinline__ void operator()(const f32x4 (&acc)[2][2][4][2], const Unit& u, int wr, int wc, int fr, int fq) const {
        const int row0 = u.pm * BM + wr * 64 + fr, col0 = u.pn * BM + wc * 32 + 4 * fq;
#pragma unroll
        for (int ai = 0; ai < 2; ++ai)
#pragma unroll
            for (int m = 0; m < 4; ++m) { float* rowp = C + (size_t)(row0 + ai * HALF + m * 16) * ldc + col0;
#pragma unroll
                for (int bj = 0; bj < 2; ++bj)
#pragma unroll
                    for (int n = 0; n < 2; ++n) *(f32x4*)(rowp + bj * HALF + n * 16) = acc[ai][bj][m][n]; }
    }
};
struct EpiBf16S {
    static constexpr bool PERM = true;
    bf16_t* O; int ldc; int pn_lo, pn_hi; float scale;
    __device__ __forceinline__ void operator()(const f32x4 (&acc)[2][2][4][2], const Unit& u, int wr, int wc, int fr, int fq) const {
        const int row0 = u.pm * BM + wr * 64 + fr, col0 = u.pn * BM + wc * 32 + 8 * fq;
        const float sc = (u.pn >= pn_lo && u.pn < pn_hi) ? scale : 1.f;
#pragma unroll
        for (int ai = 0; ai < 2; ++ai)
#pragma unroll
            for (int m = 0; m < 4; ++m) { bf16_t* rowp = O + (size_t)(row0 + ai * HALF + m * 16) * ldc + col0;
#pragma unroll
                for (int bj = 0; bj < 2; ++bj) { const f32x4 v0 = acc[ai][bj][m][0] * sc, v1 = acc[ai][bj][m][1] * sc;
                    u32x4 w; w.x = cvt_pk_bf16(v0[0], v0[1]); w.y = cvt_pk_bf16(v0[2], v0[3]); w.z = cvt_pk_bf16(v1[0], v1[1]); w.w = cvt_pk_bf16(v1[2], v1[3]);
                    *(u32x4*)(rowp + bj * HALF) = w; } }
    }
};
struct EpiRope {
    static constexpr bool PERM = true;
    bf16_t* O; int ldc; int rope_tiles; const float* cs; float oscale;
    __device__ __forceinline__ void operator()(const f32x4 (&acc)[2][2][4][2], const Unit& u, int wr, int wc, int fr, int fq) const {
        const int row0 = u.pm * BM + wr * 64 + fr, col0 = u.pn * BM + wc * 32 + 8 * fq;
        const bool rope = u.pn < rope_tiles; const int i0 = 16 * (wc & 1) + 4 * fq;
#pragma unroll
        for (int ai = 0; ai < 2; ++ai)
#pragma unroll
            for (int m = 0; m < 4; ++m) { const int row = row0 + ai * HALF + m * 16; bf16_t* rowp = O + (size_t)row * ldc + col0;
                f32x4 t0 = (f32x4){1.f, 0.f, 1.f, 0.f}, t1 = (f32x4){1.f, 0.f, 1.f, 0.f};
                if (rope) { const f32x4* tp = (const f32x4*)(cs + ((size_t)row * 32 + i0) * 2); t0 = tp[0]; t1 = tp[1]; }
#pragma unroll
                for (int bj = 0; bj < 2; ++bj) { const f32x4 v0 = acc[ai][bj][m][0], v1 = acc[ai][bj][m][1];
                    const float a0 = v0[0] * t0[0] - v0[1] * t0[1], a1 = v0[1] * t0[0] + v0[0] * t0[1], a2 = v0[2] * t0[2] - v0[3] * t0[3], a3 = v0[3] * t0[2] + v0[2] * t0[3];
                    const float b0 = v1[0] * t1[0] - v1[1] * t1[1], b1 = v1[1] * t1[0] + v1[0] * t1[1], b2 = v1[2] * t1[2] - v1[3] * t1[3], b3 = v1[3] * t1[2] + v1[2] * t1[3];
                    u32x4 w; w.x = cvt_pk_bf16(a0 * oscale, a1 * oscale); w.y = cvt_pk_bf16(a2 * oscale, a3 * oscale); w.z = cvt_pk_bf16(b0 * oscale, b1 * oscale); w.w = cvt_pk_bf16(b2 * oscale, b3 * oscale);
                    *(u32x4*)(rowp + bj * HALF) = w; } }
    }
};
struct EpiGU {
    static constexpr bool PERM = true;
    bf16_t* O;
    __device__ __forceinline__ void operator()(const f32x4 (&acc)[2][2][4][2], const Unit& u, int wr, int wc, int fr, int fq) const {
        const int row0 = u.pm * BM + wr * 64 + fr, col0 = u.pn * HALF + wc * 32 + 8 * fq;
#pragma unroll
        for (int ai = 0; ai < 2; ++ai)
#pragma unroll
            for (int m = 0; m < 4; ++m) { bf16_t* rowp = O + (size_t)(row0 + ai * HALF + m * 16) * 256 + col0;
                float r[8];
#pragma unroll
                for (int n = 0; n < 2; ++n)
#pragma unroll
                    for (int j = 0; j < 4; ++j) { const float gt = acc[ai][0][m][n][j], up = acc[ai][1][m][n][j]; r[n * 4 + j] = gt * __builtin_amdgcn_rcpf(1.f + __expf(-gt)) * up; }
                u32x4 w; w.x = cvt_pk_bf16(r[0], r[1]); w.y = cvt_pk_bf16(r[2], r[3]); w.z = cvt_pk_bf16(r[4], r[5]); w.w = cvt_pk_bf16(r[6], r[7]);
                *(u32x4*)rowp = w; }
    }
};

template <class Epi, class Sched, bool ALIGN_EPI>
__device__ __forceinline__ void gemm_phase(PG8_LAS unsigned char* lds, const Gemm g, const Sched& S, const Epi& E, int wave_s) {
    const int tid = hw_tid(wave_s);
    const int wid = __builtin_amdgcn_readfirstlane(tid >> 6), lane = tid & 63, wr = wid >> 2, wc = wid & 3, fr = lane & 15, fq = lane >> 4;
    const int K = g.K, nt = K / BK;
    int sR[2], sC[2]; unsigned voffB[2];
#pragma unroll
    for (int i = 0; i < 2; ++i) { int R, C; stage_rc(tid * 16 + i * 8192, R, C); sR[i] = R; sC[i] = C; const int Rb = Epi::PERM ? ((R & ~31) + perm32(R & 31)) : R; voffB[i] = (unsigned)(Rb * K + C) * 2u; }
    const unsigned kstep = (unsigned)(BK * 2);
    const size_t hstep = (size_t)HALF * K * 2;
    const unsigned ldsw = (unsigned)wid * 1024u;
    const int aoff = lds_byte(wr * 64 + fr, fq * 8), boff = lds_byte(wc * 32 + fr, fq * 8);
    const char* const Ab = (const char*)g.A;
#define PG8_SA(b, h) (((b) * 2 + (h)) * HTB)
#define PG8_SB(b, h) ((4 + (b) * 2 + (h)) * HTB)
#define PG8_STAGEB(bufoff, gbase) do { _Pragma("unroll") for (int _i = 0; _i < 2; ++_i) \
        __builtin_amdgcn_global_load_lds((const unsigned*)((const char*)(gbase) + voffB[_i]), (PG8_LAS unsigned*)(lds + (bufoff) + ldsw + _i * 8192), 16, 0, 0); } while (0)
#define PG8_STAGEA(bufoff, o0, o1) do { \
        __builtin_amdgcn_global_load_lds((const unsigned*)(Ab + (o0)), (PG8_LAS unsigned*)(lds + (bufoff) + ldsw), 16, 0, 0); \
        __builtin_amdgcn_global_load_lds((const unsigned*)(Ab + (o1)), (PG8_LAS unsigned*)(lds + (bufoff) + ldsw + 8192), 16, 0, 0); } while (0)
#define PG8_LDA(dst, b, h) do { _Pragma("unroll") for (int m = 0; m < 4; ++m) _Pragma("unroll") for (int k = 0; k < 2; ++k) dst[m][k] = *(const PG8_LAS bf16x8*)(lds + PG8_SA(b, h) + aoff + m * 2048 + k * 1024); } while (0)
#define PG8_LDB(dst, b, h) do { _Pragma("unroll") for (int n = 0; n < 2; ++n) _Pragma("unroll") for (int k = 0; k < 2; ++k) dst[n][k] = *(const PG8_LAS bf16x8*)(lds + PG8_SB(b, h) + boff + n * 2048 + k * 1024); } while (0)
#define PG8_MMA(ai, bj, At, Bt) do { __builtin_amdgcn_s_setprio(1); _Pragma("unroll") for (int m = 0; m < 4; ++m) _Pragma("unroll") for (int n = 0; n < 2; ++n) _Pragma("unroll") for (int k = 0; k < 2; ++k) \
        acc[ai][bj][m][n] = __builtin_amdgcn_mfma_f32_16x16x32_bf16(Bt[n][k], At[m][k], acc[ai][bj][m][n], 0, 0, 0); __builtin_amdgcn_s_setprio(0); } while (0)
#define PG8_WAIT_V(n) asm volatile("s_waitcnt vmcnt(" #n ")" ::: "memory")
#define PG8_WAIT_L(n) asm volatile("s_waitcnt lgkmcnt(" #n ")" ::: "memory")
#define PG8_BAR __builtin_amdgcn_s_barrier()
#define PG8_SCHED __builtin_amdgcn_sched_barrier(0)
    Unit cur, nxt; int ui = 0;
    if (!S.next(0, cur)) return;
    f32x4 acc[2][2][4][2];
#pragma unroll
    for (int a = 0; a < 2; ++a)
#pragma unroll
        for (int b = 0; b < 2; ++b)
#pragma unroll
            for (int m = 0; m < 4; ++m)
#pragma unroll
                for (int n = 0; n < 2; ++n) acc[a][b][m][n] = (f32x4){0.f, 0.f, 0.f, 0.f};
    bf16x8 At[4][2], B0[2][2], B1[2][2];
    unsigned vA00, vA01, vA10, vA11;
    vA00 = S.a_off(g, cur, 0, sR[0], sC[0]); vA01 = S.a_off(g, cur, 0, sR[1], sC[1]); vA10 = S.a_off(g, cur, 1, sR[0], sC[0]); vA11 = S.a_off(g, cur, 1, sR[1], sC[1]);
    const char* cB = S.b_ptr(g, cur);
    PG8_STAGEB(PG8_SB(0, 0), cB); PG8_STAGEB(PG8_SB(0, 1), cB + hstep); PG8_STAGEA(PG8_SA(0, 0), vA00, vA01); PG8_STAGEA(PG8_SA(0, 1), vA10, vA11);
    if (wr == 1) PG8_BAR;
    PG8_WAIT_V(2); PG8_BAR;
    PG8_STAGEB(PG8_SB(1, 0), cB + kstep); PG8_STAGEA(PG8_SA(1, 0), vA00 + kstep, vA01 + kstep); PG8_STAGEB(PG8_SB(1, 1), cB + hstep + kstep);
    PG8_WAIT_V(6); PG8_BAR;
    for (;;) {
        const bool has_next = S.next(ui + 1, nxt);
        const char* nB = has_next ? S.b_ptr(g, nxt) : cB;
        unsigned nA00 = vA00, nA01 = vA01, nA10 = vA10, nA11 = vA11;
        if (has_next) { nA00 = S.a_off(g, nxt, 0, sR[0], sC[0]); nA01 = S.a_off(g, nxt, 0, sR[1], sC[1]); nA10 = S.a_off(g, nxt, 1, sR[0], sC[0]); nA11 = S.a_off(g, nxt, 1, sR[1], sC[1]); }
#pragma unroll 1
        for (int t = 0; t < nt; t += 2) {
            const bool last = (t == nt - 2);
            const unsigned k1 = (unsigned)(t + 1) * kstep;
            const unsigned k2 = last ? 0u : (unsigned)(t + 2) * kstep, k3 = k2 + kstep;
            const char* b2 = last ? nB : cB + (size_t)(t + 2) * kstep; const char* b3 = b2 + kstep;
            const unsigned s00 = (last ? nA00 : vA00), s01 = (last ? nA01 : vA01), s10 = (last ? nA10 : vA10), s11 = (last ? nA11 : vA11);
            PG8_LDB(B0, 0, 0); PG8_LDB(B1, 0, 1); PG8_SCHED; PG8_LDA(At, 0, 0); PG8_STAGEA(PG8_SA(1, 1), vA10 + k1, vA11 + k1);
            PG8_WAIT_V(8); PG8_WAIT_L(0); PG8_BAR; PG8_MMA(0, 0, At, B0); PG8_MMA(0, 1, At, B1); PG8_BAR; PG8_SCHED;
            PG8_LDA(At, 0, 1); PG8_STAGEB(PG8_SB(0, 0), b2); PG8_STAGEB(PG8_SB(0, 1), b2 + hstep); PG8_STAGEA(PG8_SA(0, 0), s00 + k2, s01 + k2);
            PG8_WAIT_V(8); PG8_WAIT_L(0); PG8_BAR; PG8_MMA(1, 0, At, B0); PG8_MMA(1, 1, At, B1); PG8_BAR; PG8_SCHED;
            PG8_LDB(B0, 1, 0); PG8_LDB(B1, 1, 1); PG8_SCHED; PG8_LDA(At, 1, 0); PG8_STAGEA(PG8_SA(0, 1), s10 + k2, s11 + k2);
            PG8_WAIT_V(8); PG8_WAIT_L(0); PG8_BAR; PG8_MMA(0, 0, At, B0); PG8_MMA(0, 1, At, B1); PG8_BAR; PG8_SCHED;
            PG8_LDA(At, 1, 1); PG8_STAGEB(PG8_SB(1, 0), b3); PG8_STAGEB(PG8_SB(1, 1), b3 + hstep); PG8_STAGEA(PG8_SA(1, 0), s00 + k3, s01 + k3);
            PG8_WAIT_V(8); PG8_WAIT_L(0); PG8_BAR; PG8_MMA(1, 0, At, B0); PG8_MMA(1, 1, At, B1); PG8_BAR; PG8_SCHED;
        }
        if constexpr (ALIGN_EPI) { if (wr == 0) PG8_BAR; }
        E(acc, cur, wr, wc, fr, fq);
        if (!has_next) break;
#pragma unroll
        for (int a = 0; a < 2; ++a)
#pragma unroll
            for (int b = 0; b < 2; ++b)
#pragma unroll
                for (int m = 0; m < 4; ++m)
#pragma unroll
                    for (int n = 0; n < 2; ++n) acc[a][b][m][n] = (f32x4){0.f, 0.f, 0.f, 0.f};
        cur = nxt; cB = nB; vA00 = nA00; vA01 = nA01; vA10 = nA10; vA11 = nA11; ++ui;
        if constexpr (ALIGN_EPI) { if (wr == 1) PG8_BAR; }
    }
    PG8_WAIT_V(0);
    if constexpr (!ALIGN_EPI) { if (wr == 0) PG8_BAR; }
    PG8_BAR;
#undef PG8_SA
#undef PG8_SB
#undef PG8_STAGEA
#undef PG8_STAGEB
#undef PG8_LDA
#undef PG8_LDB
#undef PG8_MMA
#undef PG8_WAIT_V
#undef PG8_WAIT_L
#undef PG8_BAR
#undef PG8_SCHED
}
}

constexpr int NWAVES = 8;
constexpr int BATCH = 2, SEQ = 8192, D = 1024, M = BATCH * SEQ, DEPTH = 4, NA = 2;
constexpr float ALPHA = 1.681792830507429f;
constexpr float LN_EPS = 1e-5f, A_NORM_EPS = 1e-6f;
constexpr int AH = 4, DQK = 128, DV = 256, APROJ = 3080, NPROJ = 3072;
constexpr int CH = 256, NCH = SEQ / CH;
constexpr int BG = 3, BH = 8, HD = 64, BW = 512, NQ = 1536, NKV = 3072;
constexpr int NE = 32, EG = 8, MH = 256;
constexpr int MAXRB = 160;

constexpr size_t MiB = 1u << 20;
constexpr size_t WS_CTL = 0, CTL_ZERO_BYTES = 128 * 1024;
constexpr size_t WS_MOD = 1 * MiB;
constexpr size_t WS_ROPE = 2 * MiB;
constexpr size_t WS_WR = 6 * MiB;
constexpr size_t WS_WG = 6 * MiB + 768 * 1024;
constexpr size_t WS_GATES = 7 * MiB;
constexpr size_t WS_ROUTE = 8 * MiB;
constexpr size_t WS_LIST = 9 * MiB;
constexpr size_t WS_MLS = 11 * MiB;
constexpr size_t WS_WIN = 12 * MiB, WS_WOUT = 24 * MiB, WS_WKV = 28 * MiB, WS_WQ = 34 * MiB, WS_WO = 40 * MiB, WS_WGU = 42 * MiB, WS_WD = 170 * MiB;
constexpr size_t WS_H = 234 * MiB;
constexpr size_t WS_YA = 266 * MiB;
constexpr size_t WS_S0 = 298 * MiB;
constexpr size_t WS_PROJ = WS_S0, WS_DC = WS_S0 + 96 * MiB, WS_CIN = WS_S0 + 128 * MiB;
constexpr size_t WS_Q = WS_S0, WS_OG = WS_S0 + 48 * MiB, WS_LSE = WS_S0 + 96 * MiB, WS_KV = WS_S0 + 112 * MiB;
constexpr size_t WS_YMIX = WS_S0;
constexpr size_t WS_Y = WS_S0, WS_ACT = WS_S0 + 80 * MiB;
constexpr size_t WS_X = WS_S0 + 208 * MiB;
constexpr size_t WS_END = WS_X + 64 * MiB;
constexpr int CW_BAR = 4096;
constexpr int CW_CNT = 16384;

constexpr int RING_BYTES = 131072;
constexpr int LDSCTL_OFF = 145408;
constexpr int LDS_BYTES = 147456;

#define GAS __attribute__((address_space(1)))
#define LAS __attribute__((address_space(3)))
typedef unsigned short bf16;
typedef unsigned v4u __attribute__((ext_vector_type(4)));
typedef unsigned v2u __attribute__((ext_vector_type(2)));
typedef float f32x4 __attribute__((ext_vector_type(4)));
typedef float f32x2 __attribute__((ext_vector_type(2)));
#define RLX_AGENT __ATOMIC_RELAXED, __HIP_MEMORY_SCOPE_AGENT
#ifndef ST_NT
#define ST_NT(p, v) __builtin_nontemporal_store((v), (p))
#endif
__device__ __forceinline__ unsigned f2bf(float f) { unsigned u = __builtin_bit_cast(unsigned, f); return (u + 0x7fffu + ((u >> 16) & 1u)) >> 16; }
typedef __bf16 bf16n2 __attribute__((ext_vector_type(2)));
__device__ __forceinline__ unsigned pk2(float lo, float hi) { bf16n2 v; v.x = (__bf16)lo; v.y = (__bf16)hi; return __builtin_bit_cast(unsigned, v); }
__device__ __forceinline__ float u2f(unsigned w) { return __builtin_bit_cast(float, w); }
__device__ __forceinline__ unsigned f2u(float f) { return __builtin_bit_cast(unsigned, f); }
__device__ __forceinline__ float bflo(unsigned w) { return __builtin_bit_cast(float, w << 16); }
__device__ __forceinline__ float bfhi(unsigned w) { return __builtin_bit_cast(float, w & 0xffff0000u); }
__device__ __forceinline__ float bf2f(bf16 v) { return __builtin_bit_cast(float, (unsigned)v << 16); }
template <int CTRL> __device__ __forceinline__ float dpp_mov(float v) { return __builtin_bit_cast(float, __builtin_amdgcn_update_dpp(0, __builtin_bit_cast(int, v), CTRL, 0xF, 0xF, true)); }
__device__ __forceinline__ float rdlane(float v, int l) { return __builtin_bit_cast(float, __builtin_amdgcn_readlane(__builtin_bit_cast(int, v), l)); }
__device__ __forceinline__ float quad_sum(float v) { v += dpp_mov<0xB1>(v); v += dpp_mov<0x4E>(v); return v; }
__device__ __forceinline__ float quad_max(float v) { v = fmaxf(v, dpp_mov<0xB1>(v)); v = fmaxf(v, dpp_mov<0x4E>(v)); return v; }
__device__ __forceinline__ float row16_sum(float v) { v += dpp_mov<0xB1>(v); v += dpp_mov<0x4E>(v); v += dpp_mov<0x141>(v); v += dpp_mov<0x140>(v); return v; }
__device__ __forceinline__ float row16_max(float v) { v = fmaxf(v, dpp_mov<0xB1>(v)); v = fmaxf(v, dpp_mov<0x4E>(v)); v = fmaxf(v, dpp_mov<0x141>(v)); v = fmaxf(v, dpp_mov<0x140>(v)); return v; }
__device__ __forceinline__ float wave_sum(float v) { v = row16_sum(v); return (rdlane(v, 0) + rdlane(v, 16)) + (rdlane(v, 32) + rdlane(v, 48)); }
__device__ __forceinline__ float wave_max(float v) { v = row16_max(v); return fmaxf(fmaxf(rdlane(v, 0), rdlane(v, 16)), fmaxf(rdlane(v, 32), rdlane(v, 48))); }
#define opaque_tid() hw_tid(F.wave)
__device__ __forceinline__ float sigmoidf_(float x) { return __builtin_amdgcn_rcpf(1.f + __expf(-x)); }
__device__ __forceinline__ float logsigmoidf_(float x) { return fminf(x, 0.f) - __logf(1.f + __expf(-fabsf(x))); }
__device__ __forceinline__ float lane_xor(float v, int m, int lane) { return __builtin_bit_cast(float, __builtin_amdgcn_ds_bpermute((lane ^ m) << 2, __builtin_bit_cast(int, v))); }
__device__ __forceinline__ float lane_up(float v, int o, int lane) { return __builtin_bit_cast(float, __builtin_amdgcn_ds_bpermute(((lane - o) & 63) << 2, __builtin_bit_cast(int, v))); }
__device__ __forceinline__ int lane_up(int v, int o, int lane) { return __builtin_amdgcn_ds_bpermute(((lane - o) & 63) << 2, v); }
__device__ __forceinline__ int lane_get(int v, int src) { return __builtin_amdgcn_ds_bpermute(src << 2, v); }

#define XB_TMO      128
#define XB_XCNT(j)  (256  + 64 * (j))
#define XB_XSUB(j)  (1280 + 64 * (j))
#define XB_XGEN(j)  (2304 + 64 * (j))
#define XB_TOP      3328
#define XB_TOPGEN   3392
#define XCD_BAR_WORDS 3456
#define XB_SPIN_CAP (1u << 18)

__device__ __forceinline__ unsigned xb_ld(unsigned* p)              { return __hip_atomic_load(p, __ATOMIC_RELAXED, __HIP_MEMORY_SCOPE_AGENT); }
__device__ __forceinline__ unsigned xb_add(unsigned* p, unsigned v) { return __hip_atomic_fetch_add(p, v, __ATOMIC_RELAXED, __HIP_MEMORY_SCOPE_AGENT); }
__device__ __forceinline__ unsigned xb_xcc_id() { return (unsigned)__builtin_amdgcn_s_getreg((3 << 11) | 20) & 0xFu; }
#define XB_SPIN(cond, bar) do { unsigned _sp = 0; while (cond) { __builtin_amdgcn_s_sleep(1); \
    if ((++_sp & 255u) == 0u) { if (xb_ld(&(bar)[XB_TMO])) break; if (_sp > XB_SPIN_CAP) { atomicAdd(&(bar)[XB_TMO], 1u); break; } } } } while (0)

struct XcdBarrier {
    unsigned* bar; unsigned x;
    volatile LAS unsigned* st;
    int w;
};
__device__ __forceinline__ XcdBarrier xcd_barrier_post(unsigned* bar, volatile LAS unsigned* st, int wave_s) {
    XcdBarrier b; b.bar = bar; b.x = xb_xcc_id(); b.st = st; b.w = wave_s;
    if (hw_tid(wave_s) == 0) (void)xb_add(&bar[XB_XCNT(b.x)], 1u);
    return b;
}
__device__ __forceinline__ void xcd_barrier_complete(unsigned* bar, unsigned x, unsigned& nloc, unsigned& nx) {
    const unsigned G = gridDim.x * gridDim.y * gridDim.z;
    unsigned sum, cnt, mine, sp = 0u;
    for (;;) {
        sum = 0u; cnt = 0u; mine = 0u;
#pragma unroll
        for (unsigned j = 0; j < 16; ++j) { const unsigned c = xb_ld(&bar[XB_XCNT(j)]); sum += c; cnt += (c > 0u) ? 1u : 0u; mine = (j == x) ? c : mine; }
        if (sum == G) break;
        __builtin_amdgcn_s_sleep(1);
        if ((++sp & 255u) == 0u) { if (xb_ld(&bar[XB_TMO])) break; if (sp > XB_SPIN_CAP) { atomicAdd(&bar[XB_TMO], 1u); break; } }
    }
    nloc = mine > 0u ? mine : 1u; nx = cnt > 0u ? cnt : 1u;
}
__device__ __forceinline__ void xcd_barrier(const XcdBarrier& b) {
    asm volatile("s_waitcnt vmcnt(0)" ::: "memory");
    __syncthreads();
    if (hw_tid(b.w) == 0) {
        unsigned* bar = b.bar;
        __builtin_amdgcn_s_waitcnt(0);
        unsigned nloc = b.st[0], nx = b.st[1];
        if (nloc == 0u) { xcd_barrier_complete(bar, b.x, nloc, nx); b.st[0] = nloc; b.st[1] = nx; }
        const unsigned old = xb_add(&bar[XB_XSUB(b.x)], 1u);
        const unsigned gen = old / nloc;
        if (old + 1u == (gen + 1u) * nloc) {
            __builtin_amdgcn_fence(__ATOMIC_RELEASE, "agent");
            asm volatile("s_waitcnt vmcnt(0)" ::: "memory");
            const unsigned og = xb_add(&bar[XB_TOP], 1u);
            const unsigned tg = og / nx;
            if (og + 1u == (tg + 1u) * nx) xb_add(&bar[XB_TOPGEN], 1u);
            else XB_SPIN(xb_ld(&bar[XB_TOPGEN]) == tg, bar);
            __builtin_amdgcn_fence(__ATOMIC_ACQUIRE, "agent");
            xb_add(&bar[XB_XGEN(b.x)], 1u);
            asm volatile("s_waitcnt vmcnt(0)" ::: "memory");
        } else {
            XB_SPIN(xb_ld(&bar[XB_XGEN(b.x)]) == gen, bar);
            __builtin_amdgcn_fence(__ATOMIC_ACQUIRE, "agent");
            asm volatile("s_waitcnt vmcnt(0)" ::: "memory");
        }
    }
    __syncthreads();
}

struct Frame {
    LAS unsigned char* lds;
    unsigned* ctl;
    unsigned char* ws;
    int tid, lane, wave, G;
    const float *x, *c; const int* pos; const float *ada_w, *ada_b, *ln_g, *ln_b, *a_w_in, *a_b_gate, *a_norm_g, *a_w_out, *b_w_kv, *b_w_q, *b_w_o,
                *w_r1, *b_r1, *w_r2, *b_r2, *w_gate, *w_up, *w_down;
    float* out;
};

__device__ __forceinline__ int rowmap(int mode, int n) {
    if (mode == 1 || (mode == 2 && n < 1536)) { const int e = n & 63; return (n & ~63) + 2 * (e & 31) + (e >> 5); }
    if (mode == 3) return ((n >> 7) << 8) + (n & 127);
    if (mode == 4) return ((n >> 7) << 8) + 128 + (n & 127);
    return n;
}
__device__ __forceinline__ void transpose_load(const float* W, int ldw, int k0, int n0, f32x4 (&t)[8], int lane) {
#pragma unroll
    for (int i = 0; i < 8; ++i) t[i] = *(const f32x4*)(W + (size_t)(k0 + 8 * i + (lane >> 3)) * ldw + n0 + 4 * (lane & 7));
}
__device__ __forceinline__ void transpose_store(const f32x4 (&t)[8], int k0, int n0, bf16* WT, int ldk, int mode, LAS float* scr, int lane) {
#pragma unroll
    for (int i = 0; i < 8; ++i) { LAS float* d = scr + (8 * i + (lane >> 3)) * 33 + 4 * (lane & 7); d[0] = t[i].x; d[1] = t[i].y; d[2] = t[i].z; d[3] = t[i].w; }
    asm volatile("s_waitcnt lgkmcnt(0)" ::: "memory");
    const int c = lane & 7;
#pragma unroll
    for (int j = 0; j < 4; ++j) { const int n = (lane >> 3) + 8 * j; const LAS float* s = scr + (8 * c) * 33 + n;
        v4u o; o.x = pk2(s[0 * 33], s[1 * 33]); o.y = pk2(s[2 * 33], s[3 * 33]); o.z = pk2(s[4 * 33], s[5 * 33]); o.w = pk2(s[6 * 33], s[7 * 33]);
        *(v4u*)(WT + (size_t)rowmap(mode, n0 + n) * ldk + k0 + 8 * c) = o; }
    asm volatile("s_waitcnt lgkmcnt(0)" ::: "memory");
}
struct TItem { const float* W; bf16* WT; int ldw, k0, n0, ldk, mode; };
__device__ __forceinline__ TItem conv_item(Frame& F, int kind, int l, int r) {
    TItem t; t.mode = 0;
    const float* const wg = F.w_gate; const float* const wu = F.w_up;
    if (kind == 0) { t.W = F.a_w_in + (size_t)l * D * APROJ; t.ldw = APROJ; t.k0 = 64 * (r / 96); t.n0 = 32 * (r % 96); t.WT = (bf16*)(F.ws + WS_WIN) + (size_t)l * NPROJ * D; t.ldk = D; }
    else if (kind == 1) { t.W = F.a_w_out + (size_t)l * D * D; t.ldw = D; t.k0 = 64 * (r / 32); t.n0 = 32 * (r % 32); t.WT = (bf16*)(F.ws + WS_WOUT) + (size_t)l * D * D; t.ldk = D; }
    else if (kind == 2) { t.W = F.b_w_kv; t.ldw = NKV; t.k0 = 64 * (r / 96); t.n0 = 32 * (r % 96); t.WT = (bf16*)(F.ws + WS_WKV); t.ldk = D; t.mode = 2; }
    else if (kind == 3) { t.W = F.b_w_q + (size_t)l * D * NQ; t.ldw = NQ; t.k0 = 64 * (r / 48); t.n0 = 32 * (r % 48); t.WT = (bf16*)(F.ws + WS_WQ) + (size_t)l * NQ * D; t.ldk = D; t.mode = 1; }
    else if (kind == 4) { t.W = F.b_w_o + (size_t)l * BW * D; t.ldw = D; t.k0 = 64 * (r / 32); t.n0 = 32 * (r % 32); t.WT = (bf16*)(F.ws + WS_WO) + (size_t)l * D * BW; t.ldk = BW; }
    else { const int sub = r >> 12, q = r & 4095, le = l * NE + (q >> 7), rr = q & 127;
        if (sub < 2) { t.W = (sub == 0 ? wg : wu) + (size_t)le * D * MH; t.ldw = MH; t.k0 = 64 * (rr / 8); t.n0 = 32 * (rr % 8); t.WT = (bf16*)(F.ws + WS_WGU) + (size_t)le * 512 * D; t.ldk = D; t.mode = 3 + sub; }
        else { t.W = F.w_down + (size_t)le * MH * D; t.ldw = D; t.k0 = 64 * (rr / 32); t.n0 = 32 * (rr % 32); t.WT = (bf16*)(F.ws + WS_WD) + (size_t)le * D * MH; t.ldk = MH; } }
    return t;
}
template <int STAGE> __device__ __forceinline__ int stage_count(int l) { return STAGE == 0 ? 1536 + 512 + 12288 : STAGE == 1 ? 1536 + 512 : STAGE == 2 ? 1536 + 768 + 256 : STAGE == 3 ? 768 + 256 : STAGE == 4 ? (l >= NA ? 8192 : 12288) : 4096; }
template <int STAGE> __device__ __forceinline__ TItem stage_item(Frame& F, int r, int l) {
    if (STAGE == 0) { if (r < 1536) return conv_item(F, 0, 0, r); r -= 1536; if (r < 512) return conv_item(F, 1, 0, r); return conv_item(F, 5, 0, r - 512); }
    if (STAGE == 1) { if (r < 1536) return conv_item(F, 0, 1, r); return conv_item(F, 1, 1, r - 1536); }
    if (STAGE == 2) { if (r < 1536) return conv_item(F, 2, 0, r); r -= 1536; if (r < 768) return conv_item(F, 3, 0, r); return conv_item(F, 4, 0, r - 768); }
    if (STAGE == 3) { if (r < 768) return conv_item(F, 3, 1, r); return conv_item(F, 4, 1, r - 768); }
    if (STAGE == 5) return conv_item(F, 5, l, 8192 + r);
    return conv_item(F, 5, l, r);
}
template <int STAGE> __device__ __forceinline__ void conv_run(Frame& F, int l, int gw, int NGW, int lane, int wave) {
    LAS float* scr = (LAS float*)(F.lds + wave * 16384);
    const int NITEMS = stage_count<STAGE>(l);
    f32x4 cur[8], nxt[8];
    int it = gw;
    if (it < NITEMS) { const TItem t = stage_item<STAGE>(F, it, l); transpose_load(t.W, t.ldw, t.k0, t.n0, cur, lane); }
#pragma unroll 1
    for (; it < NITEMS; it += NGW) {
        const TItem t = stage_item<STAGE>(F, it, l);
        const bool more = it + NGW < NITEMS;
        if (more) { const TItem tn = stage_item<STAGE>(F, it + NGW, l); transpose_load(tn.W, tn.ldw, tn.k0, tn.n0, nxt, lane); }
        transpose_store(cur, t.k0, t.n0, t.WT, t.ldk, t.mode, scr, lane);
        if (more) {
#pragma unroll
            for (int j = 0; j < 8; ++j) cur[j] = nxt[j]; }
    }
}
__device__ __forceinline__ void gemv_run(Frame& F, int tid, int lane, int wave) {
    LAS float* red = (LAS float*)F.lds;
    LAS float* sc = (LAS float*)(F.lds + 8192);
    float* mod = (float*)(F.ws + WS_MOD);
    for (int i = tid; i < 2 * D; i += NWAVES * 64) { const float c = F.c[i]; sc[i] = c / (1.f + expf(-c)); }
    __syncthreads();
    for (int it = blockIdx.x; it < 4 * 64; it += F.G) {
        const int l = it >> 6, n0 = (it & 63) * 96;
        const float* W = F.ada_w + (size_t)l * D * 6144 + n0 + 2 * (lane < 48 ? lane : 0);
        float a00 = 0.f, a01 = 0.f, a10 = 0.f, a11 = 0.f;
        const int k0 = wave * 128;
#pragma unroll 1
        for (int kb = k0; kb < k0 + 128; kb += 32) {
            f32x2 w[32];
#pragma unroll
            for (int k = 0; k < 32; ++k) w[k] = *(const f32x2*)(W + (size_t)(kb + k) * 6144);
#pragma unroll
            for (int k = 0; k < 32; ++k) { const float c0 = sc[kb + k], c1 = sc[D + kb + k]; a00 += c0 * w[k].x; a01 += c0 * w[k].y; a10 += c1 * w[k].x; a11 += c1 * w[k].y; }
        }
        if (lane < 48) { red[(wave * 2 + 0) * 96 + 2 * lane] = a00; red[(wave * 2 + 0) * 96 + 2 * lane + 1] = a01;
                         red[(wave * 2 + 1) * 96 + 2 * lane] = a10; red[(wave * 2 + 1) * 96 + 2 * lane + 1] = a11; }
        __syncthreads();
        if (tid < 192) { const int b = tid / 96, nn = tid % 96; float s = 0.f;
#pragma unroll
            for (int w8 = 0; w8 < 8; ++w8) s += red[(w8 * 2 + b) * 96 + nn];
            mod[(size_t)(l * 2 + b) * 6144 + n0 + nn] = s + F.ada_b[l * 6144 + n0 + nn]; }
        __syncthreads();
    }
}
__device__ __forceinline__ void rope_table(Frame& F, int gt, int NGT) {
    float* cs = (float*)(F.ws + WS_ROPE);
    const float inv = powf(10000.f, -(float)(gt & 31) * 2.0f / 64.0f);
    for (int i = gt; i < M * 32; i += NGT) { const int tok = i >> 5;
        const float ang = (float)F.pos[tok] * inv;
        const double a = (double)ang; const double n = rint(a * 0.15915494309189535); const float r = (float)(a - n * 6.283185307179586);
        *(f32x2*)(cs + 2 * (size_t)i) = (f32x2){cosf(r), sinf(r)}; }
}
template <int STAGE> __device__ __forceinline__ void tail_fill(Frame& F, int l, int total_units, int vcu) {
    const int tid = opaque_tid(), lane = tid & 63, wave = __builtin_amdgcn_readfirstlane(tid >> 6);
    const int maxu = (total_units + F.G - 1) / F.G; int cut = total_units - (maxu - 1) * F.G; if (cut < 0 || F.G - cut < F.G / 2) cut = 0;
    if (vcu >= cut) {
        const int j = vcu - cut, n = F.G - cut;
        if (STAGE == 4) conv_run<STAGE>(F, l, j * NWAVES + wave, n * NWAVES, lane, wave);
        else {
            conv_run<STAGE>(F, l, j * NWAVES + wave, n * NWAVES, lane, wave);
            if (STAGE == 1) rope_table(F, j * (NWAVES * 64) + tid, n * (NWAVES * 64));
        }
    }
}
__device__ __forceinline__ void pro_a(Frame& F) {
    const int tid = opaque_tid(), lane = tid & 63, wave = __builtin_amdgcn_readfirstlane(tid >> 6);
    gemv_run(F, tid, lane, wave);
    conv_run<0>(F, 0, blockIdx.x * NWAVES + wave, F.G * NWAVES, lane, wave);
    {
        const int gt = blockIdx.x * (NWAVES * 64) + tid, NGT = F.G * NWAVES * 64;
        float* WR = (float*)(F.ws + WS_WR); float* WG = (float*)(F.ws + WS_WG);
        for (int i = gt; i < 4 * 48 * D; i += NGT) { const int l = i / (48 * D), c = (i / D) % 48, k = i % D;
            WR[i] = c < 4 ? F.w_r1[(size_t)(l * D + k) * 4 + c] : (c < 36 ? F.w_r2[(size_t)(l * D + k) * 32 + (c - 4)] : 0.f); }
        for (int i = gt; i < 2 * 8 * D; i += NGT) { const int l = i / (8 * D), j = (i / D) % 8, k = i % D; WG[i] = F.a_w_in[(size_t)(l * D + k) * APROJ + NPROJ + j]; }
    }
}

__device__ __forceinline__ void ln_row(f32x4 (&v)[4], const float* lng, const float* lnb, int lane) {
    float s = 0.f;
#pragma unroll
    for (int j = 0; j < 4; ++j) s += (v[j].x + v[j].y) + (v[j].z + v[j].w);
    const float mean = wave_sum(s) * (1.f / D); float q = 0.f;
#pragma unroll
    for (int j = 0; j < 4; ++j) { v[j] = v[j] - mean; q += (v[j].x * v[j].x + v[j].y * v[j].y) + (v[j].z * v[j].z + v[j].w * v[j].w); }
    const float rstd = 1.f / sqrtf(wave_sum(q) * (1.f / D) + LN_EPS);
#pragma unroll
    for (int j = 0; j < 4; ++j) { const f32x4 g = *(const f32x4*)(lng + 256 * j + 4 * lane), b = *(const f32x4*)(lnb + 256 * j + 4 * lane); v[j] = v[j] * rstd * g + b; }
}
__device__ __forceinline__ void modulate(const f32x4 (&v)[4], f32x4 (&h)[4], const float* sc, const float* sh, int lane) {
#pragma unroll
    for (int j = 0; j < 4; ++j) { const f32x4 s = *(const f32x4*)(sc + 256 * j + 4 * lane), t = *(const f32x4*)(sh + 256 * j + 4 * lane); h[j] = v[j] * (1.f + s) + t; }
}
__device__ __forceinline__ void store_row_bf16(bf16* dst, const f32x4 (&h)[4], int lane) {
#pragma unroll
    for (int j = 0; j < 4; ++j) { v2u o; o.x = pk2(h[j].x, h[j].y); o.y = pk2(h[j].z, h[j].w); ST_NT((v2u*)(dst + 256 * j + 4 * lane), o); }
}
__device__ __forceinline__ void gates_row(const f32x4 (&h)[4], const float* WGl, const float* bg, float* grow, int lane) {
    float p[8];
#pragma unroll
    for (int g = 0; g < 8; ++g) { float s = 0.f;
        if ((g & 1) == 0) asm volatile("" ::: "memory");
#pragma unroll
        for (int j = 0; j < 4; ++j) { const f32x4 w = *(const f32x4*)(WGl + g * D + 256 * j + 4 * lane); s += (h[j].x * w.x + h[j].y * w.y) + (h[j].z * w.z + h[j].w * w.w); }
        p[g] = wave_sum(s) + bg[g]; }
    if (lane == 0) { *(f32x4*)grow = (f32x4){p[0], p[1], p[2], p[3]}; *(f32x4*)(grow + 4) = (f32x4){p[4], p[5], p[6], p[7]}; }
}
template <int NR> __device__ __forceinline__ void gates_rows(const f32x4 (&h)[NR][4], const float* WGl, const float* bg, float* grow0, int lane) {
    float p[NR][8];
#pragma unroll
    for (int g = 0; g < 8; ++g) { f32x4 w[4];
#pragma unroll
        for (int j = 0; j < 4; ++j) w[j] = *(const f32x4*)(WGl + g * D + 256 * j + 4 * lane);
#pragma unroll
        for (int r = 0; r < NR; ++r) { float s = 0.f;
#pragma unroll
            for (int j = 0; j < 4; ++j) s += (h[r][j].x * w[j].x + h[r][j].y * w[j].y) + (h[r][j].z * w[j].z + h[r][j].w * w[j].w);
            p[r][g] = wave_sum(s) + bg[g]; } }
    if (lane == 0) {
#pragma unroll
        for (int r = 0; r < NR; ++r) { *(f32x4*)(grow0 + r * 8) = (f32x4){p[r][0], p[r][1], p[r][2], p[r][3]}; *(f32x4*)(grow0 + r * 8 + 4) = (f32x4){p[r][4], p[r][5], p[r][6], p[r][7]}; } }
}
constexpr int RW = 4;
__device__ __forceinline__ void pro_b(Frame& F) {
    const int tid = opaque_tid(), lane = tid & 63, wave = __builtin_amdgcn_readfirstlane(tid >> 6), gw = blockIdx.x * NWAVES + wave, NGW = F.G * NWAVES; (void)tid;
    const float* mod = (const float*)(F.ws + WS_MOD); bf16* H = (bf16*)(F.ws + WS_H); float* gates = (float*)(F.ws + WS_GATES); const float* WG = (const float*)(F.ws + WS_WG);
    for (int row0 = gw * RW; row0 < M; row0 += NGW * RW) {
        const int b = row0 >> 13; const float* mb = mod + (size_t)(0 * 2 + b) * 6144;
        f32x4 h[RW][4];
#pragma unroll
        for (int r = 0; r < RW; ++r)
#pragma unroll
            for (int j = 0; j < 4; ++j) h[r][j] = *(const f32x4*)(F.x + (size_t)(row0 + r) * D + 256 * j + 4 * lane);
#pragma unroll
        for (int r = 0; r < RW; ++r) { store_row_bf16((bf16*)(F.ws + WS_X) + (size_t)(row0 + r) * D, h[r], lane);
            modulate(h[r], h[r], mb + 1024, mb, lane); store_row_bf16(H + (size_t)(row0 + r) * D, h[r], lane); }
        gates_rows<RW>(h, WG, F.a_b_gate, gates + (size_t)row0 * 8, lane);
    }
}
template <bool DRY> __device__ __forceinline__ void phase_r1(Frame& F, int l) {
    const int tid = opaque_tid(), lane = tid & 63, wave = __builtin_amdgcn_readfirstlane(tid >> 6), fr = lane & 15, fq = lane >> 4;
    const float* mod = (const float*)(F.ws + WS_MOD); bf16* H = (bf16*)(F.ws + WS_H); const bf16* ymix = (const bf16*)(F.ws + WS_YMIX);
    const float* WR = (const float*)(F.ws + WS_WR) + (size_t)l * 48 * D;
    unsigned* cnt = F.ctl + CW_CNT + l * 32 * 64;     int* list = (int*)(F.ws + WS_LIST); unsigned* route = (unsigned*)(F.ws + WS_ROUTE);
    bf16* const xres = (bf16*)(F.ws + WS_X);
    constexpr int HSP = 1028, RB = 2, BR = NWAVES * RB;
    LAS float* HS = (LAS float*)F.lds; LAS float* PS = (LAS float*)(F.lds + 100864); LAS float* LG = (LAS float*)(F.lds + 125440);
    LAS float* VEC = (LAS float*)(F.lds + 67584);
    {
        const float* const m0 = mod + (size_t)(l * 2 + 0) * 6144; const float* const m1 = mod + (size_t)(l * 2 + 1) * 6144;
        const float* const p0 = F.ln_g + (size_t)(l * 2 + 0) * D; const float* const p1 = F.ln_b + (size_t)(l * 2 + 0) * D;
        const float* const p2 = m0 + 2048; const float* const p3 = m0 + 4096; const float* const p4 = m0 + 3072; const float* const p5 = m1 + 2048; const float* const p6 = m1 + 4096; const float* const p7 = m1 + 3072;
        const bool hi = tid >= 256; const int e = (tid & 255) * 4;
        const f32x4 a = *(const f32x4*)((hi ? p1 : p0) + e), b = *(const f32x4*)((hi ? p3 : p2) + e), c = *(const f32x4*)((hi ? p5 : p4) + e), d = *(const f32x4*)((hi ? p7 : p6) + e);
        LAS float* dst = VEC + (hi ? 1024 : 0) + e;
        *(LAS f32x4*)(dst) = a; *(LAS f32x4*)(dst + 2048) = b; *(LAS f32x4*)(dst + 4096) = c; *(LAS f32x4*)(dst + 6144) = d;
        if (tid < 36) VEC[8192 + tid] = tid < 4 ? F.b_r1[l * 4 + tid] : F.b_r2[l * 32 + tid - 4];
    }
    f32x4 b4[8][3];
#pragma unroll
    for (int mi = 0; mi < 8; ++mi)
#pragma unroll
        for (int ct = 0; ct < 3; ++ct) b4[mi][ct] = *(const f32x4*)(WR + (size_t)(16 * ct + fr) * D + 16 * (8 * wave + mi) + 4 * fq);
    int pe = 0, prow0 = -1; unsigned pp0 = 0u, pp1 = 0u; float pw0 = 0.f, pw1 = 0.f;
    auto flush = [&]() { if (prow0 >= 0 && lane < RB) { const int prow = prow0 + lane, pe0 = pe & 255, pe1 = pe >> 8; list[pe0 * 16384 + (int)pp0] = prow; list[pe1 * 16384 + (int)pp1] = prow;
            *(v4u*)(route + (size_t)prow * 8) = (v4u){(unsigned)pe0, pp0, (unsigned)pe1, pp1}; *(v2u*)(route + (size_t)prow * 8 + 4) = (v2u){f2u(pw0), f2u(pw1)}; } prow0 = -1; };
    auto route_rows = [&](int r0) {
        if (lane < RB) {
            const LAS float* lg = LG + (wave * RB + lane) * 40;
            const float l10 = lg[0], l11 = lg[1], l12 = lg[2], l13 = lg[3];
            int gi = 0; float mx = l10;
            if (l11 > mx) { mx = l11; gi = 1; }
            if (l12 > mx) { mx = l12; gi = 2; }
            if (l13 > mx) { mx = l13; gi = 3; }
            const float pg = 1.f / (expf(l10 - mx) + expf(l11 - mx) + expf(l12 - mx) + expf(l13 - mx));
            int j0 = 0; float v0 = lg[4 + gi * 8];
            for (int j = 1; j < 8; ++j) { const float t = lg[4 + gi * 8 + j]; if (t > v0) { v0 = t; j0 = j; } }
            int j1 = -1; float v1 = -3.0e38f;
            for (int j = 0; j < 8; ++j) { const float t = lg[4 + gi * 8 + j]; if (j != j0 && t > v1) { v1 = t; j1 = j; } }
            const float ee = expf(v1 - v0);
            pw0 = pg / (1.f + ee); pw1 = pg * ee / (1.f + ee); const int pe0 = gi * 8 + j0, pe1 = gi * 8 + j1; pe = pe0 | (pe1 << 8);
            pp0 = __hip_atomic_fetch_add(cnt + pe0 * 64, DRY ? 0u : 1u, RLX_AGENT); pp1 = __hip_atomic_fetch_add(cnt + pe1 * 64, DRY ? 0u : 1u, RLX_AGENT);
        }
        prow0 = r0; };
    int lrow0 = -1;
    v2u xv[RB][4], yv[RB][4];
    auto request = [&](int r0) {
#pragma unroll
        for (int r = 0; r < RB; ++r)
#pragma unroll
            for (int j = 0; j < 4; ++j) { xv[r][j] = *(const v2u*)(xres + (size_t)(r0 + r) * D + 256 * j + 4 * lane); yv[r][j] = *(const v2u*)(ymix + (size_t)(r0 + r) * D + 256 * j + 4 * lane); } };
    int rowb = blockIdx.x * BR;
    if (rowb < M) request(rowb + wave * RB);
    __syncthreads();
    for (; rowb < M; rowb += F.G * BR) {
        const int row0 = rowb + wave * RB; const int b = row0 >> 13;
        const LAS float* vl = VEC + 4 * lane; const LAS float* vg1 = vl + (2 + 3 * b) * 1024;
        f32x4 h[RB][4];
#pragma unroll
        for (int j = 0; j < 4; ++j) { const f32x4 g1 = *(const LAS f32x4*)(vg1 + 256 * j);
#pragma unroll
            for (int r = 0; r < RB; ++r) { const v2u a = yv[r][j], x = xv[r][j]; h[r][j] = (f32x4){bflo(x.x), bfhi(x.x), bflo(x.y), bfhi(x.y)} * ALPHA + (1.f + g1) * (f32x4){bflo(a.x), bfhi(a.x), bflo(a.y), bfhi(a.y)}; } }
        { const int nb = rowb + F.G * BR; if (nb < M) request(nb + wave * RB); }
#pragma unroll
        for (int r = 0; r < RB; ++r) { float s = 0.f;
#pragma unroll
            for (int j = 0; j < 4; ++j) s += (h[r][j].x + h[r][j].y) + (h[r][j].z + h[r][j].w);
            const float mean = wave_sum(s) * (1.f / D); float q = 0.f;
#pragma unroll
            for (int j = 0; j < 4; ++j) { h[r][j] = h[r][j] - mean; q += (h[r][j].x * h[r][j].x + h[r][j].y * h[r][j].y) + (h[r][j].z * h[r][j].z + h[r][j].w * h[r][j].w); }
            const float rstd = 1.f / sqrtf(wave_sum(q) * (1.f / D) + LN_EPS);
#pragma unroll
            for (int j = 0; j < 4; ++j) h[r][j] = h[r][j] * rstd * *(const LAS f32x4*)(vl + 256 * j) + *(const LAS f32x4*)(vl + 1024 + 256 * j); }
#pragma unroll
        for (int r = 0; r < RB; ++r) {
            store_row_bf16(xres + (size_t)(row0 + r) * D, h[r], lane);
#pragma unroll
            for (int j = 0; j < 4; ++j) h[r][j] = h[r][j] * (1.f + *(const LAS f32x4*)(vg1 + 1024 + 256 * j)) + *(const LAS f32x4*)(vg1 + 2048 + 256 * j);
            store_row_bf16(H + (size_t)(row0 + r) * D, h[r], lane); }
#pragma unroll
        for (int r = 0; r < RB; ++r)
#pragma unroll
            for (int j = 0; j < 4; ++j) *(LAS f32x4*)(HS + (wave * RB + r) * HSP + 256 * j + 4 * lane) = h[r][j];
        __syncthreads();
        flush();
        if (lrow0 >= 0) route_rows(lrow0);
        f32x4 lacc[3];
#pragma unroll
        for (int ct = 0; ct < 3; ++ct) lacc[ct] = (f32x4){0.f, 0.f, 0.f, 0.f};
#pragma unroll
        for (int mi = 0; mi < 8; ++mi) { const f32x4 a0 = *(const LAS f32x4*)(HS + fr * HSP + 16 * (8 * wave + mi) + 4 * fq);
#pragma unroll
            for (int i = 0; i < 4; ++i)
#pragma unroll
                for (int ct = 0; ct < 3; ++ct) lacc[ct] = __builtin_amdgcn_mfma_f32_16x16x4f32(a0[i], b4[mi][ct][i], lacc[ct], 0, 0, 0); }
#pragma unroll
        for (int ct = 0; ct < 3; ++ct) *(LAS f32x4*)(PS + ((wave * 3 + ct) * 64 + lane) * 4) = lacc[ct];
        __syncthreads();
#pragma unroll
        for (int i = 0; i < 2; ++i) { const int idx = tid + 512 * i;
            if (idx < 768) { const int j = idx & 3, ln = (idx >> 2) & 63, ct = idx >> 8; const int off = (ct * 64 + ln) * 4 + j; float v = 0.f;
#pragma unroll
                for (int ks = 0; ks < 8; ++ks) v += PS[off + ks * 768];
                const int rowl = 4 * (ln >> 4) + j, col = 16 * ct + (ln & 15);
                if (col < 36) LG[rowl * 40 + col] = v + VEC[8192 + col]; } }
        lrow0 = row0;
    }
    __syncthreads();
    flush();
    if (lrow0 >= 0) route_rows(lrow0);
    flush();
}
template <int NR> __device__ __forceinline__ void gates_rows_lds(const f32x4 (&h)[NR][4], const LAS float* W, const float* bg, float* grow0, int lane) {
    float p[NR][8];
#pragma unroll
    for (int g = 0; g < 8; ++g) { f32x4 w[4];
#pragma unroll
        for (int j = 0; j < 4; ++j) w[j] = *(const LAS f32x4*)(W + g * D + 256 * j + 4 * lane);
#pragma unroll
        for (int r = 0; r < NR; ++r) { float s = 0.f;
#pragma unroll
            for (int j = 0; j < 4; ++j) s += (h[r][j].x * w[j].x + h[r][j].y * w[j].y) + (h[r][j].z * w[j].z + h[r][j].w * w[j].w);
            p[r][g] = wave_sum(s) + bg[g]; } }
    if (lane == 0) {
#pragma unroll
        for (int r = 0; r < NR; ++r) { *(f32x4*)(grow0 + r * 8) = (f32x4){p[r][0], p[r][1], p[r][2], p[r][3]}; *(f32x4*)(grow0 + r * 8 + 4) = (f32x4){p[r][4], p[r][5], p[r][6], p[r][7]}; } }
}
template <bool DRY> __device__ __forceinline__ void phase_r2(Frame& F, int l) {
    const int tid = opaque_tid(), lane = tid & 63, wave = __builtin_amdgcn_readfirstlane(tid >> 6), gw = blockIdx.x * NWAVES + wave, NGW = F.G * NWAVES;
    const float* mod = (const float*)(F.ws + WS_MOD); bf16* H = (bf16*)(F.ws + WS_H); const bf16* Y = (const bf16*)(F.ws + WS_Y);
    float* gates = (float*)(F.ws + WS_GATES); const float* WG = (const float*)(F.ws + WS_WG);
    const unsigned* route = (const unsigned*)(F.ws + WS_ROUTE);
    bf16* const xres = (bf16*)(F.ws + WS_X);
    constexpr int RB = 2;
    const bool has_next = l < DEPTH - 1, has_gates = l + 1 < NA;
    LAS float* VEC = (LAS float*)F.lds;
    LAS float* WGS = VEC + 8192;
    {
        const int ln = has_next ? l + 1 : l;
        const float* const m0 = mod + (size_t)(l * 2 + 0) * 6144; const float* const m1 = mod + (size_t)(l * 2 + 1) * 6144;
        const float* const n0 = mod + (size_t)(ln * 2 + 0) * 6144; const float* const n1 = mod + (size_t)(ln * 2 + 1) * 6144;
        const float* const p0 = F.ln_g + (size_t)(l * 2 + 1) * D; const float* const p1 = F.ln_b + (size_t)(l * 2 + 1) * D;
        const float* const p2 = m0 + 5120; const float* const p3 = m1 + 5120; const float* const p4 = n0 + 1024; const float* const p5 = n0; const float* const p6 = n1 + 1024; const float* const p7 = n1;
        const bool hi = tid >= 256; const int e = (tid & 255) * 4;
        const f32x4 a = *(const f32x4*)((hi ? p1 : p0) + e), b = *(const f32x4*)((hi ? p3 : p2) + e), c = *(const f32x4*)((hi ? p5 : p4) + e), d = *(const f32x4*)((hi ? p7 : p6) + e);
        LAS float* dst = VEC + (hi ? 1024 : 0) + e;
        *(LAS f32x4*)(dst) = a; *(LAS f32x4*)(dst + 2048) = b; *(LAS f32x4*)(dst + 4096) = c; *(LAS f32x4*)(dst + 6144) = d;
        if (has_gates) { const float* wn = WG + (size_t)(l + 1) * 8 * D + tid * 4;
#pragma unroll
            for (int k = 0; k < 4; ++k) *(LAS f32x4*)(WGS + tid * 4 + 2048 * k) = *(const f32x4*)(wn + 2048 * k); }
    }
    int excl;
    { const int cn = lane < 32 ? (int)__hip_atomic_load(F.ctl + CW_CNT + (l * 32 + lane) * 64, RLX_AGENT) : 0; const int nb = (cn + 255) >> 8; int inc = nb;
#pragma unroll
      for (int o = 1; o < 32; o <<= 1) { const int t = lane_up(inc, o, lane); if (lane >= o) inc += t; }
      excl = inc - nb; }
    __syncthreads();
    v4u q0 = (v4u){0u, 0u, 0u, 0u}; v2u q1 = (v2u){0u, 0u};
    auto load_route = [&](int rowa) { const size_t rr = (size_t)(rowa + (lane < RB ? lane : 0)) * 8; q0 = *(const v4u*)(route + rr); q1 = *(const v2u*)(route + rr + 4); };
    v2u xv[RB][4], ya[RB][4], yc[RB][4]; float w0[RB], w1[RB];
    auto request = [&](int rowa) {
        const unsigned q0x = q0.x, q0y = q0.y, q0z = q0.z, q0w = q0.w, q1x = q1.x, q1y = q1.y;
#pragma unroll
        for (int r = 0; r < RB; ++r) {
            const int e0 = __builtin_amdgcn_readlane((int)q0x, r), p0 = __builtin_amdgcn_readlane((int)q0y, r), e1 = __builtin_amdgcn_readlane((int)q0z, r), p1 = __builtin_amdgcn_readlane((int)q0w, r);
            w0[r] = u2f((unsigned)__builtin_amdgcn_readlane((int)q1x, r)); w1[r] = u2f((unsigned)__builtin_amdgcn_readlane((int)q1y, r));
            const int s0 = __builtin_amdgcn_readlane(excl, e0) * 256 + p0, s1 = __builtin_amdgcn_readlane(excl, e1) * 256 + p1;
#pragma unroll
            for (int j = 0; j < 4; ++j) { xv[r][j] = *(const v2u*)(xres + (size_t)(rowa + r) * D + 256 * j + 4 * lane);
                ya[r][j] = *(const v2u*)(Y + (size_t)s0 * D + 256 * j + 4 * lane); yc[r][j] = *(const v2u*)(Y + (size_t)s1 * D + 256 * j + 4 * lane); } } };
    const int step = NGW * RB;
    int row0 = gw * RB;
    if (row0 < M) { load_route(row0); request(row0); if (row0 + step < M) load_route(row0 + step); }
    const float* bg = F.a_b_gate + (has_gates ? (l + 1) * 8 : 0);
    for (; row0 < M; row0 += step) {
        const int b = row0 >> 13; const LAS float* vl = VEC + 4 * lane;
        f32x4 v[RB][4];
#pragma unroll
        for (int j = 0; j < 4; ++j) { const f32x4 g2 = *(const LAS f32x4*)(vl + (2 + b) * 1024 + 256 * j);
#pragma unroll
            for (int r = 0; r < RB; ++r) { const v2u a = ya[r][j], c = yc[r][j];
                const f32x4 y = (f32x4){bflo(a.x), bfhi(a.x), bflo(a.y), bfhi(a.y)} * w0[r] + (f32x4){bflo(c.x), bfhi(c.x), bflo(c.y), bfhi(c.y)} * w1[r];
                const v2u x = xv[r][j]; v[r][j] = (f32x4){bflo(x.x), bfhi(x.x), bflo(x.y), bfhi(x.y)} * ALPHA + (1.f + g2) * y; } }
        if (row0 + step < M) { request(row0 + step); if (row0 + 2 * step < M) load_route(row0 + 2 * step); }
#pragma unroll
        for (int r = 0; r < RB; ++r) { float s = 0.f;
#pragma unroll
            for (int j = 0; j < 4; ++j) s += (v[r][j].x + v[r][j].y) + (v[r][j].z + v[r][j].w);
            const float mean = wave_sum(s) * (1.f / D); float q = 0.f;
#pragma unroll
            for (int j = 0; j < 4; ++j) { v[r][j] = v[r][j] - mean; q += (v[r][j].x * v[r][j].x + v[r][j].y * v[r][j].y) + (v[r][j].z * v[r][j].z + v[r][j].w * v[r][j].w); }
            const float rstd = 1.f / sqrtf(wave_sum(q) * (1.f / D) + LN_EPS);
#pragma unroll
            for (int j = 0; j < 4; ++j) v[r][j] = v[r][j] * rstd * *(const LAS f32x4*)(vl + 256 * j) + *(const LAS f32x4*)(vl + 1024 + 256 * j); }
#pragma unroll
        for (int r = 0; r < RB; ++r) { const int row = row0 + r;
            if (l == DEPTH - 1) {
#pragma unroll
                for (int j = 0; j < 4; ++j) ST_NT((f32x4*)(F.out + (size_t)row * D + 256 * j + 4 * lane), v[r][j]); }
            else store_row_bf16(xres + (size_t)row * D, v[r], lane);
            if (has_next) {
#pragma unroll
                for (int j = 0; j < 4; ++j) v[r][j] = v[r][j] * (1.f + *(const LAS f32x4*)(vl + (4 + 2 * b) * 1024 + 256 * j)) + *(const LAS f32x4*)(vl + (5 + 2 * b) * 1024 + 256 * j);
                store_row_bf16(H + (size_t)row * D, v[r], lane);
            } }
        if (has_gates) gates_rows_lds<RB>(v, WGS, bg, gates + (size_t)row0 * 8, lane);
    }
}

typedef short bf16x8 __attribute__((ext_vector_type(8)));
#define MFMA16(a, b, c) __builtin_amdgcn_mfma_f32_16x16x32_bf16((a), (b), (c), 0, 0, 0)
constexpr int RS = 136;
template <bool MAXOP> __device__ __forceinline__ float block_scan256(float v, LAS float* scr, int lane, int wave) {
#pragma unroll
    for (int o = 1; o < 64; o <<= 1) { const float t = lane_up(v, o, lane); if (lane >= o) v = MAXOP ? fmaxf(v, t) : v + t; }
    if (lane == 63 && wave < 4) scr[wave] = v;
    __syncthreads();
    float add = MAXOP ? -3.0e38f : 0.f;
#pragma unroll
    for (int w = 0; w < 3; ++w) if (w < wave) add = MAXOP ? fmaxf(add, scr[w]) : add + scr[w];
    v = MAXOP ? fmaxf(v, add) : v + add;
    __syncthreads();
    return v;
}
__device__ __forceinline__ bf16x8 lds_frag16(const LAS bf16* p) { return __builtin_bit_cast(bf16x8, *(const LAS v4u*)p); }
template <int O0, int O1, int O2, int O3, int O4, int O5, int O6, int O7>
__device__ __forceinline__ void tr_read8(unsigned a, v2u& r0, v2u& r1, v2u& r2, v2u& r3, v2u& r4, v2u& r5, v2u& r6, v2u& r7) {
    asm volatile("ds_read_b64_tr_b16 %0, %8 offset:%9\n\tds_read_b64_tr_b16 %1, %8 offset:%10\n\tds_read_b64_tr_b16 %2, %8 offset:%11\n\tds_read_b64_tr_b16 %3, %8 offset:%12\n\t"
                 "ds_read_b64_tr_b16 %4, %8 offset:%13\n\tds_read_b64_tr_b16 %5, %8 offset:%14\n\tds_read_b64_tr_b16 %6, %8 offset:%15\n\tds_read_b64_tr_b16 %7, %8 offset:%16\n\t"
                 "s_waitcnt lgkmcnt(0)"
                 : "=&v"(r0), "=&v"(r1), "=&v"(r2), "=&v"(r3), "=&v"(r4), "=&v"(r5), "=&v"(r6), "=&v"(r7)
                 : "v"(a), "i"(O0), "i"(O1), "i"(O2), "i"(O3), "i"(O4), "i"(O5), "i"(O6), "i"(O7) : "memory");
}
__device__ __forceinline__ bf16x8 frag_lh(v2u lo, v2u hi) { return __builtin_bit_cast(bf16x8, (v4u){lo.x, lo.y, hi.x, hi.y}); }

__device__ __forceinline__ void ml_a(Frame& F) {
    const int tid = opaque_tid(), lane = tid & 63, wave = __builtin_amdgcn_readfirstlane(tid >> 6), fr = lane & 15, fq = lane >> 4;
    LAS unsigned char* KWb = F.lds;
    LAS unsigned char* VRb = F.lds + 18432;
    constexpr int KPB = 288, VPB = 544;
    const unsigned krd = (unsigned)(__UINTPTR_TYPE__)KWb + (4 * fq + (fr >> 2)) * KPB + (lane & 3) * 8;
    const unsigned vrd = (unsigned)(__UINTPTR_TYPE__)VRb + (4 * fq + (fr >> 2)) * VPB + (lane & 3) * 8 + wave * 64;
    const bf16x8 ones = __builtin_bit_cast(bf16x8, (v4u){0x3f803f80u, 0x3f803f80u, 0x3f803f80u, 0x3f803f80u});
    LAS float* wv = (LAS float*)(F.lds + 55296);
    LAS float* scr = (LAS float*)(F.lds + 56320);
    const bf16* proj = (const bf16*)(F.ws + WS_PROJ); const float* gates = (const float*)(F.ws + WS_GATES);
    float* Bv = (float*)(F.ws + WS_MLS); float* Mloc = Bv + 256; float* dn = (float*)(F.ws + WS_MLS + 65536); float* dC = (float*)(F.ws + WS_DC);
    for (int u = blockIdx.x; u < 256; u += F.G) {
        const int bh = u >> 5, c = u & 31, b = bh >> 2, h = bh & 3, t0 = b * SEQ + c * CH;
        v4u kreg[2], vreg[4];
        auto request = [&](int sb) { const bf16* rows = proj + (size_t)(t0 + sb * 64) * NPROJ;
#pragma unroll
            for (int i = 0; i < 2; ++i) { const int p = tid + 512 * i, s = p >> 4, part = p & 15; kreg[i] = *(const v4u*)(rows + (size_t)s * NPROJ + 512 + h * DQK + part * 8); }
#pragma unroll
            for (int i = 0; i < 4; ++i) { const int p = tid + 512 * i, s = p >> 5, part = p & 31; vreg[i] = *(const v4u*)(rows + (size_t)s * NPROJ + 1024 + h * DV + part * 8); } };
        request(0);
        float ip = 0.f, lf = 0.f;
        if (tid < 256) { ip = gates[(size_t)(t0 + tid) * 8 + h]; lf = logsigmoidf_(gates[(size_t)(t0 + tid) * 8 + 4 + h]); }
        const float bs = block_scan256<false>(lf, scr, lane, wave);
        const float as = tid < 256 ? ip - bs : -3.0e38f;
        const float wm = wave_max(as); if (lane == 0) scr[wave] = wm;
        __syncthreads();
        float mloc = scr[0];
#pragma unroll
        for (int w = 1; w < 8; ++w) mloc = fmaxf(mloc, scr[w]);
        if (tid < 256) wv[tid] = expf(as - mloc);
        if (tid == 255) { Bv[u] = bs; Mloc[u] = mloc; }
        f32x4 acc[2][8];
#pragma unroll
        for (int i = 0; i < 2; ++i)
#pragma unroll
            for (int j = 0; j < 8; ++j) acc[i][j] = (f32x4){0.f, 0.f, 0.f, 0.f};
        f32x4 dn4 = (f32x4){0.f, 0.f, 0.f, 0.f};
#pragma unroll 1
        for (int sb = 0; sb < 4; ++sb) {
            __syncthreads();
#pragma unroll
            for (int i = 0; i < 2; ++i) { const int p = tid + 512 * i, s = p >> 4, part = p & 15; v4u a = kreg[i]; const float w = wv[sb * 64 + s];
                a.x = pk2(bflo(a.x) * w, bfhi(a.x) * w); a.y = pk2(bflo(a.y) * w, bfhi(a.y) * w); a.z = pk2(bflo(a.z) * w, bfhi(a.z) * w); a.w = pk2(bflo(a.w) * w, bfhi(a.w) * w);
                *(LAS v4u*)(KWb + s * KPB + part * 16) = a; }
#pragma unroll
            for (int i = 0; i < 4; ++i) { const int p = tid + 512 * i, s = p >> 5, part = p & 31; *(LAS v4u*)(VRb + s * VPB + part * 16) = vreg[i]; }
            __syncthreads();
            if (sb < 3) request(sb + 1);
            v2u va[8];
            tr_read8<0, 16 * VPB, 32, 16 * VPB + 32, 32 * VPB, 48 * VPB, 32 * VPB + 32, 48 * VPB + 32>(vrd, va[0], va[1], va[2], va[3], va[4], va[5], va[6], va[7]);
#define ML_A_STEP(KS, HF) { v2u kb[8]; constexpr int KO = (KS) * 32 * KPB + (HF) * 128; \
                tr_read8<KO, KO + 16 * KPB, KO + 32, KO + 16 * KPB + 32, KO + 64, KO + 16 * KPB + 64, KO + 96, KO + 16 * KPB + 96>(krd, kb[0], kb[1], kb[2], kb[3], kb[4], kb[5], kb[6], kb[7]); \
                const bf16x8 a0 = frag_lh(va[4 * (KS)], va[4 * (KS) + 1]), a1 = frag_lh(va[4 * (KS) + 2], va[4 * (KS) + 3]); \
                _Pragma("unroll") for (int d4 = 0; d4 < 4; ++d4) { const int dt = 4 * (HF) + d4; const bf16x8 bb = frag_lh(kb[2 * d4], kb[2 * d4 + 1]); \
                    acc[0][dt] = MFMA16(a0, bb, acc[0][dt]); acc[1][dt] = MFMA16(a1, bb, acc[1][dt]); if (dt == wave) dn4 = MFMA16(ones, bb, dn4); } }
            ML_A_STEP(0, 0) ML_A_STEP(0, 1) ML_A_STEP(1, 0) ML_A_STEP(1, 1)
#undef ML_A_STEP
        }
        float* dCu = dC + (size_t)u * 32768;
#pragma unroll
        for (int i = 0; i < 2; ++i) { float* const bp = dCu + (size_t)((32 * wave + 16 * i + 4 * fq) * 128 + fr);
#pragma unroll
            for (int dt = 0; dt < 8; ++dt)
#pragma unroll
                for (int j = 0; j < 4; ++j) bp[j * 128 + 16 * dt] = acc[i][dt][j]; }
        if (fq == 0) dn[u * 128 + 16 * wave + fr] = dn4[0];
        __syncthreads();
    }
}
__device__ __forceinline__ void ml_scan(Frame& F) {
    const int tid = opaque_tid(), lane = tid & 63; (void)lane;
    const float* Bv = (const float*)(F.ws + WS_MLS); const float* Mloc = Bv + 256; float* Min = (float*)(F.ws + WS_MLS) + 512;
    const float* dn = (const float*)(F.ws + WS_MLS + 65536); float* nin = (float*)(F.ws + WS_MLS + 262144);
    const float* dC = (const float*)(F.ws + WS_DC); unsigned* CinT = (unsigned*)(F.ws + WS_CIN);
    LAS float* sB = (LAS float*)F.lds; LAS float* sM = sB + 32; LAS float* f1 = sB + 64; LAS float* f2 = sB + 96; LAS float* ms = sB + 128;
    for (int it0 = blockIdx.x * (NWAVES * 64); it0 < 8 * 16384; it0 += F.G * NWAVES * 64) {
        const int bh = it0 >> 14, e2 = (it0 & 16383) + tid;
        f32x2 d[NCH];
#pragma unroll
        for (int c = 0; c < NCH; ++c) d[c] = *(const f32x2*)(dC + (size_t)(bh * NCH + c) * 32768 + 2 * e2);
        __syncthreads();
        if (tid < NCH) { sB[tid] = Bv[bh * NCH + tid]; sM[tid] = Mloc[bh * NCH + tid]; }
        __syncthreads();
        if (tid == 0) { float m = 0.f;
            for (int c = 0; c < NCH; ++c) { const float ml = sM[c], mm = fmaxf(m, ml); ms[c] = m; f1[c] = expf(m - mm); f2[c] = expf(ml - mm); m = sB[c] + mm; } }
        __syncthreads();
        f32x2 C = (f32x2){0.f, 0.f};
#pragma unroll
        for (int c = 0; c < NCH; ++c) { CinT[(size_t)(bh * NCH + c) * 16384 + e2] = pk2(C.x, C.y); C = C * f1[c] + d[c] * f2[c]; }
        if ((it0 & 16383) == 0) {
            if (tid < 128) { float n = 0.f;
                for (int c = 0; c < NCH; ++c) { nin[(bh * NCH + c) * 128 + tid] = n; n = n * f1[c] + dn[(bh * NCH + c) * 128 + tid] * f2[c]; } }
            if (tid < NCH) Min[bh * NCH + tid] = ms[tid];
        }
    }
}
__device__ __forceinline__ void ml_c(Frame& F, int l) {
    const int tid = opaque_tid(), lane = tid & 63, wave = __builtin_amdgcn_readfirstlane(tid >> 6), fr = lane & 15, fq = lane >> 4;
    LAS bf16* CT = (LAS bf16*)(F.lds);
    LAS bf16* KB = (LAS bf16*)(F.lds + 69632);
    LAS unsigned char* VRb = F.lds + 87040;
    constexpr int VPB = 544;
    LAS float* eav = (LAS float*)(F.lds + 123904);
    LAS float* etv = eav + 256;
    LAS float* iwv = eav + 512;
    LAS float* thv = eav + 768;
    LAS bf16* NB = (LAS bf16*)(F.lds + 128000);
    LAS float* scr = (LAS float*)(F.lds + 128256);
    const bf16* proj = (const bf16*)(F.ws + WS_PROJ); const float* gates = (const float*)(F.ws + WS_GATES);
    const float* Min = (const float*)(F.ws + WS_MLS) + 512; const float* nin = (const float*)(F.ws + WS_MLS + 262144); const bf16* CinT = (const bf16*)(F.ws + WS_CIN);
    bf16* YA = (bf16*)(F.ws + WS_YA);
    const bf16x8 ones = __builtin_bit_cast(bf16x8, (v4u){0x3f803f80u, 0x3f803f80u, 0x3f803f80u, 0x3f803f80u});
    for (int u = blockIdx.x; u < 256; u += F.G) {
        const int bh = u >> 5, c = u & 31, b = bh >> 2, h = bh & 3, t0 = b * SEQ + c * CH;
        v4u cin[8];
        { const bf16* src = CinT + (size_t)u * 32768;
#pragma unroll
          for (int i = 0; i < 8; ++i) { const int p = tid + 512 * i, v = p >> 4, part = p & 15; cin[i] = *(const v4u*)(src + v * 128 + part * 8); } }
        float ip = 0.f, lf = 0.f;
        if (tid < 256) { ip = gates[(size_t)(t0 + tid) * 8 + h]; lf = logsigmoidf_(gates[(size_t)(t0 + tid) * 8 + 4 + h]); }
        const float bs = block_scan256<false>(lf, scr, lane, wave);
        const float as = tid < 256 ? ip - bs : -3.0e38f;
        const float pm = block_scan256<true>(as, scr, lane, wave);
        const float wm = wave_max(as); if (lane == 0) scr[wave] = wm;
        __syncthreads();
        float mloc = scr[0];
#pragma unroll
        for (int w = 1; w < 8; ++w) mloc = fmaxf(mloc, scr[w]);
        const float m_in = Min[u];
        if (tid < 256) { const float mt = bs + fmaxf(m_in, pm); eav[tid] = expf(as - mloc); etv[tid] = expf(bs + mloc - mt); iwv[tid] = expf(bs + m_in - mt); thv[tid] = expf(-mt); }
        if (tid < 64) { const f32x2 n2 = *(const f32x2*)(nin + u * 128 + 2 * tid); ((LAS unsigned*)NB)[tid] = pk2(n2.x, n2.y); }
#pragma unroll
        for (int i = 0; i < 8; ++i) { const int p = tid + 512 * i, v = p >> 4, part = p & 15; *(LAS v4u*)(CT + v * RS + part * 8) = cin[i]; }
        __syncthreads();
#pragma unroll 1
        for (int pass = 0; pass < 2; ++pass) {
            const int tt = pass == 0 ? 15 - wave : wave, nsb = pass == 0 ? 4 : 2;
            const int tmax = 16 * tt + 15, tq = 16 * tt + fr; const size_t row = (size_t)(t0 + tq);
            bf16x8 qf[4];
#pragma unroll
            for (int ks = 0; ks < 4; ++ks) qf[ks] = __builtin_bit_cast(bf16x8, *(const v4u*)(proj + row * NPROJ + h * DQK + 32 * ks + 8 * fq));
            f32x4 acc[17];
#pragma unroll
            for (int vt = 0; vt < 17; ++vt) acc[vt] = (f32x4){0.f, 0.f, 0.f, 0.f};
#pragma unroll
            for (int ks = 0; ks < 4; ++ks) {
#pragma unroll
                for (int vt = 0; vt < 16; ++vt) { acc[vt] = MFMA16(lds_frag16(CT + (16 * vt + fr) * RS + 32 * ks + 8 * fq), qf[ks], acc[vt]);
                    if ((vt & 3) == 3) __builtin_amdgcn_sched_barrier(0); }
                acc[16] = MFMA16(lds_frag16(NB + 32 * ks + 8 * fq), qf[ks], acc[16]);
            }
            { const float iw = iwv[tq];
#pragma unroll
              for (int vt = 0; vt < 17; ++vt) acc[vt] *= iw; }
            const float et = etv[tq];
            v4u kreg[2], vreg[4];
            auto request = [&](int sb) { const bf16* rows = proj + (size_t)(t0 + sb * 64) * NPROJ;
#pragma unroll
                for (int i = 0; i < 2; ++i) { const int p = tid + 512 * i, s = p >> 4, part = p & 15; kreg[i] = *(const v4u*)(rows + (size_t)s * NPROJ + 512 + h * DQK + part * 8); }
#pragma unroll
                for (int i = 0; i < 4; ++i) { const int p = tid + 512 * i, s = p >> 5, part = p & 31; vreg[i] = *(const v4u*)(rows + (size_t)s * NPROJ + 1024 + h * DV + part * 8); } };
            request(0);
#pragma unroll 1
            for (int sb = 0; sb < nsb; ++sb) {
                __syncthreads();
#pragma unroll
                for (int i = 0; i < 2; ++i) { const int p = tid + 512 * i, s = p >> 4, part = p & 15; *(LAS v4u*)(KB + s * RS + part * 8) = kreg[i]; }
#pragma unroll
                for (int i = 0; i < 4; ++i) { const int p = tid + 512 * i, s = p >> 5, part = p & 31; *(LAS v4u*)(VRb + s * VPB + part * 16) = vreg[i]; }
                __syncthreads();
                if (sb + 1 < nsb) request(sb + 1);
#pragma unroll
                for (int sp = 0; sp < 2; ++sp) {
                    const int s0 = sb * 64 + 32 * sp;
                    if (s0 <= tmax) {
                        f32x4 sa = (f32x4){0.f, 0.f, 0.f, 0.f}, sc = (f32x4){0.f, 0.f, 0.f, 0.f};
#pragma unroll
                        for (int ks = 0; ks < 4; ++ks) { sa = MFMA16(lds_frag16(KB + (32 * sp + fr) * RS + 32 * ks + 8 * fq), qf[ks], sa);
                                                         sc = MFMA16(lds_frag16(KB + (32 * sp + 16 + fr) * RS + 32 * ks + 8 * fq), qf[ks], sc); }
                        float p[8];
#pragma unroll
                        for (int j = 0; j < 4; ++j) { const int sA = s0 + 4 * fq + j, sB = sA + 16;
                            p[j] = sA <= tq ? sa[j] * eav[sA] * et : 0.f; p[4 + j] = sB <= tq ? sc[j] * eav[sB] * et : 0.f; }
                        const bf16x8 pf = __builtin_bit_cast(bf16x8, (v4u){pk2(p[0], p[1]), pk2(p[2], p[3]), pk2(p[4], p[5]), pk2(p[6], p[7])});
                        const unsigned va = (unsigned)(__UINTPTR_TYPE__)VRb + (32 * sp + 4 * fq + (fr >> 2)) * VPB + (lane & 3) * 8;
#define ML_C_PV4(G) { v2u l0, h0, l1, h1, l2, h2, l3, h3; constexpr int VO = 128 * (G); \
                        tr_read8<VO, VO + 16 * VPB, VO + 32, VO + 16 * VPB + 32, VO + 64, VO + 16 * VPB + 64, VO + 96, VO + 16 * VPB + 96>(va, l0, h0, l1, h1, l2, h2, l3, h3); \
                        acc[4 * (G)] = MFMA16(frag_lh(l0, h0), pf, acc[4 * (G)]); acc[4 * (G) + 1] = MFMA16(frag_lh(l1, h1), pf, acc[4 * (G) + 1]); \
                        acc[4 * (G) + 2] = MFMA16(frag_lh(l2, h2), pf, acc[4 * (G) + 2]); acc[4 * (G) + 3] = MFMA16(frag_lh(l3, h3), pf, acc[4 * (G) + 3]); __builtin_amdgcn_sched_barrier(0); }
                        ML_C_PV4(0) ML_C_PV4(1) ML_C_PV4(2) ML_C_PV4(3)
#undef ML_C_PV4
                        acc[16] = MFMA16(ones, pf, acc[16]);
                    }
                }
            }
            v2u ogr[16];
#pragma unroll
            for (int vt = 0; vt < 16; ++vt) ogr[vt] = *(const v2u*)(proj + row * NPROJ + 2048 + h * DV + 4 * fq + 16 * vt);
            const float dnm = 1.f / fmaxf(fabsf(acc[16][0]), thv[tq]);
            float s1 = 0.f;
#pragma unroll
            for (int vt = 0; vt < 16; ++vt) { acc[vt] *= dnm; s1 += (acc[vt][0] + acc[vt][1]) + (acc[vt][2] + acc[vt][3]); }
            s1 += lane_xor(s1, 16, lane); s1 += lane_xor(s1, 32, lane);
            const float mean = s1 * (1.f / DV); float s2 = 0.f;
#pragma unroll
            for (int vt = 0; vt < 16; ++vt) { acc[vt] -= mean; s2 += (acc[vt][0] * acc[vt][0] + acc[vt][1] * acc[vt][1]) + (acc[vt][2] * acc[vt][2] + acc[vt][3] * acc[vt][3]); }
            s2 += lane_xor(s2, 16, lane); s2 += lane_xor(s2, 32, lane);
            const float rstd = 1.f / sqrtf(s2 * (1.f / DV) + A_NORM_EPS);
            const float* ng = F.a_norm_g + l * 1024 + h * DV + 4 * fq; bf16* yp = YA + row * D + h * DV + 4 * fq;
#pragma unroll
            for (int vt = 0; vt < 16; ++vt) { const v2u og = ogr[vt]; const f32x4 g = *(const f32x4*)(ng + 16 * vt);
                const float y0 = acc[vt][0] * rstd * g.x * sigmoidf_(bflo(og.x)), y1 = acc[vt][1] * rstd * g.y * sigmoidf_(bfhi(og.x)),
                            y2 = acc[vt][2] * rstd * g.z * sigmoidf_(bflo(og.y)), y3 = acc[vt][3] * rstd * g.w * sigmoidf_(bfhi(og.y));
                *(v2u*)(yp + 16 * vt) = (v2u){pk2(y0, y1), pk2(y2, y3)}; }
        }
        __syncthreads();
    }
}

__device__ __forceinline__ void att_mfma(Frame& F) {
    const int tid = opaque_tid(), lane = tid & 63, wave = __builtin_amdgcn_readfirstlane(tid >> 6), fr = lane & 15, fq = lane >> 4;
    constexpr int NK = 384, KP = 72, VPB = 160;
    LAS bf16* Ks = (LAS bf16*)(F.lds); LAS unsigned char* Vs = F.lds + NK * KP * 2;
    const bf16* Q = (const bf16*)(F.ws + WS_Q); const bf16* KV = (const bf16*)(F.ws + WS_KV);
    bf16* OG = (bf16*)(F.ws + WS_OG); float* LSE = (float*)(F.ws + WS_LSE);
    const bf16x8 ones = __builtin_bit_cast(bf16x8, (v4u){0x3f803f80u, 0x3f803f80u, 0x3f803f80u, 0x3f803f80u});
    constexpr int NU = 1536;
    const unsigned vrd = (unsigned)(__UINTPTR_TYPE__)Vs + (4 * fq + (fr >> 2)) * VPB + (lane & 3) * 8;
    auto decode = [&](int u, int& g, int& b, int& h, int& r, int& rho, int& n2) { g = u >> 9; const int rem = u & 511; b = rem >> 8; h = (rem >> 5) & 7; const int rn = rem & 31;
        r = g == 0 ? 1 : (g == 1 ? 4 : 16); const int nb2 = 32 / r; rho = rn / nb2; n2 = rn % nb2; };
    v4u kreg[6], vreg[6]; bf16x8 qf[2][2];
    auto request = [&](int u) { int g, b, h, r, rho, n2; decode(u, g, b, h, r, rho, n2);
        const bf16* kvb = KV + (size_t)b * SEQ * NKV + g * 512 + h * 64;
#pragma unroll
        for (int i = 0; i < 6; ++i) { const int p = tid + 512 * i, kj = p >> 3, part = p & 7; const int isub = (2 * n2 - 1) * 128 + kj;
            kreg[i] = (v4u){0u, 0u, 0u, 0u}; vreg[i] = (v4u){0u, 0u, 0u, 0u};
            if (isub >= 0) { const bf16* kr = kvb + ((size_t)isub * r + rho) * NKV + part * 8; kreg[i] = *(const v4u*)kr; vreg[i] = *(const v4u*)(kr + 1536); } }
#pragma unroll
        for (int i = 0; i < 2; ++i) { const size_t tq = (size_t)b * SEQ + (size_t)(n2 * 256 + 16 * (wave + 8 * i) + fr) * r + rho;
#pragma unroll
            for (int ks = 0; ks < 2; ++ks) qf[i][ks] = __builtin_bit_cast(bf16x8, *(const v4u*)(Q + tq * NQ + g * 512 + h * 64 + 32 * ks + 8 * fq)); } };
    const int ustep = (F.G % 8 == 0) ? F.G / 8 : F.G; const int ubase = (F.G % 8 == 0) ? (int)(blockIdx.x % 8) * (NU / 8) : 0, uend = (F.G % 8 == 0) ? ubase + NU / 8 : NU;
    int u = ubase + ((F.G % 8 == 0) ? (int)(blockIdx.x / 8) : (int)blockIdx.x);
    if (u < uend) request(u);
    for (; u < uend; u += ustep) {
        int g, b, h, r, rho, n2; decode(u, g, b, h, r, rho, n2);
        __syncthreads();
#pragma unroll
        for (int i = 0; i < 6; ++i) { const int p = tid + 512 * i, kj = p >> 3, part = p & 7; *(LAS v4u*)(Ks + kj * KP + part * 8) = kreg[i]; *(LAS v4u*)(Vs + kj * VPB + part * 16) = vreg[i]; }
        bf16x8 q[2][2];
#pragma unroll
        for (int i = 0; i < 2; ++i) { q[i][0] = qf[i][0]; q[i][1] = qf[i][1]; }
        __syncthreads();
        if (u + ustep < uend) request(u + ustep);
#pragma unroll
        for (int i = 0; i < 2; ++i) {
            const int tt = wave + 8 * i, qi = 16 * tt + fr;
            const size_t tokq = (size_t)b * SEQ + (size_t)(n2 * 256 + qi) * r + rho;
            const int pi0 = tt >> 1;
            f32x4 sc[5][2];
#pragma unroll
            for (int pi = 0; pi < 5; ++pi)
#pragma unroll
                for (int st = 0; st < 2; ++st) { const int tile = 2 * (pi0 + pi) + st; f32x4 a = (f32x4){0.f, 0.f, 0.f, 0.f};
                    a = MFMA16(lds_frag16(Ks + (16 * tile + fr) * KP + 8 * fq), q[i][0], a); a = MFMA16(lds_frag16(Ks + (16 * tile + fr) * KP + 32 + 8 * fq), q[i][1], a);
                    sc[pi][st] = a; }
            const float NEG = -__builtin_inff();
#pragma unroll
            for (int st = 0; st < 2; ++st)
#pragma unroll
                for (int j = 0; j < 4; ++j) { const int k0 = 32 * pi0 + 16 * st + 4 * fq + j; sc[0][st][j] = k0 >= qi ? sc[0][st][j] : NEG; sc[4][st][j] = k0 + 128 <= qi + 128 ? sc[4][st][j] : NEG; }
            if (n2 == 0) {
#pragma unroll
                for (int pi = 0; pi < 5; ++pi)
#pragma unroll
                    for (int st = 0; st < 2; ++st)
#pragma unroll
                        for (int j = 0; j < 4; ++j) { const int kj = 32 * (pi0 + pi) + 16 * st + 4 * fq + j; sc[pi][st][j] = kj >= 128 ? sc[pi][st][j] : NEG; }
            }
            float mx = NEG;
#pragma unroll
            for (int pi = 0; pi < 5; ++pi)
#pragma unroll
                for (int st = 0; st < 2; ++st)
#pragma unroll
                    for (int j = 0; j < 4; ++j) mx = fmaxf(mx, sc[pi][st][j]);
            mx = fmaxf(mx, lane_xor(mx, 16, lane)); mx = fmaxf(mx, lane_xor(mx, 32, lane));
            f32x4 acc[4], den = (f32x4){0.f, 0.f, 0.f, 0.f};
#pragma unroll
            for (int vt = 0; vt < 4; ++vt) acc[vt] = (f32x4){0.f, 0.f, 0.f, 0.f};
#pragma unroll
            for (int pi = 0; pi < 5; ++pi) { float p[8];
#pragma unroll
                for (int j = 0; j < 4; ++j) { p[j] = __builtin_amdgcn_exp2f(sc[pi][0][j] - mx); p[4 + j] = __builtin_amdgcn_exp2f(sc[pi][1][j] - mx); }
                const bf16x8 pf = __builtin_bit_cast(bf16x8, (v4u){pk2(p[0], p[1]), pk2(p[2], p[3]), pk2(p[4], p[5]), pk2(p[6], p[7])});
                { v2u l0, h0, l1, h1, l2, h2, l3, h3;
                  tr_read8<0, 16 * VPB, 32, 16 * VPB + 32, 64, 16 * VPB + 64, 96, 16 * VPB + 96>(vrd + 32 * (pi0 + pi) * VPB, l0, h0, l1, h1, l2, h2, l3, h3);
                  acc[0] = MFMA16(frag_lh(l0, h0), pf, acc[0]); acc[1] = MFMA16(frag_lh(l1, h1), pf, acc[1]); acc[2] = MFMA16(frag_lh(l2, h2), pf, acc[2]); acc[3] = MFMA16(frag_lh(l3, h3), pf, acc[3]); }
                den = MFMA16(ones, pf, den); }
            const float lsum = den[0], inv = 1.f / lsum;
            bf16* op = OG + ((size_t)g * M + tokq) * BW + h * 64 + 4 * fq;
#pragma unroll
            for (int vt = 0; vt < 4; ++vt) *(v2u*)(op + 16 * vt) = (v2u){pk2(acc[vt][0] * inv, acc[vt][1] * inv), pk2(acc[vt][2] * inv, acc[vt][3] * inv)};
            if (fq == 0) LSE[((size_t)g * M + tokq) * 8 + h] = (mx + __builtin_amdgcn_logf(lsum)) * 0.6931471805599453f;
        }
    }
}
__device__ __forceinline__ void att_combine(Frame& F) {
    const int gt = blockIdx.x * (NWAVES * 64) + opaque_tid(), NGT = F.G * NWAVES * 64;
    const bf16* OG = (const bf16*)(F.ws + WS_OG); const float* LSE = (const float*)(F.ws + WS_LSE); bf16* YA = (bf16*)(F.ws + WS_YA);
    for (int it = gt; it < M * 64; it += NGT) {
        const int tok = it >> 6, h = (it >> 3) & 7, pc = it & 7;
        const float l0 = LSE[(size_t)tok * 8 + h], l1 = LSE[((size_t)M + tok) * 8 + h], l2 = LSE[((size_t)2 * M + tok) * 8 + h];
        const float mx = fmaxf(l0, fmaxf(l1, l2)); float w0 = expf(l0 - mx), w1 = expf(l1 - mx), w2 = expf(l2 - mx); const float inv = 1.f / (w0 + w1 + w2); w0 *= inv; w1 *= inv; w2 *= inv;
        const size_t off = (size_t)tok * BW + h * 64 + pc * 8;
        const v4u a = *(const v4u*)(OG + off), c = *(const v4u*)(OG + (size_t)M * BW + off), d = *(const v4u*)(OG + (size_t)2 * M * BW + off);
        v4u o;
        o.x = pk2(w0 * bflo(a.x) + w1 * bflo(c.x) + w2 * bflo(d.x), w0 * bfhi(a.x) + w1 * bfhi(c.x) + w2 * bfhi(d.x));
        o.y = pk2(w0 * bflo(a.y) + w1 * bflo(c.y) + w2 * bflo(d.y), w0 * bfhi(a.y) + w1 * bfhi(c.y) + w2 * bfhi(d.y));
        o.z = pk2(w0 * bflo(a.z) + w1 * bflo(c.z) + w2 * bflo(d.z), w0 * bfhi(a.z) + w1 * bfhi(c.z) + w2 * bfhi(d.z));
        o.w = pk2(w0 * bflo(a.w) + w1 * bflo(c.w) + w2 * bflo(d.w), w0 * bfhi(a.w) + w1 * bfhi(c.w) + w2 * bfhi(d.w));
        __builtin_nontemporal_store(o, (v4u*)(YA + off));
    }
}

constexpr int NPHASE = 2 + 9 * DEPTH;
struct Args { const void* in[21]; float* out; unsigned char* ws; int ph_lo, ph_hi; };
__device__ __forceinline__ void moe_table(Frame& F, int l) {
    LAS int* tab = (LAS int*)(F.lds + LDSCTL_OFF + 64);
    const int tid = opaque_tid();
    if (tid < 64) { const int lane = tid & 63; const int cn = lane < 32 ? (int)__hip_atomic_load(F.ctl + CW_CNT + (l * 32 + lane) * 64, RLX_AGENT) : 0; const int nb = (cn + 255) >> 8; int inc = nb;
#pragma unroll
        for (int o = 1; o < 32; o <<= 1) { const int t = lane_up(inc, o, lane); if (lane >= o) inc += t; }
        if (lane < 32) { tab[lane] = inc - nb; tab[33 + lane] = cn; } if (lane == 31) tab[32] = inc; }
    __syncthreads();
}
__global__ void __launch_bounds__(NWAVES * 64, 2) fwd(Args args) {
    extern __shared__ __attribute__((aligned(16))) unsigned char lds[];
    Frame F;
    F.lds = (LAS unsigned char*)lds; F.ws = args.ws; F.ctl = (unsigned*)(args.ws + WS_CTL);
    F.wave = __builtin_amdgcn_readfirstlane((int)threadIdx.x >> 6); asm volatile("" : "+s"(F.wave)); F.tid = hw_tid(F.wave); F.lane = F.tid & 63; F.G = gridDim.x;
    F.x = (const float*)args.in[0]; F.c = (const float*)args.in[1]; F.pos = (const int*)args.in[2]; F.ada_w = (const float*)args.in[3]; F.ada_b = (const float*)args.in[4];
    F.ln_g = (const float*)args.in[5]; F.ln_b = (const float*)args.in[6]; F.a_w_in = (const float*)args.in[7]; F.a_b_gate = (const float*)args.in[8]; F.a_norm_g = (const float*)args.in[9];
    F.a_w_out = (const float*)args.in[10]; F.b_w_kv = (const float*)args.in[11]; F.b_w_q = (const float*)args.in[12]; F.b_w_o = (const float*)args.in[13];
    F.w_r1 = (const float*)args.in[14]; F.b_r1 = (const float*)args.in[15]; F.w_r2 = (const float*)args.in[16]; F.b_r2 = (const float*)args.in[17];
    F.w_gate = (const float*)args.in[18]; F.w_up = (const float*)args.in[19]; F.w_down = (const float*)args.in[20]; F.out = args.out;
    for (int u = F.tid; u < (LDS_BYTES - LDSCTL_OFF) / 4; u += NWAVES * 64) ((LAS unsigned*)(F.lds + LDSCTL_OFF))[u] = 0u;
    __syncthreads();
    const int lo = args.ph_lo, hi = args.ph_hi;
    XcdBarrier bar; bar.bar = F.ctl + CW_BAR; bar.x = 0; bar.st = nullptr; bar.w = F.wave;
    if (hi - lo > 1) bar = xcd_barrier_post(F.ctl + CW_BAR, (volatile LAS unsigned*)(F.lds + LDSCTL_OFF), F.wave);
#define IN(k) (lo <= (k) && (k) < hi)
#define SEAM(k) do { if ((k) + 1 < hi) xcd_barrier(bar); } while (0)
    const int c0 = (int)blockIdx.x;
    const int vcu = (F.G % 8 == 0) ? (int)(blockIdx.x % 8) * (F.G / 8) + (int)(blockIdx.x / 8) : (int)blockIdx.x;

    if (IN(0)) { pro_a(F); SEAM(0); }
    if (IN(1)) { pro_b(F); SEAM(1); }
    for (int l = 0; l < DEPTH; ++l) {
        const int pb = 2 + 9 * l;
        if (l < NA) {
            if (IN(pb + 0)) {
                pg8::Gemm g{(const bf16*)(F.ws + WS_H), (const bf16*)(F.ws + WS_WIN) + (size_t)l * NPROJ * D, M, NPROJ, D}; pg8::StaticOrder S; S.init(M, NPROJ, F.G, c0);
                pg8::EpiBf16S E{(bf16*)(F.ws + WS_PROJ), NPROJ, 2, 4, 0.08838834764831845f};
                pg8::gemm_phase<pg8::EpiBf16S, pg8::StaticOrder, true>(F.lds, g, S, E, F.wave);
                SEAM(pb + 0);
            }
            if (IN(pb + 1)) { ml_a(F); SEAM(pb + 1); }
            if (IN(pb + 2)) { ml_scan(F); SEAM(pb + 2); }
            if (IN(pb + 3)) { ml_c(F, l); SEAM(pb + 3); }
            if (IN(pb + 4)) {
                pg8::Gemm g{(const bf16*)(F.ws + WS_YA), (const bf16*)(F.ws + WS_WOUT) + (size_t)l * D * D, M, D, D}; pg8::StaticOrder S; S.init(M, D, F.G, c0);
                pg8::EpiBf16S E{(bf16*)(F.ws + WS_YMIX), D, 0, 0, 1.f};
                pg8::gemm_phase<pg8::EpiBf16S, pg8::StaticOrder, false>(F.lds, g, S, E, F.wave);
                SEAM(pb + 4);
            }
        } else {
            if (IN(pb + 0)) {
                if (l == NA) {
                    pg8::Gemm g{(const bf16*)(F.ws + WS_X), (const bf16*)(F.ws + WS_WKV), M, NKV, D}; pg8::StaticOrder S; S.init(M, NKV, F.G, c0);
                    pg8::EpiRope E{(bf16*)(F.ws + WS_KV), NKV, 6, (const float*)(F.ws + WS_ROPE), 1.0f};
                    pg8::gemm_phase<pg8::EpiRope, pg8::StaticOrder, true>(F.lds, g, S, E, F.wave);
                }
                {
                    pg8::Gemm g{(const bf16*)(F.ws + WS_H), (const bf16*)(F.ws + WS_WQ) + (size_t)(l - NA) * NQ * D, M, NQ, D}; pg8::StaticOrder S; S.init(M, NQ, F.G, c0);
                    pg8::EpiRope E{(bf16*)(F.ws + WS_Q), NQ, 6, (const float*)(F.ws + WS_ROPE), 0.125f * 1.4426950408889634f};
                    pg8::gemm_phase<pg8::EpiRope, pg8::StaticOrder, true>(F.lds, g, S, E, F.wave);
                    { const int nq = (M / 256) * (NQ / 256), full = nq / F.G, cutq = nq - full * F.G;
                      if (cutq > 0 && F.G - cutq >= F.G / 4) { __syncthreads(); if (c0 >= cutq) { const int tid = opaque_tid(), lane = tid & 63, wave = __builtin_amdgcn_readfirstlane(tid >> 6);
                              conv_run<5>(F, l, (c0 - cutq) * NWAVES + wave, (F.G - cutq) * NWAVES, lane, wave); } }
                      else { __syncthreads(); const int tid = opaque_tid(), lane = tid & 63, wave = __builtin_amdgcn_readfirstlane(tid >> 6); conv_run<5>(F, l, c0 * NWAVES + wave, F.G * NWAVES, lane, wave); } }
                }
                SEAM(pb + 0);
            }
            if (IN(pb + 1)) { att_mfma(F); SEAM(pb + 1); }
            if (IN(pb + 2)) { att_combine(F); SEAM(pb + 2); }
            if (IN(pb + 4)) {
                pg8::Gemm g{(const bf16*)(F.ws + WS_YA), (const bf16*)(F.ws + WS_WO) + (size_t)(l - NA) * D * BW, M, D, BW}; pg8::StaticOrder S; S.init(M, D, F.G, c0);
                pg8::EpiBf16S E{(bf16*)(F.ws + WS_YMIX), D, 0, 0, 1.f};
                pg8::gemm_phase<pg8::EpiBf16S, pg8::StaticOrder, false>(F.lds, g, S, E, F.wave);
                SEAM(pb + 4);
            }
        }
        if (IN(pb + 5)) { phase_r1<false>(F, l); SEAM(pb + 5); }
        if (IN(pb + 6)) {
            moe_table(F, l);
            pg8::Gemm g{(const bf16*)(F.ws + WS_H), nullptr, 0, 512, D};
            pg8::MoeOrder S{(const LAS int*)(F.lds + LDSCTL_OFF + 64), (const int*)(F.ws + WS_LIST), (const bf16*)(F.ws + WS_WGU) + (size_t)l * NE * 512 * D, (size_t)512 * D, 2, F.G, vcu, 1};
            pg8::EpiGU E{(bf16*)(F.ws + WS_ACT)};
            pg8::gemm_phase<pg8::EpiGU, pg8::MoeOrder, true>(F.lds, g, S, E, F.wave);
            if (l + 1 < DEPTH) { __syncthreads(); tail_fill<4>(F, l + 1, ((const LAS int*)(F.lds + LDSCTL_OFF + 64))[32] * 2, vcu); }
            SEAM(pb + 6);
        }
        if (IN(pb + 7)) {
            if (!IN(pb + 6)) moe_table(F, l);
            pg8::Gemm g{(const bf16*)(F.ws + WS_ACT), nullptr, 0, D, MH};
            pg8::MoeOrder S{(const LAS int*)(F.lds + LDSCTL_OFF + 64), (const int*)(F.ws + WS_LIST), (const bf16*)(F.ws + WS_WD) + (size_t)l * NE * D * MH, (size_t)D * MH, 4, F.G, vcu, 0};
            pg8::EpiBf16S E{(bf16*)(F.ws + WS_Y), D, 0, 0, 1.f};
            pg8::gemm_phase<pg8::EpiBf16S, pg8::MoeOrder, true>(F.lds, g, S, E, F.wave);
            if (l + 1 < DEPTH) { __syncthreads(); const int tu = ((const LAS int*)(F.lds + LDSCTL_OFF + 64))[32] * 4;
                if (l == 0) tail_fill<1>(F, 0, tu, vcu); else if (l == 1) tail_fill<2>(F, 0, tu, vcu); else tail_fill<3>(F, 0, tu, vcu); }
            SEAM(pb + 7);
        }
        if (IN(pb + 8)) { phase_r2<false>(F, l); SEAM(pb + 8); }
    }
#undef IN
#undef SEAM
}

extern "C" void kernel_launch(void* const* d_in, const int* in_sizes, int n_in, void* d_out, int out_size, void* d_ws, size_t ws_size, hipStream_t stream) {
    static int grid = 0;
    if (grid == 0) {
        if (n_in != 21 || in_sizes[0] != M * D || out_size != M * D || ws_size < WS_END) { fprintf(stderr, "kernel_launch: unexpected shapes (n_in %d, in0 %d, out %d, ws %zu < %zu); nothing launched\n", n_in, n_in > 0 ? in_sizes[0] : -1, out_size, ws_size, (size_t)WS_END); grid = -1; return; }
        int dev = 0, cus = 0, per_cu = 0;
        if (hipGetDevice(&dev) != hipSuccess || hipDeviceGetAttribute(&cus, hipDeviceAttributeMultiprocessorCount, dev) != hipSuccess) { grid = -1; return; }
        if (hipFuncSetAttribute((const void*)fwd, hipFuncAttributeMaxDynamicSharedMemorySize, LDS_BYTES) != hipSuccess) { fprintf(stderr, "kernel_launch: hipFuncSetAttribute failed\n"); grid = -1; return; }
        if (hipOccupancyMaxActiveBlocksPerMultiprocessor(&per_cu, (const void*)fwd, NWAVES * 64, LDS_BYTES) != hipSuccess || per_cu < 1) fprintf(stderr, "kernel_launch: occupancy query reports %d workgroups per CU\n", per_cu);
        (void)hipGetLastError();
        grid = cus;
    }
    if (grid < 0) return;
    if (hipMemsetAsync((char*)d_ws + WS_CTL, 0, CTL_ZERO_BYTES, stream) != hipSuccess) return;
    Args a{};
    for (int i = 0; i < 21; ++i) a.in[i] = d_in[i];
    a.out = (float*)d_out; a.ws = (unsigned char*)d_ws;
#if MK_N_LAUNCHES == 1
    a.ph_lo = 0; a.ph_hi = NPHASE;
    hipLaunchKernelGGL(fwd, dim3(grid), dim3(NWAVES * 64), LDS_BYTES, stream, a);
#else
    for (int p = 0; p < NPHASE; ++p) { a.ph_lo = p; a.ph_hi = p + 1; hipLaunchKernelGGL(fwd, dim3(grid), dim3(NWAVES * 64), LDS_BYTES, stream, a); }
#endif
}
```

```cpp
#include <hip/hip_runtime.h>
#include <cstdio>
#include <cstdint>

#ifndef MK_N_LAUNCHES
#define MK_N_LAUNCHES 1
#endif

__device__ __forceinline__ int hw_tid(int wave_s) {
    unsigned z = 0u; asm volatile("" : "+s"(z));
    const unsigned lane = __builtin_amdgcn_mbcnt_hi(~0u, __builtin_amdgcn_mbcnt_lo(~0u, z));
    int t = (int)(((unsigned)wave_s << 6) | lane); asm volatile("" : "+v"(t)); return t;
}
namespace pg8 {
#define PG8_LAS __attribute__((address_space(3)))
typedef unsigned short bf16_t;
typedef short bf16x8 __attribute__((ext_vector_type(8)));
typedef float f32x4 __attribute__((ext_vector_type(4)));
typedef float f32x2 __attribute__((ext_vector_type(2)));
typedef unsigned u32x4 __attribute__((ext_vector_type(4)));
typedef unsigned u32x2 __attribute__((ext_vector_type(2)));
constexpr int BM = 256, BK = 64, HALF = 128, HTB = HALF * BK * 2  , STAGE_BYTES = 8 * HTB, NXCD = 8, WGM = 8;

__host__ __device__ __forceinline__ int lds_byte(int r, int c) { const int st = (r >> 4) * 2 + (c >> 5), rr = r & 15, cc = c & 31, ob = rr * 64 + cc * 2; return st * 1024 + (ob ^ (((ob >> 9) & 1) << 5)); }
__host__ __device__ __forceinline__ void stage_rc(int b, int& R, int& C) { const int st = b / 1024, sb = b % 1024, swz = sb ^ (((sb >> 9) & 1) << 5); R = (st >> 1) * 16 + swz / 64; C = (st & 1) * 32 + (swz % 64) / 2; }
__host__ __device__ __forceinline__ int perm32(int rho) { const int n = rho >> 4, i = rho & 15; return 8 * (i >> 2) + 4 * n + (i & 3); }

struct Unit { int pm, pn, ex, jb; };
struct Gemm { const bf16_t* A; const bf16_t* Bt; int M, N, K; };

struct StaticOrder {
    int nM, nN, nwg, G, c;
    __device__ void init(int M, int N, int G_, int c_) { nM = M / BM; nN = N / BM; nwg = nM * nN; G = G_; c = c_; }
    __device__ bool next(int i, Unit& u) const {
        const long L = (long)i * G + c; if (L >= nwg) return false;
        int wgid = (int)L; { const int q = nwg / NXCD, r = nwg % NXCD, xcd = wgid % NXCD, off = wgid / NXCD; wgid = (xcd < r ? xcd * (q + 1) : r * (q + 1) + (xcd - r) * q) + off; }
        const int nig = WGM * nN, gid = wgid / nig, fm = gid * WGM, gsz = (nM - fm) < WGM ? (nM - fm) : WGM;
        u.pm = fm + ((wgid % nig) % gsz); u.pn = (wgid % nig) / gsz; u.ex = 0; u.jb = 0; return true;
    }
    __device__ __forceinline__ const char* b_ptr(const Gemm& g, const Unit& u) const { return (const char*)g.Bt + (size_t)u.pn * BM * g.K * 2; }
    __device__ __forceinline__ unsigned a_off(const Gemm& g, const Unit& u, int h, int R, int C) const { return (unsigned)((u.pm * BM + h * HALF + R) * g.K + C) * 2u; }
};

struct MoeOrder {
    const PG8_LAS int* tab; const int* list; const bf16_t* W; size_t wstride; int ntn, G, c, gather;
    __device__ bool next(int i, Unit& u) const {
        const int L = i * G + c; const int total = tab[32] * ntn; if (L >= total) return false;
        const int rb = L / ntn; u.pn = L - rb * ntn;
        unsigned z = 0u; asm volatile("" : "+s"(z));
        const unsigned ln = __builtin_amdgcn_mbcnt_hi(~0u, __builtin_amdgcn_mbcnt_lo(~0u, z));
        const unsigned long long m = __ballot(rb >= tab[ln & 31u]);
        const int e = __builtin_popcount((unsigned)m) - 1;
        u.pm = rb; u.ex = e; u.jb = rb - tab[e]; return true;
    }
    __device__ __forceinline__ const char* b_ptr(const Gemm& g, const Unit& u) const { return (const char*)(W + (size_t)u.ex * wstride) + (size_t)u.pn * BM * g.K * 2; }
    __device__ __forceinline__ unsigned a_off(const Gemm& g, const Unit& u, int h, int R, int C) const {
        if (gather) { const int p = u.jb * BM + h * HALF + R; const int cnt = tab[33 + u.ex]; const int tok = list[u.ex * 16384 + (p < cnt ? p : 0)]; return (unsigned)(tok * g.K + C) * 2u; }
        return (unsigned)((u.pm * BM + h * HALF + R) * g.K + C) * 2u;
    }
};

__device__ __forceinline__ unsigned cvt_pk_bf16(float lo, float hi) { unsigned r; asm volatile("v_cvt_pk_bf16_f32 %0, %1, %2" : "=v"(r) : "v"(lo), "v"(hi)); return r; }

struct EpiF32 {
    static constexpr bool PERM = false;
    float* C; int ldc;
    __device__ __forceinline__ void operator()(const f32x4 (&acc)[2][2][4][2], const Unit& u, int wr, int wc, int fr, int fq) const {
        const int row0 = u.pm * BM + wr * 64 + fr, col0 = u.pn * BM + wc * 32 + 4 * fq;
#pragma unroll
        for (int ai = 0; ai < 2; ++ai)
#pragma unroll
            for (int m = 0; m < 4; ++m) { float* rowp = C + (size_t)(row0 + ai * HALF + m * 16) * ldc + col0;
#pragma unroll
                for (int bj = 0; bj < 2; ++bj)
#pragma unroll
                    for (int n = 0; n < 2; ++n) *(f32x4*)(rowp + bj * HALF + n * 16) = acc[ai][bj][m][n]; }
    }
};
struct EpiBf16S {
    static constexpr bool PERM = true;
    bf16_t* O; int ldc; int pn_lo, pn_hi; float scale;
    __device__ __forceinline__ void operator()(const f32x4 (&acc)[2][2][4][2], const Unit& u, int wr, int wc, int fr, int fq) const {
        const int row0 = u.pm * BM + wr * 64 + fr, col0 = u.pn * BM + wc * 32 + 8 * fq;
        const float sc = (u.pn >= pn_lo && u.pn < pn_hi) ? scale : 1.f;
#pragma unroll
        for (int ai = 0; ai < 2; ++ai)
#pragma unroll
            for (int m = 0; m < 4; ++m) { bf16_t* rowp = O + (size_t)(row0 + ai * HALF + m * 16) * ldc + col0;
#pragma unroll
                for (int bj = 0; bj < 2; ++bj) { const f32x4 v0 = acc[ai][bj][m][0] * sc, v1 = acc[ai][bj][m][1] * sc;
                    u32x4 w; w.x = cvt_pk_bf16(v0[0], v0[1]); w.y = cvt_pk_bf16(v0[2], v0[3]); w.z = cvt_pk_bf16(v1[0], v1[1]); w.w = cvt_pk_bf16(v1[2], v1[3]);
                    *(u32x4*)(rowp + bj * HALF) = w; } }
    }
};
struct EpiRope {
    static constexpr bool PERM = true;
    bf16_t* O; int ldc; int rope_tiles; const float* cs; float oscale;
    __device__ __forceinline__ void operator()(const f32x4 (&acc)[2][2][4][2], const Unit& u, int wr, int wc, int fr, int fq) const {
        const int row0 = u.pm * BM + wr * 64 + fr, col0 = u.pn * BM + wc * 32 + 8 * fq;
        const bool rope = u.pn < rope_tiles; const int i0 = 16 * (wc & 1) + 4 * fq;
#pragma unroll
        for (int ai = 0; ai < 2; ++ai)
#pragma unroll
            for (int m = 0; m < 4; ++m) { const int row = row0 + ai * HALF + m * 16; bf16_t* rowp = O + (size_t)row * ldc + col0;
                f32x4 t0 = (f32x4){1.f, 0.f, 1.f, 0.f}, t1 = (f32x4){1.f, 0.f, 1.f, 0.f};
                if (rope) { const f32x4* tp = (const f32x4*)(cs + ((size_t)row * 32 + i0) * 2); t0 = tp[0]; t1 = tp[1]; }
#pragma unroll
                for (int bj = 0; bj < 2; ++bj) { const f32x4 v0 = acc[ai][bj][m][0], v1 = acc[ai][bj][m][1];
                    const float a0 = v0[0] * t0[0] - v0[1] * t0[1], a1 = v0[1] * t0[0] + v0[0] * t0[1], a2 = v0[2] * t0[2] - v0[3] * t0[3], a3 = v0[3] * t0[2] + v0[2] * t0[3];
                    const float b0 = v1[0] * t1[0] - v1[1] * t1[1], b1 = v1[1] * t1[0] + v1[0] * t1[1], b2 = v1[2] * t1[2] - v1[3] * t1[3], b3 = v1[3] * t1[2] + v1[2] * t1[3];
                    u32x4 w; w.x = cvt_pk_bf16(a0 * oscale, a1 * oscale); w.y = cvt_pk_bf16(a2 * oscale, a3 * oscale); w.z = cvt_pk_bf16(b0 * oscale, b1 * oscale); w.w = cvt_pk_bf16(b2 * oscale, b3 * oscale);
                    *(u32x4*)(rowp + bj * HALF) = w; } }
    }
};
struct EpiGU {
    static constexpr bool PERM = true;
    bf16_t* O;
    __device__ __forceinline__ void operator()(const f32x4 (&acc)[2][2][4][2], const Unit& u, int wr, int wc, int fr, int fq) const {
        const int row0 = u.pm * BM + wr * 64 + fr, col0 = u.pn * HALF + wc * 32 + 8 * fq;
#pragma unroll
        for (int ai = 0; ai < 2; ++ai)
#pragma unroll
            for (int m = 0; m < 4; ++m) { bf16_t* rowp = O + (size_t)(row0 + ai * HALF + m * 16) * 256 + col0;
                float r[8];
#pragma unroll
                for (int n = 0; n < 2; ++n)
#pragma unroll
                    for (int j = 0; j < 4; ++j) { const float gt = acc[ai][0][m][n][j], up = acc[ai][1][m][n][j]; r[n * 4 + j] = gt * __builtin_amdgcn_rcpf(1.f + __expf(-gt)) * up; }
                u32x4 w; w.x = cvt_pk_bf16(r[0], r[1]); w.y = cvt_pk_bf16(r[2], r[3]); w.z = cvt_pk_bf16(r[4], r[5]); w.w = cvt_pk_bf16(r[6], r[7]);
                *(u32x4*)rowp = w; }
    }
};

template <class Epi, class Sched, bool ALIGN_EPI>
__device__ __forceinline__ void gemm_phase(PG8_LAS unsigned char* lds, const Gemm g, const Sched& S, const Epi& E, int wave_s) {
    const int tid = hw_tid(wave_s);
    const int wid = __builtin_amdgcn_readfirstlane(tid >> 6), lane = tid & 63, wr = wid >> 2, wc = wid & 3, fr = lane & 15, fq = lane >> 4;
    const int K = g.K, nt = K / BK;
    int sR[2], sC[2]; unsigned voffB[2];
#pragma unroll
    for (int i = 0; i < 2; ++i) { int R, C; stage_rc(tid * 16 + i * 8192, R, C); sR[i] = R; sC[i] = C; const int Rb = Epi::PERM ? ((R & ~31) + perm32(R & 31)) : R; voffB[i] = (unsigned)(Rb * K + C) * 2u; }
    const unsigned kstep = (unsigned)(BK * 2);
    const size_t hstep = (size_t)HALF * K * 2;
    const unsigned ldsw = (unsigned)wid * 1024u;
    const int aoff = lds_byte(wr * 64 + fr, fq * 8), boff = lds_byte(wc * 32 + fr, fq * 8);
    const char* const Ab = (const char*)g.A;
#define PG8_SA(b, h) (((b) * 2 + (h)) * HTB)
#define PG8_SB(b, h) ((4 + (b) * 2 + (h)) * HTB)
#define PG8_STAGEB(bufoff, gbase) do { _Pragma("unroll") for (int _i = 0; _i < 2; ++_i) \
        __builtin_amdgcn_global_load_lds((const unsigned*)((const char*)(gbase) + voffB[_i]), (PG8_LAS unsigned*)(lds + (bufoff) + ldsw + _i * 8192), 16, 0, 0); } while (0)
#define PG8_STAGEA(bufoff, o0, o1) do { \
        __builtin_amdgcn_global_load_lds((const unsigned*)(Ab + (o0)), (PG8_LAS unsigned*)(lds + (bufoff) + ldsw), 16, 0, 0); \
        __builtin_amdgcn_global_load_lds((const unsigned*)(Ab + (o1)), (PG8_LAS unsigned*)(lds + (bufoff) + ldsw + 8192), 16, 0, 0); } while (0)
#define PG8_LDA(dst, b, h) do { _Pragma("unroll") for (int m = 0; m < 4; ++m) _Pragma("unroll") for (int k = 0; k < 2; ++k) dst[m][k] = *(const PG8_LAS bf16x8*)(lds + PG8_SA(b, h) + aoff + m * 2048 + k * 1024); } while (0)
#define PG8_LDB(dst, b, h) do { _Pragma("unroll") for (int n = 0; n < 2; ++n) _Pragma("unroll") for (int k = 0; k < 2; ++k) dst[n][k] = *(const PG8_LAS bf16x8*)(lds + PG8_SB(b, h) + boff + n * 2048 + k * 1024); } while (0)
#define PG8_MMA(ai, bj, At, Bt) do { __builtin_amdgcn_s_setprio(1); _Pragma("unroll") for (int m = 0; m < 4; ++m) _Pragma("unroll") for (int n = 0; n < 2; ++n) _Pragma("unroll") for (int k = 0; k < 2; ++k) \
        acc[ai][bj][m][n] = __builtin_amdgcn_mfma_f32_16x16x32_bf16(Bt[n][k], At[m][k], acc[ai][bj][m][n], 0, 0, 0); __builtin_amdgcn_s_setprio(0); } while (0)
#define PG8_WAIT_V(n) asm volatile("s_waitcnt vmcnt(" #n ")" ::: "memory")
#define PG8_WAIT_L(n) asm volatile("s_waitcnt lgkmcnt(" #n ")" ::: "memory")
#define PG8_BAR __builtin_amdgcn_s_barrier()
#define PG8_SCHED __builtin_amdgcn_sched_barrier(0)
    Unit cur, nxt; int ui = 0;
    if (!S.next(0, cur)) return;
    f32x4 acc[2][2][4][2];
#pragma unroll
    for (int a = 0; a < 2; ++a)
#pragma unroll
        for (int b = 0; b < 2; ++b)
#pragma unroll
            for (int m = 0; m < 4; ++m)
#pragma unroll
                for (int n = 0; n < 2; ++n) acc[a][b][m][n] = (f32x4){0.f, 0.f, 0.f, 0.f};
    bf16x8 At[4][2], B0[2][2], B1[2][2];
    unsigned vA00, vA01, vA10, vA11;
    vA00 = S.a_off(g, cur, 0, sR[0], sC[0]); vA01 = S.a_off(g, cur, 0, sR[1], sC[1]); vA10 = S.a_off(g, cur, 1, sR[0], sC[0]); vA11 = S.a_off(g, cur, 1, sR[1], sC[1]);
    const char* cB = S.b_ptr(g, cur);
    PG8_STAGEB(PG8_SB(0, 0), cB); PG8_STAGEB(PG8_SB(0, 1), cB + hstep); PG8_STAGEA(PG8_SA(0, 0), vA00, vA01); PG8_STAGEA(PG8_SA(0, 1), vA10, vA11);
    if (wr == 1) PG8_BAR;
    PG8_WAIT_V(2); PG8_BAR;
    PG8_STAGEB(PG8_SB(1, 0), cB + kstep); PG8_STAGEA(PG8_SA(1, 0), vA00 + kstep, vA01 + kstep); PG8_STAGEB(PG8_SB(1, 1), cB + hstep + kstep);
    PG8_WAIT_V(6); PG8_BAR;
    for (;;) {
        const bool has_next = S.next(ui + 1, nxt);
        const char* nB = has_next ? S.b_ptr(g, nxt) : cB;
        unsigned nA00 = vA00, nA01 = vA01, nA10 = vA10, nA11 = vA11;
        if (has_next) { nA00 = S.a_off(g, nxt, 0, sR[0], sC[0]); nA01 = S.a_off(g, nxt, 0, sR[1], sC[1]); nA10 = S.a_off(g, nxt, 1, sR[0], sC[0]); nA11 = S.a_off(g, nxt, 1, sR[1], sC[1]); }
#pragma unroll 1
        for (int t = 0; t < nt; t += 2) {
            const bool last = (t == nt - 2);
            const unsigned k1 = (unsigned)(t + 1) * kstep;
            const unsigned k2 = last ? 0u : (unsigned)(t + 2) * kstep, k3 = k2 + kstep;
            const char* b2 = last ? nB : cB + (size_t)(t + 2) * kstep; const char* b3 = b2 + kstep;
            const unsigned s00 = (last ? nA00 : vA00), s01 = (last ? nA01 : vA01), s10 = (last ? nA10 : vA10), s11 = (last ? nA11 : vA11);
            PG8_LDB(B0, 0, 0); PG8_LDB(B1, 0, 1); PG8_SCHED; PG8_LDA(At, 0, 0); PG8_STAGEA(PG8_SA(1, 1), vA10 + k1, vA11 + k1);
            PG8_WAIT_V(8); PG8_WAIT_L(0); PG8_BAR; PG8_MMA(0, 0, At, B0); PG8_MMA(0, 1, At, B1); PG8_BAR; PG8_SCHED;
            PG8_LDA(At, 0, 1); PG8_STAGEB(PG8_SB(0, 0), b2); PG8_STAGEB(PG8_SB(0, 1), b2 + hstep); PG8_STAGEA(PG8_SA(0, 0), s00 + k2, s01 + k2);
            PG8_WAIT_V(8); PG8_WAIT_L(0); PG8_BAR; PG8_MMA(1, 0, At, B0); PG8_MMA(1, 1, At, B1); PG8_BAR; PG8_SCHED;
            PG8_LDB(B0, 1, 0); PG8_LDB(B1, 1, 1); PG8_SCHED; PG8_LDA(At, 1, 0); PG8_STAGEA(PG8_SA(0, 1), s10 + k2, s11 + k2);
            PG8_WAIT_V(8); PG8_WAIT_L(0); PG8_BAR; PG8_MMA(0, 0, At, B0); PG8_MMA(0, 1, At, B1); PG8_BAR; PG8_SCHED;
            PG8_LDA(At, 1, 1); PG8_STAGEB(PG8_SB(1, 0), b3); PG8_STAGEB(PG8_SB(1, 1), b3 + hstep); PG8_STAGEA(PG8_SA(1, 0), s00 + k3, s01 + k3);
            PG8_WAIT_V(8); PG8_WAIT_L(0); PG8_BAR; PG8_MMA(1, 0, At, B0); PG8_MMA(1, 1, At, B1); PG8_BAR; PG8_SCHED;
        }
        if constexpr (ALIGN_EPI) { if (wr == 0) PG8_BAR; }
        E(acc, cur, wr, wc, fr, fq);
        if (!has_next) break;
#pragma unroll
        for (int a = 0; a < 2; ++a)
#pragma unroll
            for (int b = 0; b < 2; ++b)
#pragma unroll
                for (int m = 0; m < 4; ++m)
#pragma unroll
                    for (int n = 0; n < 2; ++n) acc[a][b][m][n] = (f32x4){0.f, 0.f, 0.f, 0.f};
        cur = nxt; cB = nB; vA00 = nA00; vA01 = nA01; vA10 = nA10; vA11 = nA11; ++ui;
        if constexpr (ALIGN_EPI) { if (wr == 1) PG8_BAR; }
    }
    PG8_WAIT_V(0);
    if constexpr (!ALIGN_EPI) { if (wr == 0) PG8_BAR; }
    PG8_BAR;
#undef PG8_SA
#undef PG8_SB
#undef PG8_STAGEA
#undef PG8_STAGEB
#undef PG8_LDA
#undef PG8_LDB
#undef PG8_MMA
#undef PG8_WAIT_V
#undef PG8_WAIT_L
#undef PG8_BAR
#undef PG8_SCHED
}
}

constexpr int NWAVES = 8;
constexpr int BATCH = 2, SEQ = 8192, D = 1024, M = BATCH * SEQ, DEPTH = 4, NA = 2;
constexpr float ALPHA = 1.681792830507429f;
constexpr float LN_EPS = 1e-5f, A_NORM_EPS = 1e-6f;
constexpr int AH = 4, DQK = 128, DV = 256, APROJ = 3080, NPROJ = 3072;
constexpr int CH = 256, NCH = SEQ / CH;
constexpr int BG = 3, BH = 8, HD = 64, BW = 512, NQ = 1536, NKV = 3072;
constexpr int NE = 32, EG = 8, MH = 256;
constexpr int MAXRB = 160;

constexpr size_t MiB = 1u << 20;
constexpr size_t WS_CTL = 0, CTL_ZERO_BYTES = 128 * 1024;
constexpr size_t WS_MOD = 1 * MiB;
constexpr size_t WS_ROPE = 2 * MiB;
constexpr size_t WS_WR = 6 * MiB;
constexpr size_t WS_WG = 6 * MiB + 768 * 1024;
constexpr size_t WS_GATES = 7 * MiB;
constexpr size_t WS_ROUTE = 8 * MiB;
constexpr size_t WS_LIST = 9 * MiB;
constexpr size_t WS_MLS = 11 * MiB;
constexpr size_t WS_WIN = 12 * MiB, WS_WOUT = 24 * MiB, WS_WKV = 28 * MiB, WS_WQ = 34 * MiB, WS_WO = 40 * MiB, WS_WGU = 42 * MiB, WS_WD = 170 * MiB;
constexpr size_t WS_H = 234 * MiB;
constexpr size_t WS_YA = 266 * MiB;
constexpr size_t WS_S0 = 298 * MiB;
constexpr size_t WS_PROJ = WS_S0, WS_DC = WS_S0 + 96 * MiB, WS_CIN = WS_S0 + 128 * MiB;
constexpr size_t WS_Q = WS_S0, WS_OG = WS_S0 + 48 * MiB, WS_LSE = WS_S0 + 96 * MiB, WS_KV = WS_S0 + 112 * MiB;
constexpr size_t WS_YMIX = WS_S0;
constexpr size_t WS_Y = WS_S0, WS_ACT = WS_S0 + 80 * MiB;
constexpr size_t WS_X = WS_S0 + 208 * MiB;
constexpr size_t WS_END = WS_X + 64 * MiB;
constexpr int CW_BAR = 4096;
constexpr int CW_CNT = 16384;

constexpr int RING_BYTES = 131072;
constexpr int LDSCTL_OFF = 145408;
constexpr int LDS_BYTES = 147456;

#define GAS __attribute__((address_space(1)))
#define LAS __attribute__((address_space(3)))
typedef unsigned short bf16;
typedef unsigned v4u __attribute__((ext_vector_type(4)));
typedef unsigned v2u __attribute__((ext_vector_type(2)));
typedef float f32x4 __attribute__((ext_vector_type(4)));
typedef float f32x2 __attribute__((ext_vector_type(2)));
#define RLX_AGENT __ATOMIC_RELAXED, __HIP_MEMORY_SCOPE_AGENT
#ifndef ST_NT
#define ST_NT(p, v) __builtin_nontemporal_store((v), (p))
#endif
__device__ __forceinline__ unsigned f2bf(float f) { unsigned u = __builtin_bit_cast(unsigned, f); return (u + 0x7fffu + ((u >> 16) & 1u)) >> 16; }
typedef __bf16 bf16n2 __attribute__((ext_vector_type(2)));
__device__ __forceinline__ unsigned pk2(float lo, float hi) { bf16n2 v; v.x = (__bf16)lo; v.y = (__bf16)hi; return __builtin_bit_cast(unsigned, v); }
__device__ __forceinline__ float u2f(unsigned w) { return __builtin_bit_cast(float, w); }
__device__ __forceinline__ unsigned f2u(float f) { return __builtin_bit_cast(unsigned, f); }
__device__ __forceinline__ float bflo(unsigned w) { return __builtin_bit_cast(float, w << 16); }
__device__ __forceinline__ float bfhi(unsigned w) { return __builtin_bit_cast(float, w & 0xffff0000u); }
__device__ __forceinline__ float bf2f(bf16 v) { return __builtin_bit_cast(float, (unsigned)v << 16); }
template <int CTRL> __device__ __forceinline__ float dpp_mov(float v) { return __builtin_bit_cast(float, __builtin_amdgcn_update_dpp(0, __builtin_bit_cast(int, v), CTRL, 0xF, 0xF, true)); }
__device__ __forceinline__ float rdlane(float v, int l) { return __builtin_bit_cast(float, __builtin_amdgcn_readlane(__builtin_bit_cast(int, v), l)); }
__device__ __forceinline__ float quad_sum(float v) { v += dpp_mov<0xB1>(v); v += dpp_mov<0x4E>(v); return v; }
__device__ __forceinline__ float quad_max(float v) { v = fmaxf(v, dpp_mov<0xB1>(v)); v = fmaxf(v, dpp_mov<0x4E>(v)); return v; }
__device__ __forceinline__ float row16_sum(float v) { v += dpp_mov<0xB1>(v); v += dpp_mov<0x4E>(v); v += dpp_mov<0x141>(v); v += dpp_mov<0x140>(v); return v; }
__device__ __forceinline__ float row16_max(float v) { v = fmaxf(v, dpp_mov<0xB1>(v)); v = fmaxf(v, dpp_mov<0x4E>(v)); v = fmaxf(v, dpp_mov<0x141>(v)); v = fmaxf(v, dpp_mov<0x140>(v)); return v; }
__device__ __forceinline__ float wave_sum(float v) { v = row16_sum(v); return (rdlane(v, 0) + rdlane(v, 16)) + (rdlane(v, 32) + rdlane(v, 48)); }
__device__ __forceinline__ float wave_max(float v) { v = row16_max(v); return fmaxf(fmaxf(rdlane(v, 0), rdlane(v, 16)), fmaxf(rdlane(v, 32), rdlane(v, 48))); }
#define opaque_tid() hw_tid(F.wave)
__device__ __forceinline__ float sigmoidf_(float x) { return __builtin_amdgcn_rcpf(1.f + __expf(-x)); }
__device__ __forceinline__ float logsigmoidf_(float x) { return fminf(x, 0.f) - __logf(1.f + __expf(-fabsf(x))); }
__device__ __forceinline__ float lane_xor(float v, int m, int lane) { return __builtin_bit_cast(float, __builtin_amdgcn_ds_bpermute((lane ^ m) << 2, __builtin_bit_cast(int, v))); }
__device__ __forceinline__ float lane_up(float v, int o, int lane) { return __builtin_bit_cast(float, __builtin_amdgcn_ds_bpermute(((lane - o) & 63) << 2, __builtin_bit_cast(int, v))); }
__device__ __forceinline__ int lane_up(int v, int o, int lane) { return __builtin_amdgcn_ds_bpermute(((lane - o) & 63) << 2, v); }
__device__ __forceinline__ int lane_get(int v, int src) { return __builtin_amdgcn_ds_bpermute(src << 2, v); }

#define XB_TMO      128
#define XB_XCNT(j)  (256  + 64 * (j))
#define XB_XSUB(j)  (1280 + 64 * (j))
#define XB_XGEN(j)  (2304 + 64 * (j))
#define XB_TOP      3328
#define XB_TOPGEN   3392
#define XCD_BAR_WORDS 3456
#define XB_SPIN_CAP (1u << 18)

__device__ __forceinline__ unsigned xb_ld(unsigned* p)              { return __hip_atomic_load(p, __ATOMIC_RELAXED, __HIP_MEMORY_SCOPE_AGENT); }
__device__ __forceinline__ unsigned xb_add(unsigned* p, unsigned v) { return __hip_atomic_fetch_add(p, v, __ATOMIC_RELAXED, __HIP_MEMORY_SCOPE_AGENT); }
__device__ __forceinline__ unsigned xb_xcc_id() { return (unsigned)__builtin_amdgcn_s_getreg((3 << 11) | 20) & 0xFu; }
#define XB_SPIN(cond, bar) do { unsigned _sp = 0; while (cond) { __builtin_amdgcn_s_sleep(1); \
    if ((++_sp & 255u) == 0u) { if (xb_ld(&(bar)[XB_TMO])) break; if (_sp > XB_SPIN_CAP) { atomicAdd(&(bar)[XB_TMO], 1u); break; } } } } while (0)

struct XcdBarrier {
    unsigned* bar; unsigned x;
    volatile LAS unsigned* st;
    int w;
};
__device__ __forceinline__ XcdBarrier xcd_barrier_post(unsigned* bar, volatile LAS unsigned* st, int wave_s) {
    XcdBarrier b; b.bar = bar; b.x = xb_xcc_id(); b.st = st; b.w = wave_s;
    if (hw_tid(wave_s) == 0) (void)xb_add(&bar[XB_XCNT(b.x)], 1u);
    return b;
}
__device__ __forceinline__ void xcd_barrier_complete(unsigned* bar, unsigned x, unsigned& nloc, unsigned& nx) {
    const unsigned G = gridDim.x * gridDim.y * gridDim.z;
    unsigned sum, cnt, mine, sp = 0u;
    for (;;) {
        sum = 0u; cnt = 0u; mine = 0u;
#pragma unroll
        for (unsigned j = 0; j < 16; ++j) { const unsigned c = xb_ld(&bar[XB_XCNT(j)]); sum += c; cnt += (c > 0u) ? 1u : 0u; mine = (j == x) ? c : mine; }
        if (sum == G) break;
        __builtin_amdgcn_s_sleep(1);
        if ((++sp & 255u) == 0u) { if (xb_ld(&bar[XB_TMO])) break; if (sp > XB_SPIN_CAP) { atomicAdd(&bar[XB_TMO], 1u); break; } }
    }
    nloc = mine > 0u ? mine : 1u; nx = cnt > 0u ? cnt : 1u;
}
__device__ __forceinline__ void xcd_barrier(const XcdBarrier& b) {
    asm volatile("s_waitcnt vmcnt(0)" ::: "memory");
    __syncthreads();
    if (hw_tid(b.w) == 0) {
        unsigned* bar = b.bar;
        __builtin_amdgcn_s_waitcnt(0);
        unsigned nloc = b.st[0], nx = b.st[1];
        if (nloc == 0u) { xcd_barrier_complete(bar, b.x, nloc, nx); b.st[0] = nloc; b.st[1] = nx; }
        const unsigned old = xb_add(&bar[XB_XSUB(b.x)], 1u);
        const unsigned gen = old / nloc;
        if (old + 1u == (gen + 1u) * nloc) {
            __builtin_amdgcn_fence(__ATOMIC_RELEASE, "agent");
            asm volatile("s_waitcnt vmcnt(0)" ::: "memory");
            const unsigned og = xb_add(&bar[XB_TOP], 1u);
            const unsigned tg = og / nx;
            if (og + 1u == (tg + 1u) * nx) xb_add(&bar[XB_TOPGEN], 1u);
            else XB_SPIN(xb_ld(&bar[XB_TOPGEN]) == tg, bar);
            __builtin_amdgcn_fence(__ATOMIC_ACQUIRE, "agent");
            xb_add(&bar[XB_XGEN(b.x)], 1u);
            asm volatile("s_waitcnt vmcnt(0)" ::: "memory");
        } else {
            XB_SPIN(xb_ld(&bar[XB_XGEN(b.x)]) == gen, bar);
            __builtin_amdgcn_fence(__ATOMIC_ACQUIRE, "agent");
            asm volatile("s_waitcnt vmcnt(0)" ::: "memory");
        }
    }
    __syncthreads();
}

struct Frame {
    LAS unsigned char* lds;
    unsigned* ctl;
    unsigned char* ws;
    int tid, lane, wave, G;
    const float *x, *c; const int* pos; const float *ada_w, *ada_b, *ln_g, *ln_b, *a_w_in, *a_b_gate, *a_norm_g, *a_w_out, *b_w_kv, *b_w_q, *b_w_o,
                *w_r1, *b_r1, *w_r2, *b_r2, *w_gate, *w_up, *w_down;
    float* out;
};

__device__ __forceinline__ int rowmap(int mode, int n) {
    if (mode == 1 || (mode == 2 && n < 1536)) { const int e = n & 63; return (n & ~63) + 2 * (e & 31) + (e >> 5); }
    if (mode == 3) return ((n >> 7) << 8) + (n & 127);
    if (mode == 4) return ((n >> 7) << 8) + 128 + (n & 127);
    return n;
}
__device__ __forceinline__ void transpose_load(const float* W, int ldw, int k0, int n0, f32x4 (&t)[8], int lane) {
#pragma unroll
    for (int i = 0; i < 8; ++i) t[i] = *(const f32x4*)(W + (size_t)(k0 + 8 * i + (lane >> 3)) * ldw + n0 + 4 * (lane & 7));
}
__device__ __forceinline__ void transpose_store(const f32x4 (&t)[8], int k0, int n0, bf16* WT, int ldk, int mode, LAS float* scr, int lane) {
#pragma unroll
    for (int i = 0; i < 8; ++i) { LAS float* d = scr + (8 * i + (lane >> 3)) * 33 + 4 * (lane & 7); d[0] = t[i].x; d[1] = t[i].y; d[2] = t[i].z; d[3] = t[i].w; }
    asm volatile("s_waitcnt lgkmcnt(0)" ::: "memory");
    const int c = lane & 7;
#pragma unroll
    for (int j = 0; j < 4; ++j) { const int n = (lane >> 3) + 8 * j; const LAS float* s = scr + (8 * c) * 33 + n;
        v4u o; o.x = pk2(s[0 * 33], s[1 * 33]); o.y = pk2(s[2 * 33], s[3 * 33]); o.z = pk2(s[4 * 33], s[5 * 33]); o.w = pk2(s[6 * 33], s[7 * 33]);
        *(v4u*)(WT + (size_t)rowmap(mode, n0 + n) * ldk + k0 + 8 * c) = o; }
    asm volatile("s_waitcnt lgkmcnt(0)" ::: "memory");
}
struct TItem { const float* W; bf16* WT; int ldw, k0, n0, ldk, mode; };
__device__ __forceinline__ TItem conv_item(Frame& F, int kind, int l, int r) {
    TItem t; t.mode = 0;
    const float* const wg = F.w_gate; const float* const wu = F.w_up;
    if (kind == 0) { t.W = F.a_w_in + (size_t)l * D * APROJ; t.ldw = APROJ; t.k0 = 64 * (r / 96); t.n0 = 32 * (r % 96); t.WT = (bf16*)(F.ws + WS_WIN) + (size_t)l * NPROJ * D; t.ldk = D; }
    else if (kind == 1) { t.W = F.a_w_out + (size_t)l * D * D; t.ldw = D; t.k0 = 64 * (r / 32); t.n0 = 32 * (r % 32); t.WT = (bf16*)(F.ws + WS_WOUT) + (size_t)l * D * D; t.ldk = D; }
    else if (kind == 2) { t.W = F.b_w_kv; t.ldw = NKV; t.k0 = 64 * (r / 96); t.n0 = 32 * (r % 96); t.WT = (bf16*)(F.ws + WS_WKV); t.ldk = D; t.mode = 2; }
    else if (kind == 3) { t.W = F.b_w_q + (size_t)l * D * NQ; t.ldw = NQ; t.k0 = 64 * (r / 48); t.n0 = 32 * (r % 48); t.WT = (bf16*)(F.ws + WS_WQ) + (size_t)l * NQ * D; t.ldk = D; t.mode = 1; }
    else if (kind == 4) { t.W = F.b_w_o + (size_t)l * BW * D; t.ldw = D; t.k0 = 64 * (r / 32); t.n0 = 32 * (r % 32); t.WT = (bf16*)(F.ws + WS_WO) + (size_t)l * D * BW; t.ldk = BW; }
    else { const int sub = r >> 12, q = r & 4095, le = l * NE + (q >> 7), rr = q & 127;
        if (sub < 2) { t.W = (sub == 0 ? wg : wu) + (size_t)le * D * MH; t.ldw = MH; t.k0 = 64 * (rr / 8); t.n0 = 32 * (rr % 8); t.WT = (bf16*)(F.ws + WS_WGU) + (size_t)le * 512 * D; t.ldk = D; t.mode = 3 + sub; }
        else { t.W = F.w_down + (size_t)le * MH * D; t.ldw = D; t.k0 = 64 * (rr / 32); t.n0 = 32 * (rr % 32); t.WT = (bf16*)(F.ws + WS_WD) + (size_t)le * D * MH; t.ldk = MH; } }
    return t;
}
template <int STAGE> __device__ __forceinline__ int stage_count(int l) { return STAGE == 0 ? 1536 + 512 + 12288 : STAGE == 1 ? 1536 + 512 : STAGE == 2 ? 1536 + 768 + 256 : STAGE == 3 ? 768 + 256 : STAGE == 4 ? (l >= NA ? 8192 : 12288) : 4096; }
template <int STAGE> __device__ __forceinline__ TItem stage_item(Frame& F, int r, int l) {
    if (STAGE == 0) { if (r < 1536) return conv_item(F, 0, 0, r); r -= 1536; if (r < 512) return conv_item(F, 1, 0, r); return conv_item(F, 5, 0, r - 512); }
    if (STAGE == 1) { if (r < 1536) return conv_item(F, 0, 1, r); return conv_item(F, 1, 1, r - 1536); }
    if (STAGE == 2) { if (r < 1536) return conv_item(F, 2, 0, r); r -= 1536; if (r < 768) return conv_item(F, 3, 0, r); return conv_item(F, 4, 0, r - 768); }
    if (STAGE == 3) { if (r < 768) return conv_item(F, 3, 1, r); return conv_item(F, 4, 1, r - 768); }
    if (STAGE == 5) return conv_item(F, 5, l, 8192 + r);
    return conv_item(F, 5, l, r);
}
template <int STAGE> __device__ __forceinline__ void conv_run(Frame& F, int l, int gw, int NGW, int lane, int wave) {
    LAS float* scr = (LAS float*)(F.lds + wave * 16384);
    const int NITEMS = stage_count<STAGE>(l);
    f32x4 cur[8], nxt[8];
    int it = gw;
    if (it < NITEMS) { const TItem t = stage_item<STAGE>(F, it, l); transpose_load(t.W, t.ldw, t.k0, t.n0, cur, lane); }
#pragma unroll 1
    for (; it < NITEMS; it += NGW) {
        const TItem t = stage_item<STAGE>(F, it, l);
        const bool more = it + NGW < NITEMS;
        if (more) { const TItem tn = stage_item<STAGE>(F, it + NGW, l); transpose_load(tn.W, tn.ldw, tn.k0, tn.n0, nxt, lane); }
        transpose_store(cur, t.k0, t.n0, t.WT, t.ldk, t.mode, scr, lane);
        if (more) {
#pragma unroll
            for (int j = 0; j < 8; ++j) cur[j] = nxt[j]; }
    }
}
__device__ __forceinline__ void gemv_run(Frame& F, int tid, int lane, int wave) {
    LAS float* red = (LAS float*)F.lds;
    LAS float* sc = (LAS float*)(F.lds + 8192);
    float* mod = (float*)(F.ws + WS_MOD);
    for (int i = tid; i < 2 * D; i += NWAVES * 64) { const float c = F.c[i]; sc[i] = c / (1.f + expf(-c)); }
    __syncthreads();
    for (int it = blockIdx.x; it < 4 * 64; it += F.G) {
        const int l = it >> 6, n0 = (it & 63) * 96;
        const float* W = F.ada_w + (size_t)l * D * 6144 + n0 + 2 * (lane < 48 ? lane : 0);
        float a00 = 0.f, a01 = 0.f, a10 = 0.f, a11 = 0.f;
        const int k0 = wave * 128;
#pragma unroll 1
        for (int kb = k0; kb < k0 + 128; kb += 32) {
            f32x2 w[32];
#pragma unroll
            for (int k = 0; k < 32; ++k) w[k] = *(const f32x2*)(W + (size_t)(kb + k) * 6144);
#pragma unroll
            for (int k = 0; k < 32; ++k) { const float c0 = sc[kb + k], c1 = sc[D + kb + k]; a00 += c0 * w[k].x; a01 += c0 * w[k].y; a10 += c1 * w[k].x; a11 += c1 * w[k].y; }
        }
        if (lane < 48) { red[(wave * 2 + 0) * 96 + 2 * lane] = a00; red[(wave * 2 + 0) * 96 + 2 * lane + 1] = a01;
                         red[(wave * 2 + 1) * 96 + 2 * lane] = a10; red[(wave * 2 + 1) * 96 + 2 * lane + 1] = a11; }
        __syncthreads();
        if (tid < 192) { const int b = tid / 96, nn = tid % 96; float s = 0.f;
#pragma unroll
            for (int w8 = 0; w8 < 8; ++w8) s += red[(w8 * 2 + b) * 96 + nn];
            mod[(size_t)(l * 2 + b) * 6144 + n0 + nn] = s + F.ada_b[l * 6144 + n0 + nn]; }
        __syncthreads();
    }
}
__device__ __forceinline__ void rope_table(Frame& F, int gt, int NGT) {
    float* cs = (float*)(F.ws + WS_ROPE);
    const float inv = powf(10000.f, -(float)(gt & 31) * 2.0f / 64.0f);
    for (int i = gt; i < M * 32; i += NGT) { const int tok = i >> 5;
        const float ang = (float)F.pos[tok] * inv;
        const double a = (double)ang; const double n = rint(a * 0.15915494309189535); const float r = (float)(a - n * 6.283185307179586);
        *(f32x2*)(cs + 2 * (size_t)i) = (f32x2){cosf(r), sinf(r)}; }
}
template <int STAGE> __device__ __forceinline__ void tail_fill(Frame& F, int l, int total_units, int vcu) {
    const int tid = opaque_tid(), lane = tid & 63, wave = __builtin_amdgcn_readfirstlane(tid >> 6);
    const int maxu = (total_units + F.G - 1) / F.G; int cut = total_units - (maxu - 1) * F.G; if (cut < 0 || F.G - cut < F.G / 2) cut = 0;
    if (vcu >= cut) {
        const int j = vcu - cut, n = F.G - cut;
        if (STAGE == 4) conv_run<STAGE>(F, l, j * NWAVES + wave, n * NWAVES, lane, wave);
        else {
            conv_run<STAGE>(F, l, j * NWAVES + wave, n * NWAVES, lane, wave);
            if (STAGE == 1) rope_table(F, j * (NWAVES * 64) + tid, n * (NWAVES * 64));
        }
    }
}
__device__ __forceinline__ void pro_a(Frame& F) {
    const int tid = opaque_tid(), lane = tid & 63, wave = __builtin_amdgcn_readfirstlane(tid >> 6);
    gemv_run(F, tid, lane, wave);
    conv_run<0>(F, 0, blockIdx.x * NWAVES + wave, F.G * NWAVES, lane, wave);
    {
        const int gt = blockIdx.x * (NWAVES * 64) + tid, NGT = F.G * NWAVES * 64;
        float* WR = (float*)(F.ws + WS_WR); float* WG = (float*)(F.ws + WS_WG);
        for (int i = gt; i < 4 * 48 * D; i += NGT) { const int l = i / (48 * D), c = (i / D) % 48, k = i % D;
            WR[i] = c < 4 ? F.w_r1[(size_t)(l * D + k) * 4 + c] : (c < 36 ? F.w_r2[(size_t)(l * D + k) * 32 + (c - 4)] : 0.f); }
        for (int i = gt; i < 2 * 8 * D; i += NGT) { const int l = i / (8 * D), j = (i / D) % 8, k = i % D; WG[i] = F.a_w_in[(size_t)(l * D + k) * APROJ + NPROJ + j]; }
    }
}

__device__ __forceinline__ void ln_row(f32x4 (&v)[4], const float* lng, const float* lnb, int lane) {
    float s = 0.f;
#pragma unroll
    for (int j = 0; j < 4; ++j) s += (v[j].x + v[j].y) + (v[j].z + v[j].w);
    const float mean = wave_sum(s) * (1.f / D); float q = 0.f;
#pragma unroll
    for (int j = 0; j < 4; ++j) { v[j] = v[j] - mean; q += (v[j].x * v[j].x + v[j].y * v[j].y) + (v[j].z * v[j].z + v[j].w * v[j].w); }
    const float rstd = 1.f / sqrtf(wave_sum(q) * (1.f / D) + LN_EPS);
#pragma unroll
    for (int j = 0; j < 4; ++j) { const f32x4 g = *(const f32x4*)(lng + 256 * j + 4 * lane), b = *(const f32x4*)(lnb + 256 * j + 4 * lane); v[j] = v[j] * rstd * g + b; }
}
__device__ __forceinline__ void modulate(const f32x4 (&v)[4], f32x4 (&h)[4], const float* sc, const float* sh, int lane) {
#pragma unroll
    for (int j = 0; j < 4; ++j) { const f32x4 s = *(const f32x4*)(sc + 256 * j + 4 * lane), t = *(const f32x4*)(sh + 256 * j + 4 * lane); h[j] = v[j] * (1.f + s) + t; }
}
__device__ __forceinline__ void store_row_bf16(bf16* dst, const f32x4 (&h)[4], int lane) {
#pragma unroll
    for (int j = 0; j < 4; ++j) { v2u o; o.x = pk2(h[j].x, h[j].y); o.y = pk2(h[j].z, h[j].w); ST_NT((v2u*)(dst + 256 * j + 4 * lane), o); }
}
__device__ __forceinline__ void gates_row(const f32x4 (&h)[4], const float* WGl, const float* bg, float* grow, int lane) {
    float p[8];
#pragma unroll
    for (int g = 0; g < 8; ++g) { float s = 0.f;
        if ((g & 1) == 0) asm volatile("" ::: "memory");
#pragma unroll
        for (int j = 0; j < 4; ++j) { const f32x4 w = *(const f32x4*)(WGl + g * D + 256 * j + 4 * lane); s += (h[j].x * w.x + h[j].y * w.y) + (h[j].z * w.z + h[j].w * w.w); }
        p[g] = wave_sum(s) + bg[g]; }
    if (lane == 0) { *(f32x4*)grow = (f32x4){p[0], p[1], p[2], p[3]}; *(f32x4*)(grow + 4) = (f32x4){p[4], p[5], p[6], p[7]}; }
}
template <int NR> __device__ __forceinline__ void gates_rows(const f32x4 (&h)[NR][4], const float* WGl, const float* bg, float* grow0, int lane) {
    float p[NR][8];
#pragma unroll
    for (int g = 0; g < 8; ++g) { f32x4 w[4];
#pragma unroll
        for (int j = 0; j < 4; ++j) w[j] = *(const f32x4*)(WGl + g * D + 256 * j + 4 * lane);
#pragma unroll
        for (int r = 0; r < NR; ++r) { float s = 0.f;
#pragma unroll
            for (int j = 0; j < 4; ++j) s += (h[r][j].x * w[j].x + h[r][j].y * w[j].y) + (h[r][j].z * w[j].z + h[r][j].w * w[j].w);
            p[r][g] = wave_sum(s) + bg[g]; } }
    if (lane == 0) {
#pragma unroll
        for (int r = 0; r < NR; ++r) { *(f32x4*)(grow0 + r * 8) = (f32x4){p[r][0], p[r][1], p[r][2], p[r][3]}; *(f32x4*)(grow0 + r * 8 + 4) = (f32x4){p[r][4], p[r][5], p[r][6], p[r][7]}; } }
}
constexpr int RW = 4;
__device__ __forceinline__ void pro_b(Frame& F) {
    const int tid = opaque_tid(), lane = tid & 63, wave = __builtin_amdgcn_readfirstlane(tid >> 6), gw = blockIdx.x * NWAVES + wave, NGW = F.G * NWAVES; (void)tid;
    const float* mod = (const float*)(F.ws + WS_MOD); bf16* H = (bf16*)(F.ws + WS_H); float* gates = (float*)(F.ws + WS_GATES); const float* WG = (const float*)(F.ws + WS_WG);
    for (int row0 = gw * RW; row0 < M; row0 += NGW * RW) {
        const int b = row0 >> 13; const float* mb = mod + (size_t)(0 * 2 + b) * 6144;
        f32x4 h[RW][4];
#pragma unroll
        for (int r = 0; r < RW; ++r)
#pragma unroll
            for (int j = 0; j < 4; ++j) h[r][j] = *(const f32x4*)(F.x + (size_t)(row0 + r) * D + 256 * j + 4 * lane);
#pragma unroll
        for (int r = 0; r < RW; ++r) { store_row_bf16((bf16*)(F.ws + WS_X) + (size_t)(row0 + r) * D, h[r], lane);
            modulate(h[r], h[r], mb + 1024, mb, lane); store_row_bf16(H + (size_t)(row0 + r) * D, h[r], lane); }
        gates_rows<RW>(h, WG, F.a_b_gate, gates + (size_t)row0 * 8, lane);
    }
}
template <bool DRY> __device__ __forceinline__ void phase_r1(Frame& F, int l) {
    const int tid = opaque_tid(), lane = tid & 63, wave = __builtin_amdgcn_readfirstlane(tid >> 6), fr = lane & 15, fq = lane >> 4;
    const float* mod = (const float*)(F.ws + WS_MOD); bf16* H = (bf16*)(F.ws + WS_H); const bf16* ymix = (const bf16*)(F.ws + WS_YMIX);
    const float* WR = (const float*)(F.ws + WS_WR) + (size_t)l * 48 * D;
    unsigned* cnt = F.ctl + CW_CNT + l * 32 * 64;     int* list = (int*)(F.ws + WS_LIST); unsigned* route = (unsigned*)(F.ws + WS_ROUTE);
    bf16* const xres = (bf16*)(F.ws + WS_X);
    constexpr int HSP = 1028, RB = 2, BR = NWAVES * RB;
    LAS float* HS = (LAS float*)F.lds; LAS float* PS = (LAS float*)(F.lds + 100864); LAS float* LG = (LAS float*)(F.lds + 125440);
    LAS float* VEC = (LAS float*)(F.lds + 67584);
    {
        const float* const m0 = mod + (size_t)(l * 2 + 0) * 6144; const float* const m1 = mod + (size_t)(l * 2 + 1) * 6144;
        const float* const p0 = F.ln_g + (size_t)(l * 2 + 0) * D; const float* const p1 = F.ln_b + (size_t)(l * 2 + 0) * D;
        const float* const p2 = m0 + 2048; const float* const p3 = m0 + 4096; const float* const p4 = m0 + 3072; const float* const p5 = m1 + 2048; const float* const p6 = m1 + 4096; const float* const p7 = m1 + 3072;
        const bool hi = tid >= 256; const int e = (tid & 255) * 4;
        const f32x4 a = *(const f32x4*)((hi ? p1 : p0) + e), b = *(const f32x4*)((hi ? p3 : p2) + e), c = *(const f32x4*)((hi ? p5 : p4) + e), d = *(const f32x4*)((hi ? p7 : p6) + e);
        LAS float* dst = VEC + (hi ? 1024 : 0) + e;
        *(LAS f32x4*)(dst) = a; *(LAS f32x4*)(dst + 2048) = b; *(LAS f32x4*)(dst + 4096) = c; *(LAS f32x4*)(dst + 6144) = d;
        if (tid < 36) VEC[8192 + tid] = tid < 4 ? F.b_r1[l * 4 + tid] : F.b_r2[l * 32 + tid - 4];
    }
    f32x4 b4[8][3];
#pragma unroll
    for (int mi = 0; mi < 8; ++mi)
#pragma unroll
        for (int ct = 0; ct < 3; ++ct) b4[mi][ct] = *(const f32x4*)(WR + (size_t)(16 * ct + fr) * D + 16 * (8 * wave + mi) + 4 * fq);
    int pe = 0, prow0 = -1; unsigned pp0 = 0u, pp1 = 0u; float pw0 = 0.f, pw1 = 0.f;
    auto flush = [&]() { if (prow0 >= 0 && lane < RB) { const int prow = prow0 + lane, pe0 = pe & 255, pe1 = pe >> 8; list[pe0 * 16384 + (int)pp0] = prow; list[pe1 * 16384 + (int)pp1] = prow;
            *(v4u*)(route + (size_t)prow * 8) = (v4u){(unsigned)pe0, pp0, (unsigned)pe1, pp1}; *(v2u*)(route + (size_t)prow * 8 + 4) = (v2u){f2u(pw0), f2u(pw1)}; } prow0 = -1; };
    auto route_rows = [&](int r0) {
        if (lane < RB) {
            const LAS float* lg = LG + (wave * RB + lane) * 40;
            const float l10 = lg[0], l11 = lg[1], l12 = lg[2], l13 = lg[3];
            int gi = 0; float mx = l10;
            if (l11 > mx) { mx = l11; gi = 1; }
            if (l12 > mx) { mx = l12; gi = 2; }
            if (l13 > mx) { mx = l13; gi = 3; }
            const float pg = 1.f / (expf(l10 - mx) + expf(l11 - mx) + expf(l12 - mx) + expf(l13 - mx));
            int j0 = 0; float v0 = lg[4 + gi * 8];
            for (int j = 1; j < 8; ++j) { const float t = lg[4 + gi * 8 + j]; if (t > v0) { v0 = t; j0 = j; } }
            int j1 = -1; float v1 = -3.0e38f;
            for (int j = 0; j < 8; ++j) { const float t = lg[4 + gi * 8 + j]; if (j != j0 && t > v1) { v1 = t; j1 = j; } }
            const float ee = expf(v1 - v0);
            pw0 = pg / (1.f + ee); pw1 = pg * ee / (1.f + ee); const int pe0 = gi * 8 + j0, pe1 = gi * 8 + j1; pe = pe0 | (pe1 << 8);
            pp0 = __hip_atomic_fetch_add(cnt + pe0 * 64, DRY ? 0u : 1u, RLX_AGENT); pp1 = __hip_atomic_fetch_add(cnt + pe1 * 64, DRY ? 0u : 1u, RLX_AGENT);
        }
        prow0 = r0; };
    int lrow0 = -1;
    v2u xv[RB][4], yv[RB][4];
    auto request = [&](int r0) {
#pragma unroll
        for (int r = 0; r < RB; ++r)
#pragma unroll
            for (int j = 0; j < 4; ++j) { xv[r][j] = *(const v2u*)(xres + (size_t)(r0 + r) * D + 256 * j + 4 * lane); yv[r][j] = *(const v2u*)(ymix + (size_t)(r0 + r) * D + 256 * j + 4 * lane); } };
    int rowb = blockIdx.x * BR;
    if (rowb < M) request(rowb + wave * RB);
    __syncthreads();
    for (; rowb < M; rowb += F.G * BR) {
        const int row0 = rowb + wave * RB; const int b = row0 >> 13;
        const LAS float* vl = VEC + 4 * lane; const LAS float* vg1 = vl + (2 + 3 * b) * 1024;
        f32x4 h[RB][4];
#pragma unroll
        for (int j = 0; j < 4; ++j) { const f32x4 g1 = *(const LAS f32x4*)(vg1 + 256 * j);
#pragma unroll
            for (int r = 0; r < RB; ++r) { const v2u a = yv[r][j], x = xv[r][j]; h[r][j] = (f32x4){bflo(x.x), bfhi(x.x), bflo(x.y), bfhi(x.y)} * ALPHA + (1.f + g1) * (f32x4){bflo(a.x), bfhi(a.x), bflo(a.y), bfhi(a.y)}; } }
        { const int nb = rowb + F.G * BR; if (nb < M) request(nb + wave * RB); }
#pragma unroll
        for (int r = 0; r < RB; ++r) { float s = 0.f;
#pragma unroll
            for (int j = 0; j < 4; ++j) s += (h[r][j].x + h[r][j].y) + (h[r][j].z + h[r][j].w);
            const float mean = wave_sum(s) * (1.f / D); float q = 0.f;
#pragma unroll
            for (int j = 0; j < 4; ++j) { h[r][j] = h[r][j] - mean; q += (h[r][j].x * h[r][j].x + h[r][j].y * h[r][j].y) + (h[r][j].z * h[r][j].z + h[r][j].w * h[r][j].w); }
            const float rstd = 1.f / sqrtf(wave_sum(q) * (1.f / D) + LN_EPS);
#pragma unroll
            for (int j = 0; j < 4; ++j) h[r][j] = h[r][j] * rstd * *(const LAS f32x4*)(vl + 256 * j) + *(const LAS f32x4*)(vl + 1024 + 256 * j); }
#pragma unroll
        for (int r = 0; r < RB; ++r) {
            store_row_bf16(xres + (size_t)(row0 + r) * D, h[r], lane);
#pragma unroll
            for (int j = 0; j < 4; ++j) h[r][j] = h[r][j] * (1.f + *(const LAS f32x4*)(vg1 + 1024 + 256 * j)) + *(const LAS f32x4*)(vg1 + 2048 + 256 * j);
            store_row_bf16(H + (size_t)(row0 + r) * D, h[r], lane); }
#pragma unroll
        for (int r = 0; r < RB; ++r)
#pragma unroll
            for (int j = 0; j < 4; ++j) *(LAS f32x4*)(HS + (wave * RB + r) * HSP + 256 * j + 4 * lane) = h[r][j];
        __syncthreads();
        flush();
        if (lrow0 >= 0) route_rows(lrow0);
        f32x4 lacc[3];
#pragma unroll
        for (int ct = 0; ct < 3; ++ct) lacc[ct] = (f32x4){0.f, 0.f, 0.f, 0.f};
#pragma unroll
        for (int mi = 0; mi < 8; ++mi) { const f32x4 a0 = *(const LAS f32x4*)(HS + fr * HSP + 16 * (8 * wave + mi) + 4 * fq);
#pragma unroll
            for (int i = 0; i < 4; ++i)
#pragma unroll
                for (int ct = 0; ct < 3; ++ct) lacc[ct] = __builtin_amdgcn_mfma_f32_16x16x4f32(a0[i], b4[mi][ct][i], lacc[ct], 0, 0, 0); }
#pragma unroll
        for (int ct = 0; ct < 3; ++ct) *(LAS f32x4*)(PS + ((wave * 3 + ct) * 64 + lane) * 4) = lacc[ct];
        __syncthreads();
#pragma unroll
        for (int i = 0; i < 2; ++i) { const int idx = tid + 512 * i;
            if (idx < 768) { const int j = idx & 3, ln = (idx >> 2) & 63, ct = idx >> 8; const int off = (ct * 64 + ln) * 4 + j; float v = 0.f;
#pragma unroll
                for (int ks = 0; ks < 8; ++ks) v += PS[off + ks * 768];
                const int rowl = 4 * (ln >> 4) + j, col = 16 * ct + (ln & 15);
                if (col < 36) LG[rowl * 40 + col] = v + VEC[8192 + col]; } }
        lrow0 = row0;
    }
    __syncthreads();
    flush();
    if (lrow0 >= 0) route_rows(lrow0);
    flush();
}
template <int NR> __device__ __forceinline__ void gates_rows_lds(const f32x4 (&h)[NR][4], const LAS float* W, const float* bg, float* grow0, int lane) {
    float p[NR][8];
#pragma unroll
    for (int g = 0; g < 8; ++g) { f32x4 w[4];
#pragma unroll
        for (int j = 0; j < 4; ++j) w[j] = *(const LAS f32x4*)(W + g * D + 256 * j + 4 * lane);
#pragma unroll
        for (int r = 0; r < NR; ++r) { float s = 0.f;
#pragma unroll
            for (int j = 0; j < 4; ++j) s += (h[r][j].x * w[j].x + h[r][j].y * w[j].y) + (h[r][j].z * w[j].z + h[r][j].w * w[j].w);
            p[r][g] = wave_sum(s) + bg[g]; } }
    if (lane == 0) {
#pragma unroll
        for (int r = 0; r < NR; ++r) { *(f32x4*)(grow0 + r * 8) = (f32x4){p[r][0], p[r][1], p[r][2], p[r][3]}; *(f32x4*)(grow0 + r * 8 + 4) = (f32x4){p[r][4], p[r][5], p[r][6], p[r][7]}; } }
}
template <bool DRY> __device__ __forceinline__ void phase_r2(Frame& F, int l) {
    const int tid = opaque_tid(), lane = tid & 63, wave = __builtin_amdgcn_readfirstlane(tid >> 6), gw = blockIdx.x * NWAVES + wave, NGW = F.G * NWAVES;
    const float* mod = (const float*)(F.ws + WS_MOD); bf16* H = (bf16*)(F.ws + WS_H); const bf16* Y = (const bf16*)(F.ws + WS_Y);
    float* gates = (float*)(F.ws + WS_GATES); const float* WG = (const float*)(F.ws + WS_WG);
    const unsigned* route = (const unsigned*)(F.ws + WS_ROUTE);
    bf16* const xres = (bf16*)(F.ws + WS_X);
    constexpr int RB = 2;
    const bool has_next = l < DEPTH - 1, has_gates = l + 1 < NA;
    LAS float* VEC = (LAS float*)F.lds;
    LAS float* WGS = VEC + 8192;
    {
        const int ln = has_next ? l + 1 : l;
        const float* const m0 = mod + (size_t)(l * 2 + 0) * 6144; const float* const m1 = mod + (size_t)(l * 2 + 1) * 6144;
        const float* const n0 = mod + (size_t)(ln * 2 + 0) * 6144; const float* const n1 = mod + (size_t)(ln * 2 + 1) * 6144;
        const float* const p0 = F.ln_g + (size_t)(l * 2 + 1) * D; const float* const p1 = F.ln_b + (size_t)(l * 2 + 1) * D;
        const float* const p2 = m0 + 5120; const float* const p3 = m1 + 5120; const float* const p4 = n0 + 1024; const float* const p5 = n0; const float* const p6 = n1 + 1024; const float* const p7 = n1;
        const bool hi = tid >= 256; const int e = (tid & 255) * 4;
        const f32x4 a = *(const f32x4*)((hi ? p1 : p0) + e), b = *(const f32x4*)((hi ? p3 : p2) + e), c = *(const f32x4*)((hi ? p5 : p4) + e), d = *(const f32x4*)((hi ? p7 : p6) + e);
        LAS float* dst = VEC + (hi ? 1024 : 0) + e;
        *(LAS f32x4*)(dst) = a; *(LAS f32x4*)(dst + 2048) = b; *(LAS f32x4*)(dst + 4096) = c; *(LAS f32x4*)(dst + 6144) = d;
        if (has_gates) { const float* wn = WG + (size_t)(l + 1) * 8 * D + tid * 4;
#pragma unroll
            for (int k = 0; k < 4; ++k) *(LAS f32x4*)(WGS + tid * 4 + 2048 * k) = *(const f32x4*)(wn + 2048 * k); }
    }
    int excl;
    { const int cn = lane < 32 ? (int)__hip_atomic_load(F.ctl + CW_CNT + (l * 32 + lane) * 64, RLX_AGENT) : 0; const int nb = (cn + 255) >> 8; int inc = nb;
#pragma unroll
      for (int o = 1; o < 32; o <<= 1) { const int t = lane_up(inc, o, lane); if (lane >= o) inc += t; }
      excl = inc - nb; }
    __syncthreads();
    v4u q0 = (v4u){0u, 0u, 0u, 0u}; v2u q1 = (v2u){0u, 0u};
    auto load_route = [&](int rowa) { const size_t rr = (size_t)(rowa + (lane < RB ? lane : 0)) * 8; q0 = *(const v4u*)(route + rr); q1 = *(const v2u*)(route + rr + 4); };
    v2u xv[RB][4], ya[RB][4], yc[RB][4]; float w0[RB], w1[RB];
    auto request = [&](int rowa) {
        const unsigned q0x = q0.x, q0y = q0.y, q0z = q0.z, q0w = q0.w, q1x = q1.x, q1y = q1.y;
#pragma unroll
        for (int r = 0; r < RB; ++r) {
            const int e0 = __builtin_amdgcn_readlane((int)q0x, r), p0 = __builtin_amdgcn_readlane((int)q0y, r), e1 = __builtin_amdgcn_readlane((int)q0z, r), p1 = __builtin_amdgcn_readlane((int)q0w, r);
            w0[r] = u2f((unsigned)__builtin_amdgcn_readlane((int)q1x, r)); w1[r] = u2f((unsigned)__builtin_amdgcn_readlane((int)q1y, r));
            const int s0 = __builtin_amdgcn_readlane(excl, e0) * 256 + p0, s1 = __builtin_amdgcn_readlane(excl, e1) * 256 + p1;
#pragma unroll
            for (int j = 0; j < 4; ++j) { xv[r][j] = *(const v2u*)(xres + (size_t)(rowa + r) * D + 256 * j + 4 * lane);
                ya[r][j] = *(const v2u*)(Y + (size_t)s0 * D + 256 * j + 4 * lane); yc[r][j] = *(const v2u*)(Y + (size_t)s1 * D + 256 * j + 4 * lane); } } };
    const int step = NGW * RB;
    int row0 = gw * RB;
    if (row0 < M) { load_route(row0); request(row0); if (row0 + step < M) load_route(row0 + step); }
    const float* bg = F.a_b_gate + (has_gates ? (l + 1) * 8 : 0);
    for (; row0 < M; row0 += step) {
        const int b = row0 >> 13; const LAS float* vl = VEC + 4 * lane;
        f32x4 v[RB][4];
#pragma unroll
        for (int j = 0; j < 4; ++j) { const f32x4 g2 = *(const LAS f32x4*)(vl + (2 + b) * 1024 + 256 * j);
#pragma unroll
            for (int r = 0; r < RB; ++r) { const v2u a = ya[r][j], c = yc[r][j];
                const f32x4 y = (f32x4){bflo(a.x), bfhi(a.x), bflo(a.y), bfhi(a.y)} * w0[r] + (f32x4){bflo(c.x), bfhi(c.x), bflo(c.y), bfhi(c.y)} * w1[r];
                const v2u x = xv[r][j]; v[r][j] = (f32x4){bflo(x.x), bfhi(x.x), bflo(x.y), bfhi(x.y)} * ALPHA + (1.f + g2) * y; } }
        if (row0 + step < M) { request(row0 + step); if (row0 + 2 * step < M) load_route(row0 + 2 * step); }
#pragma unroll
        for (int r = 0; r < RB; ++r) { float s = 0.f;
#pragma unroll
            for (int j = 0; j < 4; ++j) s += (v[r][j].x + v[r][j].y) + (v[r][j].z + v[r][j].w);
            const float mean = wave_sum(s) * (1.f / D); float q = 0.f;
#pragma unroll
            for (int j = 0; j < 4; ++j) { v[r][j] = v[r][j] - mean; q += (v[r][j].x * v[r][j].x + v[r][j].y * v[r][j].y) + (v[r][j].z * v[r][j].z + v[r][j].w * v[r][j].w); }
            const float rstd = 1.f / sqrtf(wave_sum(q) * (1.f / D) + LN_EPS);
#pragma unroll
            for (int j = 0; j < 4; ++j) v[r][j] = v[r][j] * rstd * *(const LAS f32x4*)(vl + 256 * j) + *(const LAS f32x4*)(vl + 1024 + 256 * j); }
#pragma unroll
        for (int r = 0; r < RB; ++r) { const int row = row0 + r;
            if (l == DEPTH - 1) {
#pragma unroll
                for (int j = 0; j < 4; ++j) ST_NT((f32x4*)(F.out + (size_t)row * D + 256 * j + 4 * lane), v[r][j]); }
            else store_row_bf16(xres + (size_t)row * D, v[r], lane);
            if (has_next) {
#pragma unroll
                for (int j = 0; j < 4; ++j) v[r][j] = v[r][j] * (1.f + *(const LAS f32x4*)(vl + (4 + 2 * b) * 1024 + 256 * j)) + *(const LAS f32x4*)(vl + (5 + 2 * b) * 1024 + 256 * j);
                store_row_bf16(H + (size_t)row * D, v[r], lane);
            } }
        if (has_gates) gates_rows_lds<RB>(v, WGS, bg, gates + (size_t)row0 * 8, lane);
    }
}

typedef short bf16x8 __attribute__((ext_vector_type(8)));
#define MFMA16(a, b, c) __builtin_amdgcn_mfma_f32_16x16x32_bf16((a), (b), (c), 0, 0, 0)
constexpr int RS = 136;
template <bool MAXOP> __device__ __forceinline__ float block_scan256(float v, LAS float* scr, int lane, int wave) {
#pragma unroll
    for (int o = 1; o < 64; o <<= 1) { const float t = lane_up(v, o, lane); if (lane >= o) v = MAXOP ? fmaxf(v, t) : v + t; }
    if (lane == 63 && wave < 4) scr[wave] = v;
    __syncthreads();
    float add = MAXOP ? -3.0e38f : 0.f;
#pragma unroll
    for (int w = 0; w < 3; ++w) if (w < wave) add = MAXOP ? fmaxf(add, scr[w]) : add + scr[w];
    v = MAXOP ? fmaxf(v, add) : v + add;
    __syncthreads();
    return v;
}
__device__ __forceinline__ bf16x8 lds_frag16(const LAS bf16* p) { return __builtin_bit_cast(bf16x8, *(const LAS v4u*)p); }
template <int O0, int O1, int O2, int O3, int O4, int O5, int O6, int O7>
__device__ __forceinline__ void tr_read8(unsigned a, v2u& r0, v2u& r1, v2u& r2, v2u& r3, v2u& r4, v2u& r5, v2u& r6, v2u& r7) {
    asm volatile("ds_read_b64_tr_b16 %0, %8 offset:%9\n\tds_read_b64_tr_b16 %1, %8 offset:%10\n\tds_read_b64_tr_b16 %2, %8 offset:%11\n\tds_read_b64_tr_b16 %3, %8 offset:%12\n\t"
                 "ds_read_b64_tr_b16 %4, %8 offset:%13\n\tds_read_b64_tr_b16 %5, %8 offset:%14\n\tds_read_b64_tr_b16 %6, %8 offset:%15\n\tds_read_b64_tr_b16 %7, %8 offset:%16\n\t"
                 "s_waitcnt lgkmcnt(0)"
                 : "=&v"(r0), "=&v"(r1), "=&v"(r2), "=&v"(r3), "=&v"(r4), "=&v"(r5), "=&v"(r6), "=&v"(r7)
                 : "v"(a), "i"(O0), "i"(O1), "i"(O2), "i"(O3), "i"(O4), "i"(O5), "i"(O6), "i"(O7) : "memory");
}
__device__ __forceinline__ bf16x8 frag_lh(v2u lo, v2u hi) { return __builtin_bit_cast(bf16x8, (v4u){lo.x, lo.y, hi.x, hi.y}); }

__device__ __forceinline__ void ml_a(Frame& F) {
    const int tid = opaque_tid(), lane = tid & 63, wave = __builtin_amdgcn_readfirstlane(tid >> 6), fr = lane & 15, fq = lane >> 4;
    LAS unsigned char* KWb = F.lds;
    LAS unsigned char* VRb = F.lds + 18432;
    constexpr int KPB = 288, VPB = 544;
    const unsigned krd = (unsigned)(__UINTPTR_TYPE__)KWb + (4 * fq + (fr >> 2)) * KPB + (lane & 3) * 8;
    const unsigned vrd = (unsigned)(__UINTPTR_TYPE__)VRb + (4 * fq + (fr >> 2)) * VPB + (lane & 3) * 8 + wave * 64;
    const bf16x8 ones = __builtin_bit_cast(bf16x8, (v4u){0x3f803f80u, 0x3f803f80u, 0x3f803f80u, 0x3f803f80u});
    LAS float* wv = (LAS float*)(F.lds + 55296);
    LAS float* scr = (LAS float*)(F.lds + 56320);
    const bf16* proj = (const bf16*)(F.ws + WS_PROJ); const float* gates = (const float*)(F.ws + WS_GATES);
    float* Bv = (float*)(F.ws + WS_MLS); float* Mloc = Bv + 256; float* dn = (float*)(F.ws + WS_MLS + 65536); unsigned* dC = (unsigned*)(F.ws + WS_DC);
    for (int u = blockIdx.x; u < 256; u += F.G) {
        const int bh = u >> 5, c = u & 31, b = bh >> 2, h = bh & 3, t0 = b * SEQ + c * CH;
        v4u kreg[2], vreg[4];
        auto request = [&](int sb) { const bf16* rows = proj + (size_t)(t0 + sb * 64) * NPROJ;
#pragma unroll
            for (int i = 0; i < 2; ++i) { const int p = tid + 512 * i, s = p >> 4, part = p & 15; kreg[i] = *(const v4u*)(rows + (size_t)s * NPROJ + 512 + h * DQK + part * 8); }
#pragma unroll
            for (int i = 0; i < 4; ++i) { const int p = tid + 512 * i, s = p >> 5, part = p & 31; vreg[i] = *(const v4u*)(rows + (size_t)s * NPROJ + 1024 + h * DV + part * 8); } };
        request(0);
        float ip = 0.f, lf = 0.f;
        if (tid < 256) { ip = gates[(size_t)(t0 + tid) * 8 + h]; lf = logsigmoidf_(gates[(size_t)(t0 + tid) * 8 + 4 + h]); }
        const float bs = block_scan256<false>(lf, scr, lane, wave);
        const float as = tid < 256 ? ip - bs : -3.0e38f;
        const float wm = wave_max(as); if (lane == 0) scr[wave] = wm;
        __syncthreads();
        float mloc = scr[0];
#pragma unroll
        for (int w = 1; w < 8; ++w) mloc = fmaxf(mloc, scr[w]);
        if (tid < 256) wv[tid] = expf(as - mloc);
        if (tid == 255) { Bv[u] = bs; Mloc[u] = mloc; }
        f32x4 acc[2][8];
#pragma unroll
        for (int i = 0; i < 2; ++i)
#pragma unroll
            for (int j = 0; j < 8; ++j) acc[i][j] = (f32x4){0.f, 0.f, 0.f, 0.f};
        f32x4 dn4 = (f32x4){0.f, 0.f, 0.f, 0.f};
#pragma unroll 1
        for (int sb = 0; sb < 4; ++sb) {
            __syncthreads();
#pragma unroll
            for (int i = 0; i < 2; ++i) { const int p = tid + 512 * i, s = p >> 4, part = p & 15; v4u a = kreg[i]; const float w = wv[sb * 64 + s];
                a.x = pk2(bflo(a.x) * w, bfhi(a.x) * w); a.y = pk2(bflo(a.y) * w, bfhi(a.y) * w); a.z = pk2(bflo(a.z) * w, bfhi(a.z) * w); a.w = pk2(bflo(a.w) * w, bfhi(a.w) * w);
                *(LAS v4u*)(KWb + s * KPB + part * 16) = a; }
#pragma unroll
            for (int i = 0; i < 4; ++i) { const int p = tid + 512 * i, s = p >> 5, part = p & 31; *(LAS v4u*)(VRb + s * VPB + part * 16) = vreg[i]; }
            __syncthreads();
            if (sb < 3) request(sb + 1);
            v2u va[8];
            tr_read8<0, 16 * VPB, 32, 16 * VPB + 32, 32 * VPB, 48 * VPB, 32 * VPB + 32, 48 * VPB + 32>(vrd, va[0], va[1], va[2], va[3], va[4], va[5], va[6], va[7]);
#define ML_A_STEP(KS, HF) { v2u kb[8]; constexpr int KO = (KS) * 32 * KPB + (HF) * 128; \
                tr_read8<KO, KO + 16 * KPB, KO + 32, KO + 16 * KPB + 32, KO + 64, KO + 16 * KPB + 64, KO + 96, KO + 16 * KPB + 96>(krd, kb[0], kb[1], kb[2], kb[3], kb[4], kb[5], kb[6], kb[7]); \
                const bf16x8 a0 = frag_lh(va[4 * (KS)], va[4 * (KS) + 1]), a1 = frag_lh(va[4 * (KS) + 2], va[4 * (KS) + 3]); \
                _Pragma("unroll") for (int d4 = 0; d4 < 4; ++d4) { const int dt = 4 * (HF) + d4; const bf16x8 bb = frag_lh(kb[2 * d4], kb[2 * d4 + 1]); \
                    acc[0][dt] = MFMA16(a0, bb, acc[0][dt]); acc[1][dt] = MFMA16(a1, bb, acc[1][dt]); if (dt == wave) dn4 = MFMA16(ones, bb, dn4); } }
            ML_A_STEP(0, 0) ML_A_STEP(0, 1) ML_A_STEP(1, 0) ML_A_STEP(1, 1)
#undef ML_A_STEP
        }
        unsigned* dCu = dC + (size_t)u * 16384;
        const bool odd = (fr & 1) != 0;
#pragma unroll
        for (int i = 0; i < 2; ++i) { unsigned* const bp = dCu + (size_t)((32 * wave + 16 * i + 4 * fq + (odd ? 1 : 0)) * 64 + (fr >> 1));
#pragma unroll
            for (int dt = 0; dt < 8; ++dt) { const f32x4 a = acc[i][dt];
                const float n0 = dpp_mov<0xB1>(a[0]), n1 = dpp_mov<0xB1>(a[1]), n2 = dpp_mov<0xB1>(a[2]), n3 = dpp_mov<0xB1>(a[3]);
                bp[8 * dt] = odd ? pk2(n1, a[1]) : pk2(a[0], n0); bp[2 * 64 + 8 * dt] = odd ? pk2(n3, a[3]) : pk2(a[2], n2); } }
        if (fq == 0) dn[u * 128 + 16 * wave + fr] = dn4[0];
        __syncthreads();
    }
}
__device__ __forceinline__ void ml_scan(Frame& F) {
    const int tid = opaque_tid(), lane = tid & 63; (void)lane;
    const float* Bv = (const float*)(F.ws + WS_MLS); const float* Mloc = Bv + 256; float* Min = (float*)(F.ws + WS_MLS) + 512;
    const float* dn = (const float*)(F.ws + WS_MLS + 65536); float* nin = (float*)(F.ws + WS_MLS + 262144);
    const unsigned* dC = (const unsigned*)(F.ws + WS_DC); unsigned* CinT = (unsigned*)(F.ws + WS_CIN);
    LAS float* sB = (LAS float*)F.lds; LAS float* sM = sB + 32; LAS float* f1 = sB + 64; LAS float* f2 = sB + 96; LAS float* ms = sB + 128;
    for (int it0 = blockIdx.x * (NWAVES * 64); it0 < 8 * 16384; it0 += F.G * NWAVES * 64) {
        const int bh = it0 >> 14, e2 = (it0 & 16383) + tid;
        unsigned d[NCH];
#pragma unroll
        for (int c = 0; c < NCH; ++c) d[c] = dC[(size_t)(bh * NCH + c) * 16384 + e2];
        __syncthreads();
        if (tid < NCH) { sB[tid] = Bv[bh * NCH + tid]; sM[tid] = Mloc[bh * NCH + tid]; }
        __syncthreads();
        if (tid == 0) { float m = 0.f;
            for (int c = 0; c < NCH; ++c) { const float ml = sM[c], mm = fmaxf(m, ml); ms[c] = m; f1[c] = expf(m - mm); f2[c] = expf(ml - mm); m = sB[c] + mm; } }
        __syncthreads();
        f32x2 C = (f32x2){0.f, 0.f};
#pragma unroll
        for (int c = 0; c < NCH; ++c) { CinT[(size_t)(bh * NCH + c) * 16384 + e2] = pk2(C.x, C.y); C = C * f1[c] + (f32x2){bflo(d[c]), bfhi(d[c])} * f2[c]; }
        if ((it0 & 16383) == 0) {
            if (tid < 128) { float n = 0.f;
                for (int c = 0; c < NCH; ++c) { nin[(bh * NCH + c) * 128 + tid] = n; n = n * f1[c] + dn[(bh * NCH + c) * 128 + tid] * f2[c]; } }
            if (tid < NCH) Min[bh * NCH + tid] = ms[tid];
        }
    }
}
__device__ __forceinline__ void ml_c(Frame& F, int l) {
    const int tid = opaque_tid(), lane = tid & 63, wave = __builtin_amdgcn_readfirstlane(tid >> 6), fr = lane & 15, fq = lane >> 4;
    LAS bf16* CT = (LAS bf16*)(F.lds);
    LAS bf16* KB = (LAS bf16*)(F.lds + 69632);
    LAS unsigned char* VRb = F.lds + 87040;
    constexpr int VPB = 544;
    LAS float* eav = (LAS float*)(F.lds + 123904);
    LAS float* etv = eav + 256;
    LAS float* iwv = eav + 512;
    LAS float* thv = eav + 768;
    LAS bf16* NB = (LAS bf16*)(F.lds + 128000);
    LAS float* scr = (LAS float*)(F.lds + 128256);
    const bf16* proj = (const bf16*)(F.ws + WS_PROJ); const float* gates = (const float*)(F.ws + WS_GATES);
    const float* Min = (const float*)(F.ws + WS_MLS) + 512; const float* nin = (const float*)(F.ws + WS_MLS + 262144); const bf16* CinT = (const bf16*)(F.ws + WS_CIN);
    bf16* YA = (bf16*)(F.ws + WS_YA);
    const bf16x8 ones = __builtin_bit_cast(bf16x8, (v4u){0x3f803f80u, 0x3f803f80u, 0x3f803f80u, 0x3f803f80u});
    for (int u = blockIdx.x; u < 256; u += F.G) {
        const int bh = u >> 5, c = u & 31, b = bh >> 2, h = bh & 3, t0 = b * SEQ + c * CH;
        v4u cin[8];
        { const bf16* src = CinT + (size_t)u * 32768;
#pragma unroll
          for (int i = 0; i < 8; ++i) { const int p = tid + 512 * i, v = p >> 4, part = p & 15; cin[i] = *(const v4u*)(src + v * 128 + part * 8); } }
        float ip = 0.f, lf = 0.f;
        if (tid < 256) { ip = gates[(size_t)(t0 + tid) * 8 + h]; lf = logsigmoidf_(gates[(size_t)(t0 + tid) * 8 + 4 + h]); }
        const float bs = block_scan256<false>(lf, scr, lane, wave);
        const float as = tid < 256 ? ip - bs : -3.0e38f;
        const float pm = block_scan256<true>(as, scr, lane, wave);
        const float wm = wave_max(as); if (lane == 0) scr[wave] = wm;
        __syncthreads();
        float mloc = scr[0];
#pragma unroll
        for (int w = 1; w < 8; ++w) mloc = fmaxf(mloc, scr[w]);
        const float m_in = Min[u];
        if (tid < 256) { const float mt = bs + fmaxf(m_in, pm); eav[tid] = expf(as - mloc); etv[tid] = expf(bs + mloc - mt); iwv[tid] = expf(bs + m_in - mt); thv[tid] = expf(-mt); }
        if (tid < 64) { const f32x2 n2 = *(const f32x2*)(nin + u * 128 + 2 * tid); ((LAS unsigned*)NB)[tid] = pk2(n2.x, n2.y); }
#pragma unroll
        for (int i = 0; i < 8; ++i) { const int p = tid + 512 * i, v = p >> 4, part = p & 15; *(LAS v4u*)(CT + v * RS + part * 8) = cin[i]; }
        __syncthreads();
#pragma unroll 1
        for (int pass = 0; pass < 2; ++pass) {
            const int tt = pass == 0 ? 15 - wave : wave, nsb = pass == 0 ? 4 : 2;
            const int tmax = 16 * tt + 15, tq = 16 * tt + fr; const size_t row = (size_t)(t0 + tq);
            bf16x8 qf[4];
#pragma unroll
            for (int ks = 0; ks < 4; ++ks) qf[ks] = __builtin_bit_cast(bf16x8, *(const v4u*)(proj + row * NPROJ + h * DQK + 32 * ks + 8 * fq));
            f32x4 acc[17];
#pragma unroll
            for (int vt = 0; vt < 17; ++vt) acc[vt] = (f32x4){0.f, 0.f, 0.f, 0.f};
#pragma unroll
            for (int ks = 0; ks < 4; ++ks) {
#pragma unroll
                for (int vt = 0; vt < 16; ++vt) { acc[vt] = MFMA16(lds_frag16(CT + (16 * vt + fr) * RS + 32 * ks + 8 * fq), qf[ks], acc[vt]);
                    if ((vt & 3) == 3) __builtin_amdgcn_sched_barrier(0); }
                acc[16] = MFMA16(lds_frag16(NB + 32 * ks + 8 * fq), qf[ks], acc[16]);
            }
            { const float iw = iwv[tq];
#pragma unroll
              for (int vt = 0; vt < 17; ++vt) acc[vt] *= iw; }
            const float et = etv[tq];
            v4u kreg[2], vreg[4];
            auto request = [&](int sb) { const bf16* rows = proj + (size_t)(t0 + sb * 64) * NPROJ;
#pragma unroll
                for (int i = 0; i < 2; ++i) { const int p = tid + 512 * i, s = p >> 4, part = p & 15; kreg[i] = *(const v4u*)(rows + (size_t)s * NPROJ + 512 + h * DQK + part * 8); }
#pragma unroll
                for (int i = 0; i < 4; ++i) { const int p = tid + 512 * i, s = p >> 5, part = p & 31; vreg[i] = *(const v4u*)(rows + (size_t)s * NPROJ + 1024 + h * DV + part * 8); } };
            request(0);
#pragma unroll 1
            for (int sb = 0; sb < nsb; ++sb) {
                __syncthreads();
#pragma unroll
                for (int i = 0; i < 2; ++i) { const int p = tid + 512 * i, s = p >> 4, part = p & 15; *(LAS v4u*)(KB + s * RS + part * 8) = kreg[i]; }
#pragma unroll
                for (int i = 0; i < 4; ++i) { const int p = tid + 512 * i, s = p >> 5, part = p & 31; *(LAS v4u*)(VRb + s * VPB + part * 16) = vreg[i]; }
                __syncthreads();
                if (sb + 1 < nsb) request(sb + 1);
#pragma unroll
                for (int sp = 0; sp < 2; ++sp) {
                    const int s0 = sb * 64 + 32 * sp;
                    if (s0 <= tmax) {
                        f32x4 sa = (f32x4){0.f, 0.f, 0.f, 0.f}, sc = (f32x4){0.f, 0.f, 0.f, 0.f};
#pragma unroll
                        for (int ks = 0; ks < 4; ++ks) { sa = MFMA16(lds_frag16(KB + (32 * sp + fr) * RS + 32 * ks + 8 * fq), qf[ks], sa);
                                                         sc = MFMA16(lds_frag16(KB + (32 * sp + 16 + fr) * RS + 32 * ks + 8 * fq), qf[ks], sc); }
                        float p[8];
#pragma unroll
                        for (int j = 0; j < 4; ++j) { const int sA = s0 + 4 * fq + j, sB = sA + 16;
                            p[j] = sA <= tq ? sa[j] * eav[sA] * et : 0.f; p[4 + j] = sB <= tq ? sc[j] * eav[sB] * et : 0.f; }
                        const bf16x8 pf = __builtin_bit_cast(bf16x8, (v4u){pk2(p[0], p[1]), pk2(p[2], p[3]), pk2(p[4], p[5]), pk2(p[6], p[7])});
                        const unsigned va = (unsigned)(__UINTPTR_TYPE__)VRb + (32 * sp + 4 * fq + (fr >> 2)) * VPB + (lane & 3) * 8;
#define ML_C_PV4(G) { v2u l0, h0, l1, h1, l2, h2, l3, h3; constexpr int VO = 128 * (G); \
                        tr_read8<VO, VO + 16 * VPB, VO + 32, VO + 16 * VPB + 32, VO + 64, VO + 16 * VPB + 64, VO + 96, VO + 16 * VPB + 96>(va, l0, h0, l1, h1, l2, h2, l3, h3); \
                        acc[4 * (G)] = MFMA16(frag_lh(l0, h0), pf, acc[4 * (G)]); acc[4 * (G) + 1] = MFMA16(frag_lh(l1, h1), pf, acc[4 * (G) + 1]); \
                        acc[4 * (G) + 2] = MFMA16(frag_lh(l2, h2), pf, acc[4 * (G) + 2]); acc[4 * (G) + 3] = MFMA16(frag_lh(l3, h3), pf, acc[4 * (G) + 3]); __builtin_amdgcn_sched_barrier(0); }
                        ML_C_PV4(0) ML_C_PV4(1) ML_C_PV4(2) ML_C_PV4(3)
#undef ML_C_PV4
                        acc[16] = MFMA16(ones, pf, acc[16]);
                    }
                }
            }
            v2u ogr[16];
#pragma unroll
            for (int vt = 0; vt < 16; ++vt) ogr[vt] = *(const v2u*)(proj + row * NPROJ + 2048 + h * DV + 4 * fq + 16 * vt);
            const float dnm = 1.f / fmaxf(fabsf(acc[16][0]), thv[tq]);
            float s1 = 0.f;
#pragma unroll
            for (int vt = 0; vt < 16; ++vt) { acc[vt] *= dnm; s1 += (acc[vt][0] + acc[vt][1]) + (acc[vt][2] + acc[vt][3]); }
            s1 += lane_xor(s1, 16, lane); s1 += lane_xor(s1, 32, lane);
            const float mean = s1 * (1.f / DV); float s2 = 0.f;
#pragma unroll
            for (int vt = 0; vt < 16; ++vt) { acc[vt] -= mean; s2 += (acc[vt][0] * acc[vt][0] + acc[vt][1] * acc[vt][1]) + (acc[vt][2] * acc[vt][2] + acc[vt][3] * acc[vt][3]); }
            s2 += lane_xor(s2, 16, lane); s2 += lane_xor(s2, 32, lane);
            const float rstd = 1.f / sqrtf(s2 * (1.f / DV) + A_NORM_EPS);
            const float* ng = F.a_norm_g + l * 1024 + h * DV + 4 * fq; bf16* yp = YA + row * D + h * DV + 4 * fq;
#pragma unroll
            for (int vt = 0; vt < 16; ++vt) { const v2u og = ogr[vt]; const f32x4 g = *(const f32x4*)(ng + 16 * vt);
                const float y0 = acc[vt][0] * rstd * g.x * sigmoidf_(bflo(og.x)), y1 = acc[vt][1] * rstd * g.y * sigmoidf_(bfhi(og.x)),
                            y2 = acc[vt][2] * rstd * g.z * sigmoidf_(bflo(og.y)), y3 = acc[vt][3] * rstd * g.w * sigmoidf_(bfhi(og.y));
                *(v2u*)(yp + 16 * vt) = (v2u){pk2(y0, y1), pk2(y2, y3)}; }
        }
        __syncthreads();
    }
}

__device__ __forceinline__ void att_mfma(Frame& F) {
    const int tid = opaque_tid(), lane = tid & 63, wave = __builtin_amdgcn_readfirstlane(tid >> 6), fr = lane & 15, fq = lane >> 4;
    constexpr int NK = 384, KP = 72, VPB = 160;
    LAS bf16* Ks = (LAS bf16*)(F.lds); LAS unsigned char* Vs = F.lds + NK * KP * 2;
    const bf16* Q = (const bf16*)(F.ws + WS_Q); const bf16* KV = (const bf16*)(F.ws + WS_KV);
    bf16* OG = (bf16*)(F.ws + WS_OG); float* LSE = (float*)(F.ws + WS_LSE);
    const bf16x8 ones = __builtin_bit_cast(bf16x8, (v4u){0x3f803f80u, 0x3f803f80u, 0x3f803f80u, 0x3f803f80u});
    constexpr int NU = 1536;
    const unsigned vrd = (unsigned)(__UINTPTR_TYPE__)Vs + (4 * fq + (fr >> 2)) * VPB + (lane & 3) * 8;
    auto decode = [&](int u, int& g, int& b, int& h, int& r, int& rho, int& n2) { g = u >> 9; const int rem = u & 511; b = rem >> 8; h = (rem >> 5) & 7; const int rn = rem & 31;
        r = g == 0 ? 1 : (g == 1 ? 4 : 16); const int nb2 = 32 / r; rho = rn / nb2; n2 = rn % nb2; };
    v4u kreg[6], vreg[6]; bf16x8 qf[2][2];
    auto request = [&](int u) { int g, b, h, r, rho, n2; decode(u, g, b, h, r, rho, n2);
        const bf16* kvb = KV + (size_t)b * SEQ * NKV + g * 512 + h * 64;
#pragma unroll
        for (int i = 0; i < 6; ++i) { const int p = tid + 512 * i, kj = p >> 3, part = p & 7; const int isub = (2 * n2 - 1) * 128 + kj;
            kreg[i] = (v4u){0u, 0u, 0u, 0u}; vreg[i] = (v4u){0u, 0u, 0u, 0u};
            if (isub >= 0) { const bf16* kr = kvb + ((size_t)isub * r + rho) * NKV + part * 8; kreg[i] = *(const v4u*)kr; vreg[i] = *(const v4u*)(kr + 1536); } }
#pragma unroll
        for (int i = 0; i < 2; ++i) { const size_t tq = (size_t)b * SEQ + (size_t)(n2 * 256 + 16 * (wave + 8 * i) + fr) * r + rho;
#pragma unroll
            for (int ks = 0; ks < 2; ++ks) qf[i][ks] = __builtin_bit_cast(bf16x8, *(const v4u*)(Q + tq * NQ + g * 512 + h * 64 + 32 * ks + 8 * fq)); } };
    const int ustep = (F.G % 8 == 0) ? F.G / 8 : F.G; const int ubase = (F.G % 8 == 0) ? (int)(blockIdx.x % 8) * (NU / 8) : 0, uend = (F.G % 8 == 0) ? ubase + NU / 8 : NU;
    int u = ubase + ((F.G % 8 == 0) ? (int)(blockIdx.x / 8) : (int)blockIdx.x);
    if (u < uend) request(u);
    for (; u < uend; u += ustep) {
        int g, b, h, r, rho, n2; decode(u, g, b, h, r, rho, n2);
        __syncthreads();
#pragma unroll
        for (int i = 0; i < 6; ++i) { const int p = tid + 512 * i, kj = p >> 3, part = p & 7; *(LAS v4u*)(Ks + kj * KP + part * 8) = kreg[i]; *(LAS v4u*)(Vs + kj * VPB + part * 16) = vreg[i]; }
        bf16x8 q[2][2];
#pragma unroll
        for (int i = 0; i < 2; ++i) { q[i][0] = qf[i][0]; q[i][1] = qf[i][1]; }
        __syncthreads();
        if (u + ustep < uend) request(u + ustep);
#pragma unroll
        for (int i = 0; i < 2; ++i) {
            const int tt = wave + 8 * i, qi = 16 * tt + fr;
            const size_t tokq = (size_t)b * SEQ + (size_t)(n2 * 256 + qi) * r + rho;
            const int pi0 = tt >> 1;
            f32x4 sc[5][2];
#pragma unroll
            for (int pi = 0; pi < 5; ++pi)
#pragma unroll
                for (int st = 0; st < 2; ++st) { const int tile = 2 * (pi0 + pi) + st; f32x4 a = (f32x4){0.f, 0.f, 0.f, 0.f};
                    a = MFMA16(lds_frag16(Ks + (16 * tile + fr) * KP + 8 * fq), q[i][0], a); a = MFMA16(lds_frag16(Ks + (16 * tile + fr) * KP + 32 + 8 * fq), q[i][1], a);
                    sc[pi][st] = a; }
            const float NEG = -__builtin_inff();
#pragma unroll
            for (int st = 0; st < 2; ++st)
#pragma unroll
                for (int j = 0; j < 4; ++j) { const int k0 = 32 * pi0 + 16 * st + 4 * fq + j; sc[0][st][j] = k0 >= qi ? sc[0][st][j] : NEG; sc[4][st][j] = k0 + 128 <= qi + 128 ? sc[4][st][j] : NEG; }
            if (n2 == 0) {
#pragma unroll
                for (int pi = 0; pi < 5; ++pi)
#pragma unroll
                    for (int st = 0; st < 2; ++st)
#pragma unroll
                        for (int j = 0; j < 4; ++j) { const int kj = 32 * (pi0 + pi) + 16 * st + 4 * fq + j; sc[pi][st][j] = kj >= 128 ? sc[pi][st][j] : NEG; }
            }
            float mx = NEG;
#pragma unroll
            for (int pi = 0; pi < 5; ++pi)
#pragma unroll
                for (int st = 0; st < 2; ++st)
#pragma unroll
                    for (int j = 0; j < 4; ++j) mx = fmaxf(mx, sc[pi][st][j]);
            mx = fmaxf(mx, lane_xor(mx, 16, lane)); mx = fmaxf(mx, lane_xor(mx, 32, lane));
            f32x4 acc[4], den = (f32x4){0.f, 0.f, 0.f, 0.f};
#pragma unroll
            for (int vt = 0; vt < 4; ++vt) acc[vt] = (f32x4){0.f, 0.f, 0.f, 0.f};
#pragma unroll
            for (int pi = 0; pi < 5; ++pi) { float p[8];
#pragma unroll
                for (int j = 0; j < 4; ++j) { p[j] = __builtin_amdgcn_exp2f(sc[pi][0][j] - mx); p[4 + j] = __builtin_amdgcn_exp2f(sc[pi][1][j] - mx); }
                const bf16x8 pf = __builtin_bit_cast(bf16x8, (v4u){pk2(p[0], p[1]), pk2(p[2], p[3]), pk2(p[4], p[5]), pk2(p[6], p[7])});
                { v2u l0, h0, l1, h1, l2, h2, l3, h3;
                  tr_read8<0, 16 * VPB, 32, 16 * VPB + 32, 64, 16 * VPB + 64, 96, 16 * VPB + 96>(vrd + 32 * (pi0 + pi) * VPB, l0, h0, l1, h1, l2, h2, l3, h3);
                  acc[0] = MFMA16(frag_lh(l0, h0), pf, acc[0]); acc[1] = MFMA16(frag_lh(l1, h1), pf, acc[1]); acc[2] = MFMA16(frag_lh(l2, h2), pf, acc[2]); acc[3] = MFMA16(frag_lh(l3, h3), pf, acc[3]); }
                den = MFMA16(ones, pf, den); }
            const float lsum = den[0], inv = 1.f / lsum;
            bf16* op = OG + ((size_t)g * M + tokq) * BW + h * 64 + 4 * fq;
#pragma unroll
            for (int vt = 0; vt < 4; ++vt) *(v2u*)(op + 16 * vt) = (v2u){pk2(acc[vt][0] * inv, acc[vt][1] * inv), pk2(acc[vt][2] * inv, acc[vt][3] * inv)};
            if (fq == 0) LSE[((size_t)g * M + tokq) * 8 + h] = (mx + __builtin_amdgcn_logf(lsum)) * 0.6931471805599453f;
        }
    }
}
__device__ __forceinline__ void att_combine(Frame& F) {
    const int gt = blockIdx.x * (NWAVES * 64) + opaque_tid(), NGT = F.G * NWAVES * 64;
    const bf16* OG = (const bf16*)(F.ws + WS_OG); const float* LSE = (const float*)(F.ws + WS_LSE); bf16* YA = (bf16*)(F.ws + WS_YA);
    for (int it = gt; it < M * 64; it += NGT) {
        const int tok = it >> 6, h = (it >> 3) & 7, pc = it & 7;
        const float l0 = LSE[(size_t)tok * 8 + h], l1 = LSE[((size_t)M + tok) * 8 + h], l2 = LSE[((size_t)2 * M + tok) * 8 + h];
        const float mx = fmaxf(l0, fmaxf(l1, l2)); float w0 = expf(l0 - mx), w1 = expf(l1 - mx), w2 = expf(l2 - mx); const float inv = 1.f / (w0 + w1 + w2); w0 *= inv; w1 *= inv; w2 *= inv;
        const size_t off = (size_t)tok * BW + h * 64 + pc * 8;
        const v4u a = *(const v4u*)(OG + off), c = *(const v4u*)(OG + (size_t)M * BW + off), d = *(const v4u*)(OG + (size_t)2 * M * BW + off);
        v4u o;
        o.x = pk2(w0 * bflo(a.x) + w1 * bflo(c.x) + w2 * bflo(d.x), w0 * bfhi(a.x) + w1 * bfhi(c.x) + w2 * bfhi(d.x));
        o.y = pk2(w0 * bflo(a.y) + w1 * bflo(c.y) + w2 * bflo(d.y), w0 * bfhi(a.y) + w1 * bfhi(c.y) + w2 * bfhi(d.y));
        o.z = pk2(w0 * bflo(a.z) + w1 * bflo(c.z) + w2 * bflo(d.z), w0 * bfhi(a.z) + w1 * bfhi(c.z) + w2 * bfhi(d.z));
        o.w = pk2(w0 * bflo(a.w) + w1 * bflo(c.w) + w2 * bflo(d.w), w0 * bfhi(a.w) + w1 * bfhi(c.w) + w2 * bfhi(d.w));
        __builtin_nontemporal_store(o, (v4u*)(YA + off));
    }
}

constexpr int NPHASE = 2 + 9 * DEPTH;
struct Args { const void* in[21]; float* out; unsigned char* ws; int ph_lo, ph_hi; };
__device__ __forceinline__ void moe_table(Frame& F, int l) {
    LAS int* tab = (LAS int*)(F.lds + LDSCTL_OFF + 64);
    const int tid = opaque_tid();
    if (tid < 64) { const int lane = tid & 63; const int cn = lane < 32 ? (int)__hip_atomic_load(F.ctl + CW_CNT + (l * 32 + lane) * 64, RLX_AGENT) : 0; const int nb = (cn + 255) >> 8; int inc = nb;
#pragma unroll
        for (int o = 1; o < 32; o <<= 1) { const int t = lane_up(inc, o, lane); if (lane >= o) inc += t; }
        if (lane < 32) { tab[lane] = inc - nb; tab[33 + lane] = cn; } if (lane == 31) tab[32] = inc; }
    __syncthreads();
}
__global__ void __launch_bounds__(NWAVES * 64, 2) fwd(Args args) {
    extern __shared__ __attribute__((aligned(16))) unsigned char lds[];
    Frame F;
    F.lds = (LAS unsigned char*)lds; F.ws = args.ws; F.ctl = (unsigned*)(args.ws + WS_CTL);
    F.wave = __builtin_amdgcn_readfirstlane((int)threadIdx.x >> 6); asm volatile("" : "+s"(F.wave)); F.tid = hw_tid(F.wave); F.lane = F.tid & 63; F.G = gridDim.x;
    F.x = (const float*)args.in[0]; F.c = (const float*)args.in[1]; F.pos = (const int*)args.in[2]; F.ada_w = (const float*)args.in[3]; F.ada_b = (const float*)args.in[4];
    F.ln_g = (const float*)args.in[5]; F.ln_b = (const float*)args.in[6]; F.a_w_in = (const float*)args.in[7]; F.a_b_gate = (const float*)args.in[8]; F.a_norm_g = (const float*)args.in[9];
    F.a_w_out = (const float*)args.in[10]; F.b_w_kv = (const float*)args.in[11]; F.b_w_q = (const float*)args.in[12]; F.b_w_o = (const float*)args.in[13];
    F.w_r1 = (const float*)args.in[14]; F.b_r1 = (const float*)args.in[15]; F.w_r2 = (const float*)args.in[16]; F.b_r2 = (const float*)args.in[17];
    F.w_gate = (const float*)args.in[18]; F.w_up = (const float*)args.in[19]; F.w_down = (const float*)args.in[20]; F.out = args.out;
    for (int u = F.tid; u < (LDS_BYTES - LDSCTL_OFF) / 4; u += NWAVES * 64) ((LAS unsigned*)(F.lds + LDSCTL_OFF))[u] = 0u;
    __syncthreads();
    const int lo = args.ph_lo, hi = args.ph_hi;
    XcdBarrier bar; bar.bar = F.ctl + CW_BAR; bar.x = 0; bar.st = nullptr; bar.w = F.wave;
    if (hi - lo > 1) bar = xcd_barrier_post(F.ctl + CW_BAR, (volatile LAS unsigned*)(F.lds + LDSCTL_OFF), F.wave);
#define IN(k) (lo <= (k) && (k) < hi)
#define SEAM(k) do { if ((k) + 1 < hi) xcd_barrier(bar); } while (0)
    const int c0 = (int)blockIdx.x;
    const int vcu = (F.G % 8 == 0) ? (int)(blockIdx.x % 8) * (F.G / 8) + (int)(blockIdx.x / 8) : (int)blockIdx.x;

    if (IN(0)) { pro_a(F); SEAM(0); }
    if (IN(1)) { pro_b(F); SEAM(1); }
    for (int l = 0; l < DEPTH; ++l) {
        const int pb = 2 + 9 * l;
        if (l < NA) {
            if (IN(pb + 0)) {
                pg8::Gemm g{(const bf16*)(F.ws + WS_H), (const bf16*)(F.ws + WS_WIN) + (size_t)l * NPROJ * D, M, NPROJ, D}; pg8::StaticOrder S; S.init(M, NPROJ, F.G, c0);
                pg8::EpiBf16S E{(bf16*)(F.ws + WS_PROJ), NPROJ, 2, 4, 0.08838834764831845f};
                pg8::gemm_phase<pg8::EpiBf16S, pg8::StaticOrder, true>(F.lds, g, S, E, F.wave);
                SEAM(pb + 0);
            }
            if (IN(pb + 1)) { ml_a(F); SEAM(pb + 1); }
            if (IN(pb + 2)) { ml_scan(F); SEAM(pb + 2); }
            if (IN(pb + 3)) { ml_c(F, l); SEAM(pb + 3); }
            if (IN(pb + 4)) {
                pg8::Gemm g{(const bf16*)(F.ws + WS_YA), (const bf16*)(F.ws + WS_WOUT) + (size_t)l * D * D, M, D, D}; pg8::StaticOrder S; S.init(M, D, F.G, c0);
                pg8::EpiBf16S E{(bf16*)(F.ws + WS_YMIX), D, 0, 0, 1.f};
                pg8::gemm_phase<pg8::EpiBf16S, pg8::StaticOrder, false>(F.lds, g, S, E, F.wave);
                SEAM(pb + 4);
            }
        } else {
            if (IN(pb + 0)) {
                if (l == NA) {
                    pg8::Gemm g{(const bf16*)(F.ws + WS_X), (const bf16*)(F.ws + WS_WKV), M, NKV, D}; pg8::StaticOrder S; S.init(M, NKV, F.G, c0);
                    pg8::EpiRope E{(bf16*)(F.ws + WS_KV), NKV, 6, (const float*)(F.ws + WS_ROPE), 1.0f};
                    pg8::gemm_phase<pg8::EpiRope, pg8::StaticOrder, true>(F.lds, g, S, E, F.wave);
                }
                {
                    pg8::Gemm g{(const bf16*)(F.ws + WS_H), (const bf16*)(F.ws + WS_WQ) + (size_t)(l - NA) * NQ * D, M, NQ, D}; pg8::StaticOrder S; S.init(M, NQ, F.G, c0);
                    pg8::EpiRope E{(bf16*)(F.ws + WS_Q), NQ, 6, (const float*)(F.ws + WS_ROPE), 0.125f * 1.4426950408889634f};
                    pg8::gemm_phase<pg8::EpiRope, pg8::StaticOrder, true>(F.lds, g, S, E, F.wave);
                    { const int nq = (M / 256) * (NQ / 256), full = nq / F.G, cutq = nq - full * F.G;
                      if (cutq > 0 && F.G - cutq >= F.G / 4) { __syncthreads(); if (c0 >= cutq) { const int tid = opaque_tid(), lane = tid & 63, wave = __builtin_amdgcn_readfirstlane(tid >> 6);
                              conv_run<5>(F, l, (c0 - cutq) * NWAVES + wave, (F.G - cutq) * NWAVES, lane, wave); } }
                      else { __syncthreads(); const int tid = opaque_tid(), lane = tid & 63, wave = __builtin_amdgcn_readfirstlane(tid >> 6); conv_run<5>(F, l, c0 * NWAVES + wave, F.G * NWAVES, lane, wave); } }
                }
                SEAM(pb + 0);
            }
            if (IN(pb + 1)) { att_mfma(F); SEAM(pb + 1); }
            if (IN(pb + 2)) { att_combine(F); SEAM(pb + 2); }
            if (IN(pb + 4)) {
                pg8::Gemm g{(const bf16*)(F.ws + WS_YA), (const bf16*)(F.ws + WS_WO) + (size_t)(l - NA) * D * BW, M, D, BW}; pg8::StaticOrder S; S.init(M, D, F.G, c0);
                pg8::EpiBf16S E{(bf16*)(F.ws + WS_YMIX), D, 0, 0, 1.f};
                pg8::gemm_phase<pg8::EpiBf16S, pg8::StaticOrder, false>(F.lds, g, S, E, F.wave);
                SEAM(pb + 4);
            }
        }
        if (IN(pb + 5)) { phase_r1<false>(F, l); SEAM(pb + 5); }
        if (IN(pb + 6)) {
            moe_table(F, l);
            pg8::Gemm g{(const bf16*)(F.ws + WS_H), nullptr, 0, 512, D};
            pg8::MoeOrder S{(const LAS int*)(F.lds + LDSCTL_OFF + 64), (const int*)(F.ws + WS_LIST), (const bf16*)(F.ws + WS_WGU) + (size_t)l * NE * 512 * D, (size_t)512 * D, 2, F.G, vcu, 1};
            pg8::EpiGU E{(bf16*)(F.ws + WS_ACT)};
            pg8::gemm_phase<pg8::EpiGU, pg8::MoeOrder, true>(F.lds, g, S, E, F.wave);
            if (l + 1 < DEPTH) { __syncthreads(); tail_fill<4>(F, l + 1, ((const LAS int*)(F.lds + LDSCTL_OFF + 64))[32] * 2, vcu); }
            SEAM(pb + 6);
        }
        if (IN(pb + 7)) {
            if (!IN(pb + 6)) moe_table(F, l);
            pg8::Gemm g{(const bf16*)(F.ws + WS_ACT), nullptr, 0, D, MH};
            pg8::MoeOrder S{(const LAS int*)(F.lds + LDSCTL_OFF + 64), (const int*)(F.ws + WS_LIST), (const bf16*)(F.ws + WS_WD) + (size_t)l * NE * D * MH, (size_t)D * MH, 4, F.G, vcu, 0};
            pg8::EpiBf16S E{(bf16*)(F.ws + WS_Y), D, 0, 0, 1.f};
            pg8::gemm_phase<pg8::EpiBf16S, pg8::MoeOrder, true>(F.lds, g, S, E, F.wave);
            if (l + 1 < DEPTH) { __syncthreads(); const int tu = ((const LAS int*)(F.lds + LDSCTL_OFF + 64))[32] * 4;
                if (l == 0) tail_fill<1>(F, 0, tu, vcu); else if (l == 1) tail_fill<2>(F, 0, tu, vcu); else tail_fill<3>(F, 0, tu, vcu); }
            SEAM(pb + 7);
        }
        if (IN(pb + 8)) { phase_r2<false>(F, l); SEAM(pb + 8); }
    }
#undef IN
#undef SEAM
}

extern "C" void kernel_launch(void* const* d_in, const int* in_sizes, int n_in, void* d_out, int out_size, void* d_ws, size_t ws_size, hipStream_t stream) {
    static int grid = 0;
    if (grid == 0) {
        if (n_in != 21 || in_sizes[0] != M * D || out_size != M * D || ws_size < WS_END) { fprintf(stderr, "kernel_launch: unexpected shapes (n_in %d, in0 %d, out %d, ws %zu < %zu); nothing launched\n", n_in, n_in > 0 ? in_sizes[0] : -1, out_size, ws_size, (size_t)WS_END); grid = -1; return; }
        int dev = 0, cus = 0, per_cu = 0;
        if (hipGetDevice(&dev) != hipSuccess || hipDeviceGetAttribute(&cus, hipDeviceAttributeMultiprocessorCount, dev) != hipSuccess) { grid = -1; return; }
        if (hipFuncSetAttribute((const void*)fwd, hipFuncAttributeMaxDynamicSharedMemorySize, LDS_BYTES) != hipSuccess) { fprintf(stderr, "kernel_launch: hipFuncSetAttribute failed\n"); grid = -1; return; }
        if (hipOccupancyMaxActiveBlocksPerMultiprocessor(&per_cu, (const void*)fwd, NWAVES * 64, LDS_BYTES) != hipSuccess || per_cu < 1) fprintf(stderr, "kernel_launch: occupancy query reports %d workgroups per CU\n", per_cu);
        (void)hipGetLastError();
        grid = cus;
    }
    if (grid < 0) return;
    if (hipMemsetAsync((char*)d_ws + WS_CTL, 0, CTL_ZERO_BYTES, stream) != hipSuccess) return;
    Args a{};
    for (int i = 0; i < 21; ++i) a.in[i] = d_in[i];
    a.out = (float*)d_out; a.ws = (unsigned char*)d_ws;
#if MK_N_LAUNCHES == 1
    a.ph_lo = 0; a.ph_hi = NPHASE;
    hipLaunchKernelGGL(fwd, dim3(grid), dim3(NWAVES * 64), LDS_BYTES, stream, a);
#else
    for (int p = 0; p < NPHASE; ++p) { a.ph_lo = p; a.ph_hi = p + 1; hipLaunchKernelGGL(fwd, dim3(grid), dim3(NWAVES * 64), LDS_BYTES, stream, a); }
#endif
}
```

```cpp
#include <hip/hip_runtime.h>
#include <cstdio>
#include <cstdint>

#ifndef MK_N_LAUNCHES
#define MK_N_LAUNCHES 1
#endif

__device__ __forceinline__ int hw_tid(int wave_s) {
    unsigned z = 0u; asm volatile("" : "+s"(z));
    const unsigned lane = __builtin_amdgcn_mbcnt_hi(~0u, __builtin_amdgcn_mbcnt_lo(~0u, z));
    int t = (int)(((unsigned)wave_s << 6) | lane); asm volatile("" : "+v"(t)); return t;
}
namespace pg8 {
#define PG8_LAS __attribute__((address_space(3)))
typedef unsigned short bf16_t;
typedef short bf16x8 __attribute__((ext_vector_type(8)));
typedef float f32x4 __attribute__((ext_vector_type(4)));
typedef float f32x2 __attribute__((ext_vector_type(2)));
typedef unsigned u32x4 __attribute__((ext_vector_type(4)));
typedef unsigned u32x2 __attribute__((ext_vector_type(2)));
constexpr int BM = 256, BK = 64, HALF = 128, HTB = HALF * BK * 2  , STAGE_BYTES = 8 * HTB, NXCD = 8, WGM = 8;

__host__ __device__ __forceinline__ int lds_byte(int r, int c) { const int st = (r >> 4) * 2 + (c >> 5), rr = r & 15, cc = c & 31, ob = rr * 64 + cc * 2; return st * 1024 + (ob ^ (((ob >> 9) & 1) << 5)); }
__host__ __device__ __forceinline__ void stage_rc(int b, int& R, int& C) { const int st = b / 1024, sb = b % 1024, swz = sb ^ (((sb >> 9) & 1) << 5); R = (st >> 1) * 16 + swz / 64; C = (st & 1) * 32 + (swz % 64) / 2; }
__host__ __device__ __forceinline__ int perm32(int rho) { const int n = rho >> 4, i = rho & 15; return 8 * (i >> 2) + 4 * n + (i & 3); }

struct Unit { int pm, pn, ex, jb; };
struct Gemm { const bf16_t* A; const bf16_t* Bt; int M, N, K; };

struct StaticOrder {
    int nM, nN, nwg, G, c;
    __device__ void init(int M, int N, int G_, int c_) { nM = M / BM; nN = N / BM; nwg = nM * nN; G = G_; c = c_; }
    __device__ bool next(int i, Unit& u) const {
        const long L = (long)i * G + c; if (L >= nwg) return false;
        int wgid = (int)L; { const int q = nwg / NXCD, r = nwg % NXCD, xcd = wgid % NXCD, off = wgid / NXCD; wgid = (xcd < r ? xcd * (q + 1) : r * (q + 1) + (xcd - r) * q) + off; }
        const int nig = WGM * nN, gid = wgid / nig, fm = gid * WGM, gsz = (nM - fm) < WGM ? (nM - fm) : WGM;
        u.pm = fm + ((wgid % nig) % gsz); u.pn = (wgid % nig) / gsz; u.ex = 0; u.jb = 0; return true;
    }
    __device__ __forceinline__ const char* b_ptr(const Gemm& g, const Unit& u) const { return (const char*)g.Bt + (size_t)u.pn * BM * g.K * 2; }
    __device__ __forceinline__ unsigned a_off(const Gemm& g, const Unit& u, int h, int R, int C) const { return (unsigned)((u.pm * BM + h * HALF + R) * g.K + C) * 2u; }
};

struct MoeOrder {
    const PG8_LAS int* tab; const int* list; const bf16_t* W; size_t wstride; int ntn, G, c, gather;
    __device__ bool next(int i, Unit& u) const {
        const int L = i * G + c; const int total = tab[32] * ntn; if (L >= total) return false;
        const int rb = L / ntn; u.pn = L - rb * ntn;
        unsigned z = 0u; asm volatile("" : "+s"(z));
        const unsigned ln = __builtin_amdgcn_mbcnt_hi(~0u, __builtin_amdgcn_mbcnt_lo(~0u, z));
        const unsigned long long m = __ballot(rb >= tab[ln & 31u]);
        const int e = __builtin_popcount((unsigned)m) - 1;
        u.pm = rb; u.ex = e; u.jb = rb - tab[e]; return true;
    }
    __device__ __forceinline__ const char* b_ptr(const Gemm& g, const Unit& u) const { return (const char*)(W + (size_t)u.ex * wstride) + (size_t)u.pn * BM * g.K * 2; }
    __device__ __forceinline__ unsigned a_off(const Gemm& g, const Unit& u, int h, int R, int C) const {
        if (gather) { const int p = u.jb * BM + h * HALF + R; const int cnt = tab[33 + u.ex]; const int tok = list[u.ex * 16384 + (p < cnt ? p : 0)]; return (unsigned)(tok * g.K + C) * 2u; }
        return (unsigned)((u.pm * BM + h * HALF + R) * g.K + C) * 2u;
    }
};

__device__ __forceinline__ unsigned cvt_pk_bf16(float lo, float hi) { unsigned r; asm volatile("v_cvt_pk_bf16_f32 %0, %1, %2" : "=v"(r) : "v"(lo), "v"(hi)); return r; }

struct EpiF32 {
    static constexpr bool PERM = false;
    float* C; int ldc;
    __device__ __forceinline__ void operator()(const f32x4 (&acc)[2][2][4][2], const Unit& u, int wr, int wc, int fr, int fq) const {
        const int row0 = u.pm * BM + wr * 64 + fr, col0 = u.pn * BM + wc * 32 + 4 * fq;
#pragma unroll
        for (int ai = 0; ai < 2; ++ai)
#pragma unroll
            for (int m = 0; m < 4; ++m) { float* rowp = C + (size_t)(row0 + ai * HALF + m * 16) * ldc + col0;
#pragma unroll
                for (int bj = 0; bj < 2; ++bj)
#pragma unroll
                    for (int n = 0; n < 2; ++n) *(f32x4*)(rowp + bj * HALF + n * 16) = acc[ai][bj][m][n]; }
    }
};
struct EpiBf16S {
    static constexpr bool PERM = true;
    bf16_t* O; int ldc; int pn_lo, pn_hi; float scale;
    __device__ __forceinline__ void operator()(const f32x4 (&acc)[2][2][4][2], const Unit& u, int wr, int wc, int fr, int fq) const {
        const int row0 = u.pm * BM + wr * 64 + fr, col0 = u.pn * BM + wc * 32 + 8 * fq;
        const float sc = (u.pn >= pn_lo && u.pn < pn_hi) ? scale : 1.f;
#pragma unroll
        for (int ai = 0; ai < 2; ++ai)
#pragma unroll
            for (int m = 0; m < 4; ++m) { bf16_t* rowp = O + (size_t)(row0 + ai * HALF + m * 16) * ldc + col0;
#pragma unroll
                for (int bj = 0; bj < 2; ++bj) { const f32x4 v0 = acc[ai][bj][m][0] * sc, v1 = acc[ai][bj][m][1] * sc;
                    u32x4 w; w.x = cvt_pk_bf16(v0[0], v0[1]); w.y = cvt_pk_bf16(v0[2], v0[3]); w.z = cvt_pk_bf16(v1[0], v1[1]); w.w = cvt_pk_bf16(v1[2], v1[3]);
                    *(u32x4*)(rowp + bj * HALF) = w; } }
    }
};
struct EpiRope {
    static constexpr bool PERM = true;
    bf16_t* O; int ldc; int rope_tiles; const float* cs; float oscale;
    __device__ __forceinline__ void operator()(const f32x4 (&acc)[2][2][4][2], const Unit& u, int wr, int wc, int fr, int fq) const {
        const int row0 = u.pm * BM + wr * 64 + fr, col0 = u.pn * BM + wc * 32 + 8 * fq;
        const bool rope = u.pn < rope_tiles; const int i0 = 16 * (wc & 1) + 4 * fq;
#pragma unroll
        for (int ai = 0; ai < 2; ++ai)
#pragma unroll
            for (int m = 0; m < 4; ++m) { const int row = row0 + ai * HALF + m * 16; bf16_t* rowp = O + (size_t)row * ldc + col0;
                f32x4 t0 = (f32x4){1.f, 0.f, 1.f, 0.f}, t1 = (f32x4){1.f, 0.f, 1.f, 0.f};
                if (rope) { const f32x4* tp = (const f32x4*)(cs + ((size_t)row * 32 + i0) * 2); t0 = tp[0]; t1 = tp[1]; }
#pragma unroll
                for (int bj = 0; bj < 2; ++bj) { const f32x4 v0 = acc[ai][bj][m][0], v1 = acc[ai][bj][m][1];
                    const float a0 = v0[0] * t0[0] - v0[1] * t0[1], a1 = v0[1] * t0[0] + v0[0] * t0[1], a2 = v0[2] * t0[2] - v0[3] * t0[3], a3 = v0[3] * t0[2] + v0[2] * t0[3];
                    const float b0 = v1[0] * t1[0] - v1[1] * t1[1], b1 = v1[1] * t1[0] + v1[0] * t1[1], b2 = v1[2] * t1[2] - v1[3] * t1[3], b3 = v1[3] * t1[2] + v1[2] * t1[3];
                    u32x4 w; w.x = cvt_pk_bf16(a0 * oscale, a1 * oscale); w.y = cvt_pk_bf16(a2 * oscale, a3 * oscale); w.z = cvt_pk_bf16(b0 * oscale, b1 * oscale); w.w = cvt_pk_bf16(b2 * oscale, b3 * oscale);
                    *(u32x4*)(rowp + bj * HALF) = w; } }
    }
};
struct EpiGU {
    static constexpr bool PERM = true;
    bf16_t* O;
    __device__ __forceinline__ void operator()(const f32x4 (&acc)[2][2][4][2], const Unit& u, int wr, int wc, int fr, int fq) const {
        const int row0 = u.pm * BM + wr * 64 + fr, col0 = u.pn * HALF + wc * 32 + 8 * fq;
#pragma unroll
        for (int ai = 0; ai < 2; ++ai)
#pragma unroll
            for (int m = 0; m < 4; ++m) { bf16_t* rowp = O + (size_t)(row0 + ai * HALF + m * 16) * 256 + col0;
                float r[8];
#pragma unroll
                for (int n = 0; n < 2; ++n)
#pragma unroll
                    for (int j = 0; j < 4; ++j) { const float gt = acc[ai][0][m][n][j], up = acc[ai][1][m][n][j]; r[n * 4 + j] = gt * __builtin_amdgcn_rcpf(1.f + __expf(-gt)) * up; }
                u32x4 w; w.x = cvt_pk_bf16(r[0], r[1]); w.y = cvt_pk_bf16(r[2], r[3]); w.z = cvt_pk_bf16(r[4], r[5]); w.w = cvt_pk_bf16(r[6], r[7]);
                *(u32x4*)rowp = w; }
    }
};

template <class Epi, class Sched, bool ALIGN_EPI>
__device__ __forceinline__ void gemm_phase(PG8_LAS unsigned char* lds, const Gemm g, const Sched& S, const Epi& E, int wave_s) {
    const int tid = hw_tid(wave_s);
    const int wid = __builtin_amdgcn_readfirstlane(tid >> 6), lane = tid & 63, wr = wid >> 2, wc = wid & 3, fr = lane & 15, fq = lane >> 4;
    const int K = g.K, nt = K / BK;
    int sR[2], sC[2]; unsigned voffB[2];
#pragma unroll
    for (int i = 0; i < 2; ++i) { int R, C; stage_rc(tid * 16 + i * 8192, R, C); sR[i] = R; sC[i] = C; const int Rb = Epi::PERM ? ((R & ~31) + perm32(R & 31)) : R; voffB[i] = (unsigned)(Rb * K + C) * 2u; }
    const unsigned kstep = (unsigned)(BK * 2);
    const size_t hstep = (size_t)HALF * K * 2;
    const unsigned ldsw = (unsigned)wid * 1024u;
    const int aoff = lds_byte(wr * 64 + fr, fq * 8), boff = lds_byte(wc * 32 + fr, fq * 8);
    const char* const Ab = (const char*)g.A;
#define PG8_SA(b, h) (((b) * 2 + (h)) * HTB)
#define PG8_SB(b, h) ((4 + (b) * 2 + (h)) * HTB)
#define PG8_STAGEB(bufoff, gbase) do { _Pragma("unroll") for (int _i = 0; _i < 2; ++_i) \
        __builtin_amdgcn_global_load_lds((const unsigned*)((const char*)(gbase) + voffB[_i]), (PG8_LAS unsigned*)(lds + (bufoff) + ldsw + _i * 8192), 16, 0, 0); } while (0)
#define PG8_STAGEA(bufoff, o0, o1) do { \
        __builtin_amdgcn_global_load_lds((const unsigned*)(Ab + (o0)), (PG8_LAS unsigned*)(lds + (bufoff) + ldsw), 16, 0, 0); \
        __builtin_amdgcn_global_load_lds((const unsigned*)(Ab + (o1)), (PG8_LAS unsigned*)(lds + (bufoff) + ldsw + 8192), 16, 0, 0); } while (0)
#define PG8_LDA(dst, b, h) do { _Pragma("unroll") for (int m = 0; m < 4; ++m) _Pragma("unroll") for (int k = 0; k < 2; ++k) dst[m][k] = *(const PG8_LAS bf16x8*)(lds + PG8_SA(b, h) + aoff + m * 2048 + k * 1024); } while (0)
#define PG8_LDB(dst, b, h) do { _Pragma("unroll") for (int n = 0; n < 2; ++n) _Pragma("unroll") for (int k = 0; k < 2; ++k) dst[n][k] = *(const PG8_LAS bf16x8*)(lds + PG8_SB(b, h) + boff + n * 2048 + k * 1024); } while (0)
#define PG8_MMA(ai, bj, At, Bt) do { __builtin_amdgcn_s_setprio(1); _Pragma("unroll") for (int m = 0; m < 4; ++m) _Pragma("unroll") for (int n = 0; n < 2; ++n) _Pragma("unroll") for (int k = 0; k < 2; ++k) \
        acc[ai][bj][m][n] = __builtin_amdgcn_mfma_f32_16x16x32_bf16(Bt[n][k], At[m][k], acc[ai][bj][m][n], 0, 0, 0); __builtin_amdgcn_s_setprio(0); } while (0)
#define PG8_WAIT_V(n) asm volatile("s_waitcnt vmcnt(" #n ")" ::: "memory")
#define PG8_WAIT_L(n) asm volatile("s_waitcnt lgkmcnt(" #n ")" ::: "memory")
#define PG8_BAR __builtin_amdgcn_s_barrier()
#define PG8_SCHED __builtin_amdgcn_sched_barrier(0)
    Unit cur, nxt; int ui = 0;
    if (!S.next(0, cur)) return;
    f32x4 acc[2][2][4][2];
#pragma unroll
    for (int a = 0; a < 2; ++a)
#pragma unroll
        for (int b = 0; b < 2; ++b)
#pragma unroll
            for (int m = 0; m < 4; ++m)
#pragma unroll
                for (int n = 0; n < 2; ++n) acc[a][b][m][n] = (f32x4){0.f, 0.f, 0.f, 0.f};
    bf16x8 At[4][2], B0[2][2], B1[2][2];
    unsigned vA00, vA01, vA10, vA11;
    vA00 = S.a_off(g, cur, 0, sR[0], sC[0]); vA01 = S.a_off(g, cur, 0, sR[1], sC[1]); vA10 = S.a_off(g, cur, 1, sR[0], sC[0]); vA11 = S.a_off(g, cur, 1, sR[1], sC[1]);
    const char* cB = S.b_ptr(g, cur);
    PG8_STAGEB(PG8_SB(0, 0), cB); PG8_STAGEB(PG8_SB(0, 1), cB + hstep); PG8_STAGEA(PG8_SA(0, 0), vA00, vA01); PG8_STAGEA(PG8_SA(0, 1), vA10, vA11);
    if (wr == 1) PG8_BAR;
    PG8_WAIT_V(2); PG8_BAR;
    PG8_STAGEB(PG8_SB(1, 0), cB + kstep); PG8_STAGEA(PG8_SA(1, 0), vA00 + kstep, vA01 + kstep); PG8_STAGEB(PG8_SB(1, 1), cB + hstep + kstep);
    PG8_WAIT_V(6); PG8_BAR;
    for (;;) {
        const bool has_next = S.next(ui + 1, nxt);
        const char* nB = has_next ? S.b_ptr(g, nxt) : cB;
        unsigned nA00 = vA00, nA01 = vA01, nA10 = vA10, nA11 = vA11;
        if (has_next) { nA00 = S.a_off(g, nxt, 0, sR[0], sC[0]); nA01 = S.a_off(g, nxt, 0, sR[1], sC[1]); nA10 = S.a_off(g, nxt, 1, sR[0], sC[0]); nA11 = S.a_off(g, nxt, 1, sR[1], sC[1]); }
#pragma unroll 1
        for (int t = 0; t < nt; t += 2) {
            const bool last = (t == nt - 2);
            const unsigned k1 = (unsigned)(t + 1) * kstep;
            const unsigned k2 = last ? 0u : (unsigned)(t + 2) * kstep, k3 = k2 + kstep;
            const char* b2 = last ? nB : cB + (size_t)(t + 2) * kstep; const char* b3 = b2 + kstep;
            const unsigned s00 = (last ? nA00 : vA00), s01 = (last ? nA01 : vA01), s10 = (last ? nA10 : vA10), s11 = (last ? nA11 : vA11);
            PG8_LDB(B0, 0, 0); PG8_LDB(B1, 0, 1); PG8_SCHED; PG8_LDA(At, 0, 0); PG8_STAGEA(PG8_SA(1, 1), vA10 + k1, vA11 + k1);
            PG8_WAIT_V(8); PG8_WAIT_L(0); PG8_BAR; PG8_MMA(0, 0, At, B0); PG8_MMA(0, 1, At, B1); PG8_BAR; PG8_SCHED;
            PG8_LDA(At, 0, 1); PG8_STAGEB(PG8_SB(0, 0), b2); PG8_STAGEB(PG8_SB(0, 1), b2 + hstep); PG8_STAGEA(PG8_SA(0, 0), s00 + k2, s01 + k2);
            PG8_WAIT_V(8); PG8_WAIT_L(0); PG8_BAR; PG8_MMA(1, 0, At, B0); PG8_MMA(1, 1, At, B1); PG8_BAR; PG8_SCHED;
            PG8_LDB(B0, 1, 0); PG8_LDB(B1, 1, 1); PG8_SCHED; PG8_LDA(At, 1, 0); PG8_STAGEA(PG8_SA(0, 1), s10 + k2, s11 + k2);
            PG8_WAIT_V(8); PG8_WAIT_L(0); PG8_BAR; PG8_MMA(0, 0, At, B0); PG8_MMA(0, 1, At, B1); PG8_BAR; PG8_SCHED;
            PG8_LDA(At, 1, 1); PG8_STAGEB(PG8_SB(1, 0), b3); PG8_STAGEB(PG8_SB(1, 1), b3 + hstep); PG8_STAGEA(PG8_SA(1, 0), s00 + k3, s01 + k3);
            PG8_WAIT_V(8); PG8_WAIT_L(0); PG8_BAR; PG8_MMA(1, 0, At, B0); PG8_MMA(1, 1, At, B1); PG8_BAR; PG8_SCHED;
        }
        if constexpr (ALIGN_EPI) { if (wr == 0) PG8_BAR; }
        E(acc, cur, wr, wc, fr, fq);
        if (!has_next) break;
#pragma unroll
        for (int a = 0; a < 2; ++a)
#pragma unroll
            for (int b = 0; b < 2; ++b)
#pragma unroll
                for (int m = 0; m < 4; ++m)
#pragma unroll
                    for (int n = 0; n < 2; ++n) acc[a][b][m][n] = (f32x4){0.f, 0.f, 0.f, 0.f};
        cur = nxt; cB = nB; vA00 = nA00; vA01 = nA01; vA10 = nA10; vA11 = nA11; ++ui;
        if constexpr (ALIGN_EPI) { if (wr == 1) PG8_BAR; }
    }
    PG8_WAIT_V(0);
    if constexpr (!ALIGN_EPI) { if (wr == 0) PG8_BAR; }
    PG8_BAR;
#undef PG8_SA
#undef PG8_SB
#undef PG8_STAGEA
#undef PG8_STAGEB
#undef PG8_LDA
#undef PG8_LDB
#undef PG8_MMA
#undef PG8_WAIT_V
#undef PG8_WAIT_L
#undef PG8_BAR
#undef PG8_SCHED
}
}

constexpr int NWAVES = 8;
constexpr int BATCH = 2, SEQ = 8192, D = 1024, M = BATCH * SEQ, DEPTH = 4, NA = 2;
constexpr float ALPHA = 1.681792830507429f;
constexpr float LN_EPS = 1e-5f, A_NORM_EPS = 1e-6f;
constexpr int AH = 4, DQK = 128, DV = 256, APROJ = 3080, NPROJ = 3072;
constexpr int CH = 256, NCH = SEQ / CH;
constexpr int BG = 3, BH = 8, HD = 64, BW = 512, NQ = 1536, NKV = 3072;
constexpr int NE = 32, EG = 8, MH = 256;
constexpr int MAXRB = 160;

constexpr size_t MiB = 1u << 20;
constexpr size_t WS_CTL = 0, CTL_ZERO_BYTES = 128 * 1024;
constexpr size_t WS_MOD = 1 * MiB;
constexpr size_t WS_ROPE = 2 * MiB;
constexpr size_t WS_WR = 6 * MiB;
constexpr size_t WS_WG = 6 * MiB + 768 * 1024;
constexpr size_t WS_GATES = 7 * MiB;
constexpr size_t WS_ROUTE = 8 * MiB;
constexpr size_t WS_LIST = 9 * MiB;
constexpr size_t WS_MLS = 11 * MiB;
constexpr size_t WS_WIN = 12 * MiB, WS_WOUT = 24 * MiB, WS_WKV = 28 * MiB, WS_WQ = 34 * MiB, WS_WO = 40 * MiB, WS_WGU = 42 * MiB, WS_WD = 170 * MiB;
constexpr size_t WS_H = 234 * MiB;
constexpr size_t WS_YA = 266 * MiB;
constexpr size_t WS_S0 = 298 * MiB;
constexpr size_t WS_PROJ = WS_S0, WS_DC = WS_S0 + 96 * MiB, WS_CIN = WS_S0 + 128 * MiB;
constexpr size_t WS_Q = WS_S0, WS_OG = WS_S0 + 48 * MiB, WS_LSE = WS_S0 + 96 * MiB, WS_KV = WS_S0 + 112 * MiB;
constexpr size_t WS_YMIX = WS_S0;
constexpr size_t WS_Y = WS_S0, WS_ACT = WS_S0 + 80 * MiB;
constexpr size_t WS_X = WS_S0 + 208 * MiB;
constexpr size_t WS_END = WS_X + 64 * MiB;
constexpr int CW_BAR = 4096;
constexpr int CW_CNT = 16384;

constexpr int RING_BYTES = 131072;
constexpr int LDSCTL_OFF = 145408;
constexpr int LDS_BYTES = 147456;

#define GAS __attribute__((address_space(1)))
#define LAS __attribute__((address_space(3)))
typedef unsigned short bf16;
typedef unsigned v4u __attribute__((ext_vector_type(4)));
typedef unsigned v2u __attribute__((ext_vector_type(2)));
typedef float f32x4 __attribute__((ext_vector_type(4)));
typedef float f32x2 __attribute__((ext_vector_type(2)));
#define RLX_AGENT __ATOMIC_RELAXED, __HIP_MEMORY_SCOPE_AGENT
#ifndef ST_NT
#define ST_NT(p, v) __builtin_nontemporal_store((v), (p))
#endif
__device__ __forceinline__ unsigned f2bf(float f) { unsigned u = __builtin_bit_cast(unsigned, f); return (u + 0x7fffu + ((u >> 16) & 1u)) >> 16; }
typedef __bf16 bf16n2 __attribute__((ext_vector_type(2)));
__device__ __forceinline__ unsigned pk2(float lo, float hi) { bf16n2 v; v.x = (__bf16)lo; v.y = (__bf16)hi; return __builtin_bit_cast(unsigned, v); }
__device__ __forceinline__ float u2f(unsigned w) { return __builtin_bit_cast(float, w); }
__device__ __forceinline__ unsigned f2u(float f) { return __builtin_bit_cast(unsigned, f); }
__device__ __forceinline__ float bflo(unsigned w) { return __builtin_bit_cast(float, w << 16); }
__device__ __forceinline__ float bfhi(unsigned w) { return __builtin_bit_cast(float, w & 0xffff0000u); }
__device__ __forceinline__ float bf2f(bf16 v) { return __builtin_bit_cast(float, (unsigned)v << 16); }
template <int CTRL> __device__ __forceinline__ float dpp_mov(float v) { return __builtin_bit_cast(float, __builtin_amdgcn_update_dpp(0, __builtin_bit_cast(int, v), CTRL, 0xF, 0xF, true)); }
__device__ __forceinline__ float rdlane(float v, int l) { return __builtin_bit_cast(float, __builtin_amdgcn_readlane(__builtin_bit_cast(int, v), l)); }
__device__ __forceinline__ float quad_sum(float v) { v += dpp_mov<0xB1>(v); v += dpp_mov<0x4E>(v); return v; }
__device__ __forceinline__ float quad_max(float v) { v = fmaxf(v, dpp_mov<0xB1>(v)); v = fmaxf(v, dpp_mov<0x4E>(v)); return v; }
__device__ __forceinline__ float row16_sum(float v) { v += dpp_mov<0xB1>(v); v += dpp_mov<0x4E>(v); v += dpp_mov<0x141>(v); v += dpp_mov<0x140>(v); return v; }
__device__ __forceinline__ float row16_max(float v) { v = fmaxf(v, dpp_mov<0xB1>(v)); v = fmaxf(v, dpp_mov<0x4E>(v)); v = fmaxf(v, dpp_mov<0x141>(v)); v = fmaxf(v, dpp_mov<0x140>(v)); return v; }
__device__ __forceinline__ float wave_sum(float v) { v = row16_sum(v); return (rdlane(v, 0) + rdlane(v, 16)) + (rdlane(v, 32) + rdlane(v, 48)); }
__device__ __forceinline__ float wave_max(float v) { v = row16_max(v); return fmaxf(fmaxf(rdlane(v, 0), rdlane(v, 16)), fmaxf(rdlane(v, 32), rdlane(v, 48))); }
#define opaque_tid() hw_tid(F.wave)
__device__ __forceinline__ float sigmoidf_(float x) { return __builtin_amdgcn_rcpf(1.f + __expf(-x)); }
__device__ __forceinline__ float logsigmoidf_(float x) { return fminf(x, 0.f) - __logf(1.f + __expf(-fabsf(x))); }
__device__ __forceinline__ float lane_xor(float v, int m, int lane) { return __builtin_bit_cast(float, __builtin_amdgcn_ds_bpermute((lane ^ m) << 2, __builtin_bit_cast(int, v))); }
__device__ __forceinline__ float lane_up(float v, int o, int lane) { return __builtin_bit_cast(float, __builtin_amdgcn_ds_bpermute(((lane - o) & 63) << 2, __builtin_bit_cast(int, v))); }
__device__ __forceinline__ int lane_up(int v, int o, int lane) { return __builtin_amdgcn_ds_bpermute(((lane - o) & 63) << 2, v); }
__device__ __forceinline__ int lane_get(int v, int src) { return __builtin_amdgcn_ds_bpermute(src << 2, v); }

#define XB_TMO      128
#define XB_XCNT(j)  (256  + 64 * (j))
#define XB_XSUB(j)  (1280 + 64 * (j))
#define XB_XGEN(j)  (2304 + 64 * (j))
#define XB_TOP      3328
#define XB_TOPGEN   3392
#define XCD_BAR_WORDS 3456
#define XB_SPIN_CAP (1u << 18)

__device__ __forceinline__ unsigned xb_ld(unsigned* p)              { return __hip_atomic_load(p, __ATOMIC_RELAXED, __HIP_MEMORY_SCOPE_AGENT); }
__device__ __forceinline__ unsigned xb_add(unsigned* p, unsigned v) { return __hip_atomic_fetch_add(p, v, __ATOMIC_RELAXED, __HIP_MEMORY_SCOPE_AGENT); }
__device__ __forceinline__ unsigned xb_xcc_id() { return (unsigned)__builtin_amdgcn_s_getreg((3 << 11) | 20) & 0xFu; }
#define XB_SPIN(cond, bar) do { unsigned _sp = 0; while (cond) { __builtin_amdgcn_s_sleep(1); \
    if ((++_sp & 255u) == 0u) { if (xb_ld(&(bar)[XB_TMO])) break; if (_sp > XB_SPIN_CAP) { atomicAdd(&(bar)[XB_TMO], 1u); break; } } } } while (0)

struct XcdBarrier {
    unsigned* bar; unsigned x;
    volatile LAS unsigned* st;
    int w;
};
__device__ __forceinline__ XcdBarrier xcd_barrier_post(unsigned* bar, volatile LAS unsigned* st, int wave_s) {
    XcdBarrier b; b.bar = bar; b.x = xb_xcc_id(); b.st = st; b.w = wave_s;
    if (hw_tid(wave_s) == 0) (void)xb_add(&bar[XB_XCNT(b.x)], 1u);
    return b;
}
__device__ __forceinline__ void xcd_barrier_complete(unsigned* bar, unsigned x, unsigned& nloc, unsigned& nx) {
    const unsigned G = gridDim.x * gridDim.y * gridDim.z;
    unsigned sum, cnt, mine, sp = 0u;
    for (;;) {
        sum = 0u; cnt = 0u; mine = 0u;
#pragma unroll
        for (unsigned j = 0; j < 16; ++j) { const unsigned c = xb_ld(&bar[XB_XCNT(j)]); sum += c; cnt += (c > 0u) ? 1u : 0u; mine = (j == x) ? c : mine; }
        if (sum == G) break;
        __builtin_amdgcn_s_sleep(1);
        if ((++sp & 255u) == 0u) { if (xb_ld(&bar[XB_TMO])) break; if (sp > XB_SPIN_CAP) { atomicAdd(&bar[XB_TMO], 1u); break; } }
    }
    nloc = mine > 0u ? mine : 1u; nx = cnt > 0u ? cnt : 1u;
}
__device__ __forceinline__ void xcd_barrier(const XcdBarrier& b) {
    asm volatile("s_waitcnt vmcnt(0)" ::: "memory");
    __syncthreads();
    if (hw_tid(b.w) == 0) {
        unsigned* bar = b.bar;
        __builtin_amdgcn_s_waitcnt(0);
        unsigned nloc = b.st[0], nx = b.st[1];
        if (nloc == 0u) { xcd_barrier_complete(bar, b.x, nloc, nx); b.st[0] = nloc; b.st[1] = nx; }
        const unsigned old = xb_add(&bar[XB_XSUB(b.x)], 1u);
        const unsigned gen = old / nloc;
        if (old + 1u == (gen + 1u) * nloc) {
            __builtin_amdgcn_fence(__ATOMIC_RELEASE, "agent");
            asm volatile("s_waitcnt vmcnt(0)" ::: "memory");
            const unsigned og = xb_add(&bar[XB_TOP], 1u);
            const unsigned tg = og / nx;
            if (og + 1u == (tg + 1u) * nx) xb_add(&bar[XB_TOPGEN], 1u);
            else XB_SPIN(xb_ld(&bar[XB_TOPGEN]) == tg, bar);
            __builtin_amdgcn_fence(__ATOMIC_ACQUIRE, "agent");
            xb_add(&bar[XB_XGEN(b.x)], 1u);
            asm volatile("s_waitcnt vmcnt(0)" ::: "memory");
        } else {
            XB_SPIN(xb_ld(&bar[XB_XGEN(b.x)]) == gen, bar);
            __builtin_amdgcn_fence(__ATOMIC_ACQUIRE, "agent");
            asm volatile("s_waitcnt vmcnt(0)" ::: "memory");
        }
    }
    __syncthreads();
}

struct Frame {
    LAS unsigned char* lds;
    unsigned* ctl;
    unsigned char* ws;
    int tid, lane, wave, G;
    const float *x, *c; const int* pos; const float *ada_w, *ada_b, *ln_g, *ln_b, *a_w_in, *a_b_gate, *a_norm_g, *a_w_out, *b_w_kv, *b_w_q, *b_w_o,
                *w_r1, *b_r1, *w_r2, *b_r2, *w_gate, *w_up, *w_down;
    float* out;
};

__device__ __forceinline__ int rowmap(int mode, int n) {
    if (mode == 1 || (mode == 2 && n < 1536)) { const int e = n & 63; return (n & ~63) + 2 * (e & 31) + (e >> 5); }
    if (mode == 3) return ((n >> 7) << 8) + (n & 127);
    if (mode == 4) return ((n >> 7) << 8) + 128 + (n & 127);
    return n;
}
__device__ __forceinline__ void transpose_load(const float* W, int ldw, int k0, int n0, f32x4 (&t)[8], int lane) {
#pragma unroll
    for (int i = 0; i < 8; ++i) t[i] = *(const f32x4*)(W + (size_t)(k0 + 8 * i + (lane >> 3)) * ldw + n0 + 4 * (lane & 7));
}
__device__ __forceinline__ void transpose_store(const f32x4 (&t)[8], int k0, int n0, bf16* WT, int ldk, int mode, LAS float* scr, int lane) {
#pragma unroll
    for (int i = 0; i < 8; ++i) { LAS float* d = scr + (8 * i + (lane >> 3)) * 33 + 4 * (lane & 7); d[0] = t[i].x; d[1] = t[i].y; d[2] = t[i].z; d[3] = t[i].w; }
    asm volatile("s_waitcnt lgkmcnt(0)" ::: "memory");
    const int c = lane & 7;
#pragma unroll
    for (int j = 0; j < 4; ++j) { const int n = (lane >> 3) + 8 * j; const LAS float* s = scr + (8 * c) * 33 + n;
        v4u o; o.x = pk2(s[0 * 33], s[1 * 33]); o.y = pk2(s[2 * 33], s[3 * 33]); o.z = pk2(s[4 * 33], s[5 * 33]); o.w = pk2(s[6 * 33], s[7 * 33]);
        *(v4u*)(WT + (size_t)rowmap(mode, n0 + n) * ldk + k0 + 8 * c) = o; }
    asm volatile("s_waitcnt lgkmcnt(0)" ::: "memory");
}
struct TItem { const float* W; bf16* WT; int ldw, k0, n0, ldk, mode; };
__device__ __forceinline__ TItem conv_item(Frame& F, int kind, int l, int r) {
    TItem t; t.mode = 0;
    const float* const wg = F.w_gate; const float* const wu = F.w_up;
    if (kind == 0) { t.W = F.a_w_in + (size_t)l * D * APROJ; t.ldw = APROJ; t.k0 = 64 * (r / 96); t.n0 = 32 * (r % 96); t.WT = (bf16*)(F.ws + WS_WIN) + (size_t)l * NPROJ * D; t.ldk = D; }
    else if (kind == 1) { t.W = F.a_w_out + (size_t)l * D * D; t.ldw = D; t.k0 = 64 * (r / 32); t.n0 = 32 * (r % 32); t.WT = (bf16*)(F.ws + WS_WOUT) + (size_t)l * D * D; t.ldk = D; }
    else if (kind == 2) { t.W = F.b_w_kv; t.ldw = NKV; t.k0 = 64 * (r / 96); t.n0 = 32 * (r % 96); t.WT = (bf16*)(F.ws + WS_WKV); t.ldk = D; t.mode = 2; }
    else if (kind == 3) { t.W = F.b_w_q + (size_t)l * D * NQ; t.ldw = NQ; t.k0 = 64 * (r / 48); t.n0 = 32 * (r % 48); t.WT = (bf16*)(F.ws + WS_WQ) + (size_t)l * NQ * D; t.ldk = D; t.mode = 1; }
    else if (kind == 4) { t.W = F.b_w_o + (size_t)l * BW * D; t.ldw = D; t.k0 = 64 * (r / 32); t.n0 = 32 * (r % 32); t.WT = (bf16*)(F.ws + WS_WO) + (size_t)l * D * BW; t.ldk = BW; }
    else { const int sub = r >> 12, q = r & 4095, le = l * NE + (q >> 7), rr = q & 127;
        if (sub < 2) { t.W = (sub == 0 ? wg : wu) + (size_t)le * D * MH; t.ldw = MH; t.k0 = 64 * (rr / 8); t.n0 = 32 * (rr % 8); t.WT = (bf16*)(F.ws + WS_WGU) + (size_t)le * 512 * D; t.ldk = D; t.mode = 3 + sub; }
        else { t.W = F.w_down + (size_t)le * MH * D; t.ldw = D; t.k0 = 64 * (rr / 32); t.n0 = 32 * (rr % 32); t.WT = (bf16*)(F.ws + WS_WD) + (size_t)le * D * MH; t.ldk = MH; } }
    return t;
}
template <int STAGE> __device__ __forceinline__ int stage_count(int l) { return STAGE == 0 ? 1536 + 512 + 12288 : STAGE == 1 ? 1536 + 512 : STAGE == 2 ? 1536 + 768 + 256 : STAGE == 3 ? 768 + 256 : STAGE == 4 ? (l >= NA ? 8192 : 12288) : 4096; }
template <int STAGE> __device__ __forceinline__ TItem stage_item(Frame& F, int r, int l) {
    if (STAGE == 0) { if (r < 1536) return conv_item(F, 0, 0, r); r -= 1536; if (r < 512) return conv_item(F, 1, 0, r); return conv_item(F, 5, 0, r - 512); }
    if (STAGE == 1) { if (r < 1536) return conv_item(F, 0, 1, r); return conv_item(F, 1, 1, r - 1536); }
    if (STAGE == 2) { if (r < 1536) return conv_item(F, 2, 0, r); r -= 1536; if (r < 768) return conv_item(F, 3, 0, r); return conv_item(F, 4, 0, r - 768); }
    if (STAGE == 3) { if (r < 768) return conv_item(F, 3, 1, r); return conv_item(F, 4, 1, r - 768); }
    if (STAGE == 5) return conv_item(F, 5, l, 8192 + r);
    return conv_item(F, 5, l, r);
}
template <int STAGE> __device__ __forceinline__ void conv_run(Frame& F, int l, int gw, int NGW, int lane, int wave) {
    LAS float* scr = (LAS float*)(F.lds + wave * 16384);
    const int NITEMS = stage_count<STAGE>(l);
    f32x4 cur[8], nxt[8];
    int it = gw;
    if (it < NITEMS) { const TItem t = stage_item<STAGE>(F, it, l); transpose_load(t.W, t.ldw, t.k0, t.n0, cur, lane); }
#pragma unroll 1
    for (; it < NITEMS; it += NGW) {
        const TItem t = stage_item<STAGE>(F, it, l);
        const bool more = it + NGW < NITEMS;
        if (more) { const TItem tn = stage_item<STAGE>(F, it + NGW, l); transpose_load(tn.W, tn.ldw, tn.k0, tn.n0, nxt, lane); }
        transpose_store(cur, t.k0, t.n0, t.WT, t.ldk, t.mode, scr, lane);
        if (more) {
#pragma unroll
            for (int j = 0; j < 8; ++j) cur[j] = nxt[j]; }
    }
}
__device__ __forceinline__ void gemv_run(Frame& F, int tid, int lane, int wave) {
    LAS float* red = (LAS float*)F.lds;
    LAS float* sc = (LAS float*)(F.lds + 8192);
    float* mod = (float*)(F.ws + WS_MOD);
    for (int i = tid; i < 2 * D; i += NWAVES * 64) { const float c = F.c[i]; sc[i] = c / (1.f + expf(-c)); }
    __syncthreads();
    for (int it = blockIdx.x; it < 4 * 64; it += F.G) {
        const int l = it >> 6, n0 = (it & 63) * 96;
        const float* W = F.ada_w + (size_t)l * D * 6144 + n0 + 2 * (lane < 48 ? lane : 0);
        float a00 = 0.f, a01 = 0.f, a10 = 0.f, a11 = 0.f;
        const int k0 = wave * 128;
#pragma unroll 1
        for (int kb = k0; kb < k0 + 128; kb += 32) {
            f32x2 w[32];
#pragma unroll
            for (int k = 0; k < 32; ++k) w[k] = *(const f32x2*)(W + (size_t)(kb + k) * 6144);
#pragma unroll
            for (int k = 0; k < 32; ++k) { const float c0 = sc[kb + k], c1 = sc[D + kb + k]; a00 += c0 * w[k].x; a01 += c0 * w[k].y; a10 += c1 * w[k].x; a11 += c1 * w[k].y; }
        }
        if (lane < 48) { red[(wave * 2 + 0) * 96 + 2 * lane] = a00; red[(wave * 2 + 0) * 96 + 2 * lane + 1] = a01;
                         red[(wave * 2 + 1) * 96 + 2 * lane] = a10; red[(wave * 2 + 1) * 96 + 2 * lane + 1] = a11; }
        __syncthreads();
        if (tid < 192) { const int b = tid / 96, nn = tid % 96; float s = 0.f;
#pragma unroll
            for (int w8 = 0; w8 < 8; ++w8) s += red[(w8 * 2 + b) * 96 + nn];
            mod[(size_t)(l * 2 + b) * 6144 + n0 + nn] = s + F.ada_b[l * 6144 + n0 + nn]; }
        __syncthreads();
    }
}
__device__ __forceinline__ void rope_table(Frame& F, int gt, int NGT) {
    float* cs = (float*)(F.ws + WS_ROPE);
    const float inv = powf(10000.f, -(float)(gt & 31) * 2.0f / 64.0f);
    for (int i = gt; i < M * 32; i += NGT) { const int tok = i >> 5;
        const float ang = (float)F.pos[tok] * inv;
        const double a = (double)ang; const double n = rint(a * 0.15915494309189535); const float r = (float)(a - n * 6.283185307179586);
        *(f32x2*)(cs + 2 * (size_t)i) = (f32x2){cosf(r), sinf(r)}; }
}
template <int STAGE> __device__ __forceinline__ void tail_fill(Frame& F, int l, int total_units, int vcu) {
    const int tid = opaque_tid(), lane = tid & 63, wave = __builtin_amdgcn_readfirstlane(tid >> 6);
    const int maxu = (total_units + F.G - 1) / F.G; int cut = total_units - (maxu - 1) * F.G; if (cut < 0 || F.G - cut < F.G / 2) cut = 0;
    if (vcu >= cut) {
        const int j = vcu - cut, n = F.G - cut;
        if (STAGE == 4) conv_run<STAGE>(F, l, j * NWAVES + wave, n * NWAVES, lane, wave);
        else {
            conv_run<STAGE>(F, l, j * NWAVES + wave, n * NWAVES, lane, wave);
            if (STAGE == 1) rope_table(F, j * (NWAVES * 64) + tid, n * (NWAVES * 64));
        }
    }
}
__device__ __forceinline__ void pro_a(Frame& F) {
    const int tid = opaque_tid(), lane = tid & 63, wave = __builtin_amdgcn_readfirstlane(tid >> 6);
    gemv_run(F, tid, lane, wave);
    conv_run<0>(F, 0, blockIdx.x * NWAVES + wave, F.G * NWAVES, lane, wave);
    {
        const int gt = blockIdx.x * (NWAVES * 64) + tid, NGT = F.G * NWAVES * 64;
        float* WR = (float*)(F.ws + WS_WR); float* WG = (float*)(F.ws + WS_WG);
        for (int i = gt; i < 4 * 48 * D; i += NGT) { const int l = i / (48 * D), c = (i / D) % 48, k = i % D;
            WR[i] = c < 4 ? F.w_r1[(size_t)(l * D + k) * 4 + c] : (c < 36 ? F.w_r2[(size_t)(l * D + k) * 32 + (c - 4)] : 0.f); }
        for (int i = gt; i < 2 * 8 * D; i += NGT) { const int l = i / (8 * D), j = (i / D) % 8, k = i % D; WG[i] = F.a_w_in[(size_t)(l * D + k) * APROJ + NPROJ + j]; }
    }
}

__device__ __forceinline__ void ln_row(f32x4 (&v)[4], const float* lng, const float* lnb, int lane) {
    float s = 0.f;
#pragma unroll
    for (int j = 0; j < 4; ++j) s += (v[j].x + v[j].y) + (v[j].z + v[j].w);
    const float mean = wave_sum(s) * (1.f / D); float q = 0.f;
#pragma unroll
    for (int j = 0; j < 4; ++j) { v[j] = v[j] - mean; q += (v[j].x * v[j].x + v[j].y * v[j].y) + (v[j].z * v[j].z + v[j].w * v[j].w); }
    const float rstd = 1.f / sqrtf(wave_sum(q) * (1.f / D) + LN_EPS);
#pragma unroll
    for (int j = 0; j < 4; ++j) { const f32x4 g = *(const f32x4*)(lng + 256 * j + 4 * lane), b = *(const f32x4*)(lnb + 256 * j + 4 * lane); v[j] = v[j] * rstd * g + b; }
}
__device__ __forceinline__ void modulate(const f32x4 (&v)[4], f32x4 (&h)[4], const float* sc, const float* sh, int lane) {
#pragma unroll
    for (int j = 0; j < 4; ++j) { const f32x4 s = *(const f32x4*)(sc + 256 * j + 4 * lane), t = *(const f32x4*)(sh + 256 * j + 4 * lane); h[j] = v[j] * (1.f + s) + t; }
}
__device__ __forceinline__ void store_row_bf16(bf16* dst, const f32x4 (&h)[4], int lane) {
#pragma unroll
    for (int j = 0; j < 4; ++j) { v2u o; o.x = pk2(h[j].x, h[j].y); o.y = pk2(h[j].z, h[j].w); ST_NT((v2u*)(dst + 256 * j + 4 * lane), o); }
}
__device__ __forceinline__ void gates_row(const f32x4 (&h)[4], const float* WGl, const float* bg, float* grow, int lane) {
    float p[8];
#pragma unroll
    for (int g = 0; g < 8; ++g) { float s = 0.f;
        if ((g & 1) == 0) asm volatile("" ::: "memory");
#pragma unroll
        for (int j = 0; j < 4; ++j) { const f32x4 w = *(const f32x4*)(WGl + g * D + 256 * j + 4 * lane); s += (h[j].x * w.x + h[j].y * w.y) + (h[j].z * w.z + h[j].w * w.w); }
        p[g] = wave_sum(s) + bg[g]; }
    if (lane == 0) { *(f32x4*)grow = (f32x4){p[0], p[1], p[2], p[3]}; *(f32x4*)(grow + 4) = (f32x4){p[4], p[5], p[6], p[7]}; }
}
template <int NR> __device__ __forceinline__ void gates_rows(const f32x4 (&h)[NR][4], const float* WGl, const float* bg, float* grow0, int lane) {
    float p[NR][8];
#pragma unroll
    for (int g = 0; g < 8; ++g) { f32x4 w[4];
#pragma unroll
        for (int j = 0; j < 4; ++j) w[j] = *(const f32x4*)(WGl + g * D + 256 * j + 4 * lane);
#pragma unroll
        for (int r = 0; r < NR; ++r) { float s = 0.f;
#pragma unroll
            for (int j = 0; j < 4; ++j) s += (h[r][j].x * w[j].x + h[r][j].y * w[j].y) + (h[r][j].z * w[j].z + h[r][j].w * w[j].w);
            p[r][g] = wave_sum(s) + bg[g]; } }
    if (lane == 0) {
#pragma unroll
        for (int r = 0; r < NR; ++r) { *(f32x4*)(grow0 + r * 8) = (f32x4){p[r][0], p[r][1], p[r][2], p[r][3]}; *(f32x4*)(grow0 + r * 8 + 4) = (f32x4){p[r][4], p[r][5], p[r][6], p[r][7]}; } }
}
template <int NR> __device__ __forceinline__ void gates_rows_lds(const f32x4 (&h)[NR][4], const LAS float* W, const float* bg, float* grow0, int lane) {
    float p[NR][8];
#pragma unroll
    for (int g = 0; g < 8; ++g) { f32x4 w[4];
#pragma unroll
        for (int j = 0; j < 4; ++j) w[j] = *(const LAS f32x4*)(W + g * D + 256 * j + 4 * lane);
#pragma unroll
        for (int r = 0; r < NR; ++r) { float s = 0.f;
#pragma unroll
            for (int j = 0; j < 4; ++j) s += (h[r][j].x * w[j].x + h[r][j].y * w[j].y) + (h[r][j].z * w[j].z + h[r][j].w * w[j].w);
            p[r][g] = wave_sum(s) + bg[g]; } }
    if (lane == 0) {
#pragma unroll
        for (int r = 0; r < NR; ++r) { *(f32x4*)(grow0 + r * 8) = (f32x4){p[r][0], p[r][1], p[r][2], p[r][3]}; *(f32x4*)(grow0 + r * 8 + 4) = (f32x4){p[r][4], p[r][5], p[r][6], p[r][7]}; } }
}
constexpr int RW = 4;
__device__ __forceinline__ void pro_b(Frame& F) {
    const int tid = opaque_tid(), lane = tid & 63, wave = __builtin_amdgcn_readfirstlane(tid >> 6), gw = blockIdx.x * NWAVES + wave, NGW = F.G * NWAVES;
    const float* mod = (const float*)(F.ws + WS_MOD); bf16* H = (bf16*)(F.ws + WS_H); float* gates = (float*)(F.ws + WS_GATES); const float* WG = (const float*)(F.ws + WS_WG);
    bf16* const xres = (bf16*)(F.ws + WS_X);
    constexpr int RB = 2;
    LAS float* VEC = (LAS float*)F.lds;
    LAS float* WGS = VEC + 4096;
    {
        const float* const m0 = mod; const float* const m1 = mod + 6144;
        const float* const p0 = m0 + 1024; const float* const p1 = m0; const float* const p2 = m1 + 1024; const float* const p3 = m1;
        const bool hi = tid >= 256; const int e = (tid & 255) * 4;
        const f32x4 a = *(const f32x4*)((hi ? p1 : p0) + e), b = *(const f32x4*)((hi ? p3 : p2) + e);
        LAS float* dst = VEC + (hi ? 1024 : 0) + e;
        *(LAS f32x4*)(dst) = a; *(LAS f32x4*)(dst + 2048) = b;
#pragma unroll
        for (int k = 0; k < 4; ++k) *(LAS f32x4*)(WGS + tid * 4 + 2048 * k) = *(const f32x4*)(WG + tid * 4 + 2048 * k);
    }
    f32x4 xv[RB][4];
    auto request = [&](int rowa) {
#pragma unroll
        for (int r = 0; r < RB; ++r)
#pragma unroll
            for (int j = 0; j < 4; ++j) xv[r][j] = *(const f32x4*)(F.x + (size_t)(rowa + r) * D + 256 * j + 4 * lane); };
    const int step = NGW * RB;
    int row0 = gw * RB;
    if (row0 < M) request(row0);
    __syncthreads();
    for (; row0 < M; row0 += step) {
        const int b = row0 >> 13; const LAS float* vl = VEC + 4 * lane + 2048 * b;
        f32x4 h[RB][4];
#pragma unroll
        for (int r = 0; r < RB; ++r)
#pragma unroll
            for (int j = 0; j < 4; ++j) h[r][j] = xv[r][j];
        if (row0 + step < M) request(row0 + step);
#pragma unroll
        for (int r = 0; r < RB; ++r) { store_row_bf16(xres + (size_t)(row0 + r) * D, h[r], lane);
#pragma unroll
            for (int j = 0; j < 4; ++j) h[r][j] = h[r][j] * (1.f + *(const LAS f32x4*)(vl + 256 * j)) + *(const LAS f32x4*)(vl + 1024 + 256 * j);
            store_row_bf16(H + (size_t)(row0 + r) * D, h[r], lane); }
        gates_rows_lds<RB>(h, WGS, F.a_b_gate, gates + (size_t)row0 * 8, lane);
    }
}
template <bool DRY> __device__ __forceinline__ void phase_r1(Frame& F, int l) {
    const int tid = opaque_tid(), lane = tid & 63, wave = __builtin_amdgcn_readfirstlane(tid >> 6), fr = lane & 15, fq = lane >> 4;
    const float* mod = (const float*)(F.ws + WS_MOD); bf16* H = (bf16*)(F.ws + WS_H); const bf16* ymix = (const bf16*)(F.ws + WS_YMIX);
    const float* WR = (const float*)(F.ws + WS_WR) + (size_t)l * 48 * D;
    unsigned* cnt = F.ctl + CW_CNT + l * 32 * 64;     int* list = (int*)(F.ws + WS_LIST); unsigned* route = (unsigned*)(F.ws + WS_ROUTE);
    bf16* const xres = (bf16*)(F.ws + WS_X);
    constexpr int HSP = 1028, RB = 2, BR = NWAVES * RB;
    LAS float* HS = (LAS float*)F.lds; LAS float* PS = (LAS float*)(F.lds + 100864); LAS float* LG = (LAS float*)(F.lds + 125440);
    LAS float* VEC = (LAS float*)(F.lds + 67584);
    {
        const float* const m0 = mod + (size_t)(l * 2 + 0) * 6144; const float* const m1 = mod + (size_t)(l * 2 + 1) * 6144;
        const float* const p0 = F.ln_g + (size_t)(l * 2 + 0) * D; const float* const p1 = F.ln_b + (size_t)(l * 2 + 0) * D;
        const float* const p2 = m0 + 2048; const float* const p3 = m0 + 4096; const float* const p4 = m0 + 3072; const float* const p5 = m1 + 2048; const float* const p6 = m1 + 4096; const float* const p7 = m1 + 3072;
        const bool hi = tid >= 256; const int e = (tid & 255) * 4;
        const f32x4 a = *(const f32x4*)((hi ? p1 : p0) + e), b = *(const f32x4*)((hi ? p3 : p2) + e), c = *(const f32x4*)((hi ? p5 : p4) + e), d = *(const f32x4*)((hi ? p7 : p6) + e);
        LAS float* dst = VEC + (hi ? 1024 : 0) + e;
        *(LAS f32x4*)(dst) = a; *(LAS f32x4*)(dst + 2048) = b; *(LAS f32x4*)(dst + 4096) = c; *(LAS f32x4*)(dst + 6144) = d;
        if (tid < 36) VEC[8192 + tid] = tid < 4 ? F.b_r1[l * 4 + tid] : F.b_r2[l * 32 + tid - 4];
    }
    f32x4 b4[8][3];
#pragma unroll
    for (int mi = 0; mi < 8; ++mi)
#pragma unroll
        for (int ct = 0; ct < 3; ++ct) b4[mi][ct] = *(const f32x4*)(WR + (size_t)(16 * ct + fr) * D + 16 * (8 * wave + mi) + 4 * fq);
    int pe = 0, prow0 = -1; unsigned pp0 = 0u, pp1 = 0u; float pw0 = 0.f, pw1 = 0.f;
    auto flush = [&]() { if (prow0 >= 0 && lane < RB) { const int prow = prow0 + lane, pe0 = pe & 255, pe1 = pe >> 8; list[pe0 * 16384 + (int)pp0] = prow; list[pe1 * 16384 + (int)pp1] = prow;
            *(v4u*)(route + (size_t)prow * 8) = (v4u){(unsigned)pe0, pp0, (unsigned)pe1, pp1}; *(v2u*)(route + (size_t)prow * 8 + 4) = (v2u){f2u(pw0), f2u(pw1)}; } prow0 = -1; };
    auto route_rows = [&](int r0) {
        if (lane < RB) {
            const LAS float* lg = LG + (wave * RB + lane) * 40;
            const float l10 = lg[0], l11 = lg[1], l12 = lg[2], l13 = lg[3];
            int gi = 0; float mx = l10;
            if (l11 > mx) { mx = l11; gi = 1; }
            if (l12 > mx) { mx = l12; gi = 2; }
            if (l13 > mx) { mx = l13; gi = 3; }
            const float pg = 1.f / (expf(l10 - mx) + expf(l11 - mx) + expf(l12 - mx) + expf(l13 - mx));
            int j0 = 0; float v0 = lg[4 + gi * 8];
            for (int j = 1; j < 8; ++j) { const float t = lg[4 + gi * 8 + j]; if (t > v0) { v0 = t; j0 = j; } }
            int j1 = -1; float v1 = -3.0e38f;
            for (int j = 0; j < 8; ++j) { const float t = lg[4 + gi * 8 + j]; if (j != j0 && t > v1) { v1 = t; j1 = j; } }
            const float ee = expf(v1 - v0);
            pw0 = pg / (1.f + ee); pw1 = pg * ee / (1.f + ee); const int pe0 = gi * 8 + j0, pe1 = gi * 8 + j1; pe = pe0 | (pe1 << 8);
            pp0 = __hip_atomic_fetch_add(cnt + pe0 * 64, DRY ? 0u : 1u, RLX_AGENT); pp1 = __hip_atomic_fetch_add(cnt + pe1 * 64, DRY ? 0u : 1u, RLX_AGENT);
        }
        prow0 = r0; };
    int lrow0 = -1;
    v2u xv[RB][4], yv[RB][4];
    auto request = [&](int r0) {
#pragma unroll
        for (int r = 0; r < RB; ++r)
#pragma unroll
            for (int j = 0; j < 4; ++j) { xv[r][j] = *(const v2u*)(xres + (size_t)(r0 + r) * D + 256 * j + 4 * lane); yv[r][j] = *(const v2u*)(ymix + (size_t)(r0 + r) * D + 256 * j + 4 * lane); } };
    int rowb = blockIdx.x * BR;
    if (rowb < M) request(rowb + wave * RB);
    __syncthreads();
    for (; rowb < M; rowb += F.G * BR) {
        const int row0 = rowb + wave * RB; const int b = row0 >> 13;
        const LAS float* vl = VEC + 4 * lane; const LAS float* vg1 = vl + (2 + 3 * b) * 1024;
        f32x4 h[RB][4];
#pragma unroll
        for (int j = 0; j < 4; ++j) { const f32x4 g1 = *(const LAS f32x4*)(vg1 + 256 * j);
#pragma unroll
            for (int r = 0; r < RB; ++r) { const v2u a = yv[r][j], x = xv[r][j]; h[r][j] = (f32x4){bflo(x.x), bfhi(x.x), bflo(x.y), bfhi(x.y)} * ALPHA + (1.f + g1) * (f32x4){bflo(a.x), bfhi(a.x), bflo(a.y), bfhi(a.y)}; } }
        { const int nb = rowb + F.G * BR; if (nb < M) request(nb + wave * RB); }
#pragma unroll
        for (int r = 0; r < RB; ++r) { float s = 0.f;
#pragma unroll
            for (int j = 0; j < 4; ++j) s += (h[r][j].x + h[r][j].y) + (h[r][j].z + h[r][j].w);
            const float mean = wave_sum(s) * (1.f / D); float q = 0.f;
#pragma unroll
            for (int j = 0; j < 4; ++j) { h[r][j] = h[r][j] - mean; q += (h[r][j].x * h[r][j].x + h[r][j].y * h[r][j].y) + (h[r][j].z * h[r][j].z + h[r][j].w * h[r][j].w); }
            const float rstd = 1.f / sqrtf(wave_sum(q) * (1.f / D) + LN_EPS);
#pragma unroll
            for (int j = 0; j < 4; ++j) h[r][j] = h[r][j] * rstd * *(const LAS f32x4*)(vl + 256 * j) + *(const LAS f32x4*)(vl + 1024 + 256 * j); }
#pragma unroll
        for (int r = 0; r < RB; ++r) {
            store_row_bf16(xres + (size_t)(row0 + r) * D, h[r], lane);
#pragma unroll
            for (int j = 0; j < 4; ++j) h[r][j] = h[r][j] * (1.f + *(const LAS f32x4*)(vg1 + 1024 + 256 * j)) + *(const LAS f32x4*)(vg1 + 2048 + 256 * j);
            store_row_bf16(H + (size_t)(row0 + r) * D, h[r], lane); }
#pragma unroll
        for (int r = 0; r < RB; ++r)
#pragma unroll
            for (int j = 0; j < 4; ++j) *(LAS f32x4*)(HS + (wave * RB + r) * HSP + 256 * j + 4 * lane) = h[r][j];
        __syncthreads();
        flush();
        if (lrow0 >= 0) route_rows(lrow0);
        f32x4 lacc[3];
#pragma unroll
        for (int ct = 0; ct < 3; ++ct) lacc[ct] = (f32x4){0.f, 0.f, 0.f, 0.f};
#pragma unroll
        for (int mi = 0; mi < 8; ++mi) { const f32x4 a0 = *(const LAS f32x4*)(HS + fr * HSP + 16 * (8 * wave + mi) + 4 * fq);
#pragma unroll
            for (int i = 0; i < 4; ++i)
#pragma unroll
                for (int ct = 0; ct < 3; ++ct) lacc[ct] = __builtin_amdgcn_mfma_f32_16x16x4f32(a0[i], b4[mi][ct][i], lacc[ct], 0, 0, 0); }
#pragma unroll
        for (int ct = 0; ct < 3; ++ct) *(LAS f32x4*)(PS + ((wave * 3 + ct) * 64 + lane) * 4) = lacc[ct];
        __syncthreads();
#pragma unroll
        for (int i = 0; i < 2; ++i) { const int idx = tid + 512 * i;
            if (idx < 768) { const int j = idx & 3, ln = (idx >> 2) & 63, ct = idx >> 8; const int off = (ct * 64 + ln) * 4 + j; float v = 0.f;
#pragma unroll
                for (int ks = 0; ks < 8; ++ks) v += PS[off + ks * 768];
                const int rowl = 4 * (ln >> 4) + j, col = 16 * ct + (ln & 15);
                if (col < 36) LG[rowl * 40 + col] = v + VEC[8192 + col]; } }
        lrow0 = row0;
    }
    __syncthreads();
    flush();
    if (lrow0 >= 0) route_rows(lrow0);
    flush();
}
template <bool DRY> __device__ __forceinline__ void phase_r2(Frame& F, int l) {
    const int tid = opaque_tid(), lane = tid & 63, wave = __builtin_amdgcn_readfirstlane(tid >> 6), gw = blockIdx.x * NWAVES + wave, NGW = F.G * NWAVES;
    const float* mod = (const float*)(F.ws + WS_MOD); bf16* H = (bf16*)(F.ws + WS_H); const bf16* Y = (const bf16*)(F.ws + WS_Y);
    float* gates = (float*)(F.ws + WS_GATES); const float* WG = (const float*)(F.ws + WS_WG);
    const unsigned* route = (const unsigned*)(F.ws + WS_ROUTE);
    bf16* const xres = (bf16*)(F.ws + WS_X);
    constexpr int RB = 2;
    const bool has_next = l < DEPTH - 1, has_gates = l + 1 < NA;
    LAS float* VEC = (LAS float*)F.lds;
    LAS float* WGS = VEC + 8192;
    {
        const int ln = has_next ? l + 1 : l;
        const float* const m0 = mod + (size_t)(l * 2 + 0) * 6144; const float* const m1 = mod + (size_t)(l * 2 + 1) * 6144;
        const float* const n0 = mod + (size_t)(ln * 2 + 0) * 6144; const float* const n1 = mod + (size_t)(ln * 2 + 1) * 6144;
        const float* const p0 = F.ln_g + (size_t)(l * 2 + 1) * D; const float* const p1 = F.ln_b + (size_t)(l * 2 + 1) * D;
        const float* const p2 = m0 + 5120; const float* const p3 = m1 + 5120; const float* const p4 = n0 + 1024; const float* const p5 = n0; const float* const p6 = n1 + 1024; const float* const p7 = n1;
        const bool hi = tid >= 256; const int e = (tid & 255) * 4;
        const f32x4 a = *(const f32x4*)((hi ? p1 : p0) + e), b = *(const f32x4*)((hi ? p3 : p2) + e), c = *(const f32x4*)((hi ? p5 : p4) + e), d = *(const f32x4*)((hi ? p7 : p6) + e);
        LAS float* dst = VEC + (hi ? 1024 : 0) + e;
        *(LAS f32x4*)(dst) = a; *(LAS f32x4*)(dst + 2048) = b; *(LAS f32x4*)(dst + 4096) = c; *(LAS f32x4*)(dst + 6144) = d;
        if (has_gates) { const float* wn = WG + (size_t)(l + 1) * 8 * D + tid * 4;
#pragma unroll
            for (int k = 0; k < 4; ++k) *(LAS f32x4*)(WGS + tid * 4 + 2048 * k) = *(const f32x4*)(wn + 2048 * k); }
    }
    int excl;
    { const int cn = lane < 32 ? (int)__hip_atomic_load(F.ctl + CW_CNT + (l * 32 + lane) * 64, RLX_AGENT) : 0; const int nb = (cn + 255) >> 8; int inc = nb;
#pragma unroll
      for (int o = 1; o < 32; o <<= 1) { const int t = lane_up(inc, o, lane); if (lane >= o) inc += t; }
      excl = inc - nb; }
    __syncthreads();
    v4u q0 = (v4u){0u, 0u, 0u, 0u}; v2u q1 = (v2u){0u, 0u};
    auto load_route = [&](int rowa) { const size_t rr = (size_t)(rowa + (lane < RB ? lane : 0)) * 8; q0 = *(const v4u*)(route + rr); q1 = *(const v2u*)(route + rr + 4); };
    v2u xv[RB][4], ya[RB][4], yc[RB][4]; float w0[RB], w1[RB];
    auto request = [&](int rowa) {
        const unsigned q0x = q0.x, q0y = q0.y, q0z = q0.z, q0w = q0.w, q1x = q1.x, q1y = q1.y;
#pragma unroll
        for (int r = 0; r < RB; ++r) {
            const int e0 = __builtin_amdgcn_readlane((int)q0x, r), p0 = __builtin_amdgcn_readlane((int)q0y, r), e1 = __builtin_amdgcn_readlane((int)q0z, r), p1 = __builtin_amdgcn_readlane((int)q0w, r);
            w0[r] = u2f((unsigned)__builtin_amdgcn_readlane((int)q1x, r)); w1[r] = u2f((unsigned)__builtin_amdgcn_readlane((int)q1y, r));
            const int s0 = __builtin_amdgcn_readlane(excl, e0) * 256 + p0, s1 = __builtin_amdgcn_readlane(excl, e1) * 256 + p1;
#pragma unroll
            for (int j = 0; j < 4; ++j) { xv[r][j] = *(const v2u*)(xres + (size_t)(rowa + r) * D + 256 * j + 4 * lane);
                ya[r][j] = *(const v2u*)(Y + (size_t)s0 * D + 256 * j + 4 * lane); yc[r][j] = *(const v2u*)(Y + (size_t)s1 * D + 256 * j + 4 * lane); } } };
    const int step = NGW * RB;
    int row0 = gw * RB;
    if (row0 < M) { load_route(row0); request(row0); if (row0 + step < M) load_route(row0 + step); }
    const float* bg = F.a_b_gate + (has_gates ? (l + 1) * 8 : 0);
    for (; row0 < M; row0 += step) {
        const int b = row0 >> 13; const LAS float* vl = VEC + 4 * lane;
        f32x4 v[RB][4];
#pragma unroll
        for (int j = 0; j < 4; ++j) { const f32x4 g2 = *(const LAS f32x4*)(vl + (2 + b) * 1024 + 256 * j);
#pragma unroll
            for (int r = 0; r < RB; ++r) { const v2u a = ya[r][j], c = yc[r][j];
                const f32x4 y = (f32x4){bflo(a.x), bfhi(a.x), bflo(a.y), bfhi(a.y)} * w0[r] + (f32x4){bflo(c.x), bfhi(c.x), bflo(c.y), bfhi(c.y)} * w1[r];
                const v2u x = xv[r][j]; v[r][j] = (f32x4){bflo(x.x), bfhi(x.x), bflo(x.y), bfhi(x.y)} * ALPHA + (1.f + g2) * y; } }
        if (row0 + step < M) { request(row0 + step); if (row0 + 2 * step < M) load_route(row0 + 2 * step); }
#pragma unroll
        for (int r = 0; r < RB; ++r) { float s = 0.f;
#pragma unroll
            for (int j = 0; j < 4; ++j) s += (v[r][j].x + v[r][j].y) + (v[r][j].z + v[r][j].w);
            const float mean = wave_sum(s) * (1.f / D); float q = 0.f;
#pragma unroll
            for (int j = 0; j < 4; ++j) { v[r][j] = v[r][j] - mean; q += (v[r][j].x * v[r][j].x + v[r][j].y * v[r][j].y) + (v[r][j].z * v[r][j].z + v[r][j].w * v[r][j].w); }
            const float rstd = 1.f / sqrtf(wave_sum(q) * (1.f / D) + LN_EPS);
#pragma unroll
            for (int j = 0; j < 4; ++j) v[r][j] = v[r][j] * rstd * *(const LAS f32x4*)(vl + 256 * j) + *(const LAS f32x4*)(vl + 1024 + 256 * j); }
#pragma unroll
        for (int r = 0; r < RB; ++r) { const int row = row0 + r;
            if (l == DEPTH - 1) {
#pragma unroll
                for (int j = 0; j < 4; ++j) ST_NT((f32x4*)(F.out + (size_t)row * D + 256 * j + 4 * lane), v[r][j]); }
            else store_row_bf16(xres + (size_t)row * D, v[r], lane);
            if (has_next) {
#pragma unroll
                for (int j = 0; j < 4; ++j) v[r][j] = v[r][j] * (1.f + *(const LAS f32x4*)(vl + (4 + 2 * b) * 1024 + 256 * j)) + *(const LAS f32x4*)(vl + (5 + 2 * b) * 1024 + 256 * j);
                store_row_bf16(H + (size_t)row * D, v[r], lane);
            } }
        if (has_gates) gates_rows_lds<RB>(v, WGS, bg, gates + (size_t)row0 * 8, lane);
    }
}

typedef short bf16x8 __attribute__((ext_vector_type(8)));
#define MFMA16(a, b, c) __builtin_amdgcn_mfma_f32_16x16x32_bf16((a), (b), (c), 0, 0, 0)
constexpr int RS = 136;
template <bool MAXOP> __device__ __forceinline__ float block_scan256(float v, LAS float* scr, int lane, int wave) {
#pragma unroll
    for (int o = 1; o < 64; o <<= 1) { const float t = lane_up(v, o, lane); if (lane >= o) v = MAXOP ? fmaxf(v, t) : v + t; }
    if (lane == 63 && wave < 4) scr[wave] = v;
    __syncthreads();
    float add = MAXOP ? -3.0e38f : 0.f;
#pragma unroll
    for (int w = 0; w < 3; ++w) if (w < wave) add = MAXOP ? fmaxf(add, scr[w]) : add + scr[w];
    v = MAXOP ? fmaxf(v, add) : v + add;
    __syncthreads();
    return v;
}
__device__ __forceinline__ bf16x8 lds_frag16(const LAS bf16* p) { return __builtin_bit_cast(bf16x8, *(const LAS v4u*)p); }
template <int O0, int O1, int O2, int O3, int O4, int O5, int O6, int O7>
__device__ __forceinline__ void tr_read8(unsigned a, v2u& r0, v2u& r1, v2u& r2, v2u& r3, v2u& r4, v2u& r5, v2u& r6, v2u& r7) {
    asm volatile("ds_read_b64_tr_b16 %0, %8 offset:%9\n\tds_read_b64_tr_b16 %1, %8 offset:%10\n\tds_read_b64_tr_b16 %2, %8 offset:%11\n\tds_read_b64_tr_b16 %3, %8 offset:%12\n\t"
                 "ds_read_b64_tr_b16 %4, %8 offset:%13\n\tds_read_b64_tr_b16 %5, %8 offset:%14\n\tds_read_b64_tr_b16 %6, %8 offset:%15\n\tds_read_b64_tr_b16 %7, %8 offset:%16\n\t"
                 "s_waitcnt lgkmcnt(0)"
                 : "=&v"(r0), "=&v"(r1), "=&v"(r2), "=&v"(r3), "=&v"(r4), "=&v"(r5), "=&v"(r6), "=&v"(r7)
                 : "v"(a), "i"(O0), "i"(O1), "i"(O2), "i"(O3), "i"(O4), "i"(O5), "i"(O6), "i"(O7) : "memory");
}
__device__ __forceinline__ bf16x8 frag_lh(v2u lo, v2u hi) { return __builtin_bit_cast(bf16x8, (v4u){lo.x, lo.y, hi.x, hi.y}); }

__device__ __forceinline__ void ml_a(Frame& F) {
    const int tid = opaque_tid(), lane = tid & 63, wave = __builtin_amdgcn_readfirstlane(tid >> 6), fr = lane & 15, fq = lane >> 4;
    LAS unsigned char* KWb = F.lds;
    LAS unsigned char* VRb = F.lds + 18432;
    constexpr int KPB = 288, VPB = 544;
    const unsigned krd = (unsigned)(__UINTPTR_TYPE__)KWb + (4 * fq + (fr >> 2)) * KPB + (lane & 3) * 8;
    const unsigned vrd = (unsigned)(__UINTPTR_TYPE__)VRb + (4 * fq + (fr >> 2)) * VPB + (lane & 3) * 8 + wave * 64;
    const bf16x8 ones = __builtin_bit_cast(bf16x8, (v4u){0x3f803f80u, 0x3f803f80u, 0x3f803f80u, 0x3f803f80u});
    LAS float* wv = (LAS float*)(F.lds + 55296);
    LAS float* scr = (LAS float*)(F.lds + 56320);
    const bf16* proj = (const bf16*)(F.ws + WS_PROJ); const float* gates = (const float*)(F.ws + WS_GATES);
    float* Bv = (float*)(F.ws + WS_MLS); float* Mloc = Bv + 256; float* dn = (float*)(F.ws + WS_MLS + 65536); unsigned* dC = (unsigned*)(F.ws + WS_DC);
    for (int u = blockIdx.x; u < 256; u += F.G) {
        const int bh = u >> 5, c = u & 31, b = bh >> 2, h = bh & 3, t0 = b * SEQ + c * CH;
        v4u kreg[2], vreg[4];
        auto request = [&](int sb) { const bf16* rows = proj + (size_t)(t0 + sb * 64) * NPROJ;
#pragma unroll
            for (int i = 0; i < 2; ++i) { const int p = tid + 512 * i, s = p >> 4, part = p & 15; kreg[i] = *(const v4u*)(rows + (size_t)s * NPROJ + 512 + h * DQK + part * 8); }
#pragma unroll
            for (int i = 0; i < 4; ++i) { const int p = tid + 512 * i, s = p >> 5, part = p & 31; vreg[i] = *(const v4u*)(rows + (size_t)s * NPROJ + 1024 + h * DV + part * 8); } };
        request(0);
        float ip = 0.f, lf = 0.f;
        if (tid < 256) { ip = gates[(size_t)(t0 + tid) * 8 + h]; lf = logsigmoidf_(gates[(size_t)(t0 + tid) * 8 + 4 + h]); }
        const float bs = block_scan256<false>(lf, scr, lane, wave);
        const float as = tid < 256 ? ip - bs : -3.0e38f;
        const float wm = wave_max(as); if (lane == 0) scr[wave] = wm;
        __syncthreads();
        float mloc = scr[0];
#pragma unroll
        for (int w = 1; w < 8; ++w) mloc = fmaxf(mloc, scr[w]);
        if (tid < 256) wv[tid] = expf(as - mloc);
        if (tid == 255) { Bv[u] = bs; Mloc[u] = mloc; }
        f32x4 acc[2][8];
#pragma unroll
        for (int i = 0; i < 2; ++i)
#pragma unroll
            for (int j = 0; j < 8; ++j) acc[i][j] = (f32x4){0.f, 0.f, 0.f, 0.f};
        f32x4 dn4 = (f32x4){0.f, 0.f, 0.f, 0.f};
#pragma unroll 1
        for (int sb = 0; sb < 4; ++sb) {
            __syncthreads();
#pragma unroll
            for (int i = 0; i < 2; ++i) { const int p = tid + 512 * i, s = p >> 4, part = p & 15; v4u a = kreg[i]; const float w = wv[sb * 64 + s];
                a.x = pk2(bflo(a.x) * w, bfhi(a.x) * w); a.y = pk2(bflo(a.y) * w, bfhi(a.y) * w); a.z = pk2(bflo(a.z) * w, bfhi(a.z) * w); a.w = pk2(bflo(a.w) * w, bfhi(a.w) * w);
                *(LAS v4u*)(KWb + s * KPB + part * 16) = a; }
#pragma unroll
            for (int i = 0; i < 4; ++i) { const int p = tid + 512 * i, s = p >> 5, part = p & 31; *(LAS v4u*)(VRb + s * VPB + part * 16) = vreg[i]; }
            __syncthreads();
            if (sb < 3) request(sb + 1);
            v2u va[8];
            tr_read8<0, 16 * VPB, 32, 16 * VPB + 32, 32 * VPB, 48 * VPB, 32 * VPB + 32, 48 * VPB + 32>(vrd, va[0], va[1], va[2], va[3], va[4], va[5], va[6], va[7]);
#define ML_A_STEP(KS, HF) { v2u kb[8]; constexpr int KO = (KS) * 32 * KPB + (HF) * 128; \
                tr_read8<KO, KO + 16 * KPB, KO + 32, KO + 16 * KPB + 32, KO + 64, KO + 16 * KPB + 64, KO + 96, KO + 16 * KPB + 96>(krd, kb[0], kb[1], kb[2], kb[3], kb[4], kb[5], kb[6], kb[7]); \
                const bf16x8 a0 = frag_lh(va[4 * (KS)], va[4 * (KS) + 1]), a1 = frag_lh(va[4 * (KS) + 2], va[4 * (KS) + 3]); \
                _Pragma("unroll") for (int d4 = 0; d4 < 4; ++d4) { const int dt = 4 * (HF) + d4; const bf16x8 bb = frag_lh(kb[2 * d4], kb[2 * d4 + 1]); \
                    acc[0][dt] = MFMA16(a0, bb, acc[0][dt]); acc[1][dt] = MFMA16(a1, bb, acc[1][dt]); if (dt == wave) dn4 = MFMA16(ones, bb, dn4); } }
            ML_A_STEP(0, 0) ML_A_STEP(0, 1) ML_A_STEP(1, 0) ML_A_STEP(1, 1)
#undef ML_A_STEP
        }
        unsigned* dCu = dC + (size_t)u * 16384;
        const bool odd = (fr & 1) != 0;
#pragma unroll
        for (int i = 0; i < 2; ++i) { unsigned* const bp = dCu + (size_t)((32 * wave + 16 * i + 4 * fq + (odd ? 1 : 0)) * 64 + (fr >> 1));
#pragma unroll
            for (int dt = 0; dt < 8; ++dt) { const f32x4 a = acc[i][dt];
                const float n0 = dpp_mov<0xB1>(a[0]), n1 = dpp_mov<0xB1>(a[1]), n2 = dpp_mov<0xB1>(a[2]), n3 = dpp_mov<0xB1>(a[3]);
                bp[8 * dt] = odd ? pk2(n1, a[1]) : pk2(a[0], n0); bp[2 * 64 + 8 * dt] = odd ? pk2(n3, a[3]) : pk2(a[2], n2); } }
        if (fq == 0) dn[u * 128 + 16 * wave + fr] = dn4[0];
        __syncthreads();
    }
}
__device__ __forceinline__ void ml_scan(Frame& F) {
    const int tid = opaque_tid(), lane = tid & 63; (void)lane;
    const float* Bv = (const float*)(F.ws + WS_MLS); const float* Mloc = Bv + 256; float* Min = (float*)(F.ws + WS_MLS) + 512;
    const float* dn = (const float*)(F.ws + WS_MLS + 65536); float* nin = (float*)(F.ws + WS_MLS + 262144);
    const unsigned* dC = (const unsigned*)(F.ws + WS_DC); unsigned* CinT = (unsigned*)(F.ws + WS_CIN);
    LAS float* sB = (LAS float*)F.lds; LAS float* sM = sB + 32; LAS float* f1 = sB + 64; LAS float* f2 = sB + 96; LAS float* ms = sB + 128;
    for (int it0 = blockIdx.x * (NWAVES * 64); it0 < 8 * 16384; it0 += F.G * NWAVES * 64) {
        const int bh = it0 >> 14, e2 = (it0 & 16383) + tid;
        unsigned d[NCH];
#pragma unroll
        for (int c = 0; c < NCH; ++c) d[c] = dC[(size_t)(bh * NCH + c) * 16384 + e2];
        __syncthreads();
        if (tid < NCH) { sB[tid] = Bv[bh * NCH + tid]; sM[tid] = Mloc[bh * NCH + tid]; }
        __syncthreads();
        if (tid == 0) { float m = 0.f;
            for (int c = 0; c < NCH; ++c) { const float ml = sM[c], mm = fmaxf(m, ml); ms[c] = m; f1[c] = expf(m - mm); f2[c] = expf(ml - mm); m = sB[c] + mm; } }
        __syncthreads();
        f32x2 C = (f32x2){0.f, 0.f};
#pragma unroll
        for (int c = 0; c < NCH; ++c) { CinT[(size_t)(bh * NCH + c) * 16384 + e2] = pk2(C.x, C.y); C = C * f1[c] + (f32x2){bflo(d[c]), bfhi(d[c])} * f2[c]; }
        if ((it0 & 16383) == 0) {
            if (tid < 128) { float n = 0.f;
                for (int c = 0; c < NCH; ++c) { nin[(bh * NCH + c) * 128 + tid] = n; n = n * f1[c] + dn[(bh * NCH + c) * 128 + tid] * f2[c]; } }
            if (tid < NCH) Min[bh * NCH + tid] = ms[tid];
        }
    }
}
__device__ __forceinline__ void ml_c(Frame& F, int l) {
    const int tid = opaque_tid(), lane = tid & 63, wave = __builtin_amdgcn_readfirstlane(tid >> 6), fr = lane & 15, fq = lane >> 4;
    LAS bf16* CT = (LAS bf16*)(F.lds);
    LAS bf16* KB = (LAS bf16*)(F.lds + 69632);
    LAS unsigned char* VRb = F.lds + 87040;
    constexpr int VPB = 544;
    LAS float* eav = (LAS float*)(F.lds + 123904);
    LAS float* etv = eav + 256;
    LAS float* iwv = eav + 512;
    LAS float* thv = eav + 768;
    LAS bf16* NB = (LAS bf16*)(F.lds + 128000);
    LAS float* scr = (LAS float*)(F.lds + 128256);
    const bf16* proj = (const bf16*)(F.ws + WS_PROJ); const float* gates = (const float*)(F.ws + WS_GATES);
    const float* Min = (const float*)(F.ws + WS_MLS) + 512; const float* nin = (const float*)(F.ws + WS_MLS + 262144); const bf16* CinT = (const bf16*)(F.ws + WS_CIN);
    bf16* YA = (bf16*)(F.ws + WS_YA);
    const bf16x8 ones = __builtin_bit_cast(bf16x8, (v4u){0x3f803f80u, 0x3f803f80u, 0x3f803f80u, 0x3f803f80u});
    for (int u = blockIdx.x; u < 256; u += F.G) {
        const int bh = u >> 5, c = u & 31, b = bh >> 2, h = bh & 3, t0 = b * SEQ + c * CH;
        v4u cin[8];
        { const bf16* src = CinT + (size_t)u * 32768;
#pragma unroll
          for (int i = 0; i < 8; ++i) { const int p = tid + 512 * i, v = p >> 4, part = p & 15; cin[i] = *(const v4u*)(src + v * 128 + part * 8); } }
        float ip = 0.f, lf = 0.f;
        if (tid < 256) { ip = gates[(size_t)(t0 + tid) * 8 + h]; lf = logsigmoidf_(gates[(size_t)(t0 + tid) * 8 + 4 + h]); }
        const float bs = block_scan256<false>(lf, scr, lane, wave);
        const float as = tid < 256 ? ip - bs : -3.0e38f;
        const float pm = block_scan256<true>(as, scr, lane, wave);
        const float wm = wave_max(as); if (lane == 0) scr[wave] = wm;
        __syncthreads();
        float mloc = scr[0];
#pragma unroll
        for (int w = 1; w < 8; ++w) mloc = fmaxf(mloc, scr[w]);
        const float m_in = Min[u];
        if (tid < 256) { const float mt = bs + fmaxf(m_in, pm); eav[tid] = expf(as - mloc); etv[tid] = expf(bs + mloc - mt); iwv[tid] = expf(bs + m_in - mt); thv[tid] = expf(-mt); }
        if (tid < 64) { const f32x2 n2 = *(const f32x2*)(nin + u * 128 + 2 * tid); ((LAS unsigned*)NB)[tid] = pk2(n2.x, n2.y); }
#pragma unroll
        for (int i = 0; i < 8; ++i) { const int p = tid + 512 * i, v = p >> 4, part = p & 15; *(LAS v4u*)(CT + v * RS + part * 8) = cin[i]; }
        __syncthreads();
#pragma unroll 1
        for (int pass = 0; pass < 2; ++pass) {
            const int tt = pass == 0 ? 15 - wave : wave, nsb = pass == 0 ? 4 : 2;
            const int tmax = 16 * tt + 15, tq = 16 * tt + fr; const size_t row = (size_t)(t0 + tq);
            bf16x8 qf[4];
#pragma unroll
            for (int ks = 0; ks < 4; ++ks) qf[ks] = __builtin_bit_cast(bf16x8, *(const v4u*)(proj + row * NPROJ + h * DQK + 32 * ks + 8 * fq));
            f32x4 acc[17];
#pragma unroll
            for (int vt = 0; vt < 17; ++vt) acc[vt] = (f32x4){0.f, 0.f, 0.f, 0.f};
#pragma unroll
            for (int ks = 0; ks < 4; ++ks) {
#pragma unroll
                for (int vt = 0; vt < 16; ++vt) { acc[vt] = MFMA16(lds_frag16(CT + (16 * vt + fr) * RS + 32 * ks + 8 * fq), qf[ks], acc[vt]);
                    if ((vt & 3) == 3) __builtin_amdgcn_sched_barrier(0); }
                acc[16] = MFMA16(lds_frag16(NB + 32 * ks + 8 * fq), qf[ks], acc[16]);
            }
            { const float iw = iwv[tq];
#pragma unroll
              for (int vt = 0; vt < 17; ++vt) acc[vt] *= iw; }
            const float et = etv[tq];
            v4u kreg[2], vreg[4];
            auto request = [&](int sb) { const bf16* rows = proj + (size_t)(t0 + sb * 64) * NPROJ;
#pragma unroll
                for (int i = 0; i < 2; ++i) { const int p = tid + 512 * i, s = p >> 4, part = p & 15; kreg[i] = *(const v4u*)(rows + (size_t)s * NPROJ + 512 + h * DQK + part * 8); }
#pragma unroll
                for (int i = 0; i < 4; ++i) { const int p = tid + 512 * i, s = p >> 5, part = p & 31; vreg[i] = *(const v4u*)(rows + (size_t)s * NPROJ + 1024 + h * DV + part * 8); } };
            request(0);
#pragma unroll 1
            for (int sb = 0; sb < nsb; ++sb) {
                __syncthreads();
#pragma unroll
                for (int i = 0; i < 2; ++i) { const int p = tid + 512 * i, s = p >> 4, part = p & 15; *(LAS v4u*)(KB + s * RS + part * 8) = kreg[i]; }
#pragma unroll
                for (int i = 0; i < 4; ++i) { const int p = tid + 512 * i, s = p >> 5, part = p & 31; *(LAS v4u*)(VRb + s * VPB + part * 16) = vreg[i]; }
                __syncthreads();
                if (sb + 1 < nsb) request(sb + 1);
#pragma unroll
                for (int sp = 0; sp < 2; ++sp) {
                    const int s0 = sb * 64 + 32 * sp;
                    if (s0 <= tmax) {
                        f32x4 sa = (f32x4){0.f, 0.f, 0.f, 0.f}, sc = (f32x4){0.f, 0.f, 0.f, 0.f};
#pragma unroll
                        for (int ks = 0; ks < 4; ++ks) { sa = MFMA16(lds_frag16(KB + (32 * sp + fr) * RS + 32 * ks + 8 * fq), qf[ks], sa);
                                                         sc = MFMA16(lds_frag16(KB + (32 * sp + 16 + fr) * RS + 32 * ks + 8 * fq), qf[ks], sc); }
                        float p[8];
#pragma unroll
                        for (int j = 0; j < 4; ++j) { const int sA = s0 + 4 * fq + j, sB = sA + 16;
                            p[j] = sA <= tq ? sa[j] * eav[sA] * et : 0.f; p[4 + j] = sB <= tq ? sc[j] * eav[sB] * et : 0.f; }
                        const bf16x8 pf = __builtin_bit_cast(bf16x8, (v4u){pk2(p[0], p[1]), pk2(p[2], p[3]), pk2(p[4], p[5]), pk2(p[6], p[7])});
                        const unsigned va = (unsigned)(__UINTPTR_TYPE__)VRb + (32 * sp + 4 * fq + (fr >> 2)) * VPB + (lane & 3) * 8;
#define ML_C_PV4(G) { v2u l0, h0, l1, h1, l2, h2, l3, h3; constexpr int VO = 128 * (G); \
                        tr_read8<VO, VO + 16 * VPB, VO + 32, VO + 16 * VPB + 32, VO + 64, VO + 16 * VPB + 64, VO + 96, VO + 16 * VPB + 96>(va, l0, h0, l1, h1, l2, h2, l3, h3); \
                        acc[4 * (G)] = MFMA16(frag_lh(l0, h0), pf, acc[4 * (G)]); acc[4 * (G) + 1] = MFMA16(frag_lh(l1, h1), pf, acc[4 * (G) + 1]); \
                        acc[4 * (G) + 2] = MFMA16(frag_lh(l2, h2), pf, acc[4 * (G) + 2]); acc[4 * (G) + 3] = MFMA16(frag_lh(l3, h3), pf, acc[4 * (G) + 3]); __builtin_amdgcn_sched_barrier(0); }
                        ML_C_PV4(0) ML_C_PV4(1) ML_C_PV4(2) ML_C_PV4(3)
#undef ML_C_PV4
                        acc[16] = MFMA16(ones, pf, acc[16]);
                    }
                }
            }
            v2u ogr[16];
#pragma unroll
            for (int vt = 0; vt < 16; ++vt) ogr[vt] = *(const v2u*)(proj + row * NPROJ + 2048 + h * DV + 4 * fq + 16 * vt);
            const float dnm = 1.f / fmaxf(fabsf(acc[16][0]), thv[tq]);
            float s1 = 0.f;
#pragma unroll
            for (int vt = 0; vt < 16; ++vt) { acc[vt] *= dnm; s1 += (acc[vt][0] + acc[vt][1]) + (acc[vt][2] + acc[vt][3]); }
            s1 += lane_xor(s1, 16, lane); s1 += lane_xor(s1, 32, lane);
            const float mean = s1 * (1.f / DV); float s2 = 0.f;
#pragma unroll
            for (int vt = 0; vt < 16; ++vt) { acc[vt] -= mean; s2 += (acc[vt][0] * acc[vt][0] + acc[vt][1] * acc[vt][1]) + (acc[vt][2] * acc[vt][2] + acc[vt][3] * acc[vt][3]); }
            s2 += lane_xor(s2, 16, lane); s2 += lane_xor(s2, 32, lane);
            const float rstd = 1.f / sqrtf(s2 * (1.f / DV) + A_NORM_EPS);
            const float* ng = F.a_norm_g + l * 1024 + h * DV + 4 * fq; bf16* yp = YA + row * D + h * DV + 4 * fq;
#pragma unroll
            for (int vt = 0; vt < 16; ++vt) { const v2u og = ogr[vt]; const f32x4 g = *(const f32x4*)(ng + 16 * vt);
                const float y0 = acc[vt][0] * rstd * g.x * sigmoidf_(bflo(og.x)), y1 = acc[vt][1] * rstd * g.y * sigmoidf_(bfhi(og.x)),
                            y2 = acc[vt][2] * rstd * g.z * sigmoidf_(bflo(og.y)), y3 = acc[vt][3] * rstd * g.w * sigmoidf_(bfhi(og.y));
                *(v2u*)(yp + 16 * vt) = (v2u){pk2(y0, y1), pk2(y2, y3)}; }
        }
        __syncthreads();
    }
}

__device__ __forceinline__ void att_mfma(Frame& F) {
    const int tid = opaque_tid(), lane = tid & 63, wave = __builtin_amdgcn_readfirstlane(tid >> 6), fr = lane & 15, fq = lane >> 4;
    constexpr int NK = 384, KP = 72, VPB = 160;
    LAS bf16* Ks = (LAS bf16*)(F.lds); LAS unsigned char* Vs = F.lds + NK * KP * 2;
    const bf16* Q = (const bf16*)(F.ws + WS_Q); const bf16* KV = (const bf16*)(F.ws + WS_KV);
    bf16* OG = (bf16*)(F.ws + WS_OG); float* LSE = (float*)(F.ws + WS_LSE);
    const bf16x8 ones = __builtin_bit_cast(bf16x8, (v4u){0x3f803f80u, 0x3f803f80u, 0x3f803f80u, 0x3f803f80u});
    constexpr int NU = 1536;
    const unsigned vrd = (unsigned)(__UINTPTR_TYPE__)Vs + (4 * fq + (fr >> 2)) * VPB + (lane & 3) * 8;
    auto decode = [&](int u, int& g, int& b, int& h, int& r, int& rho, int& n2) { g = u >> 9; const int rem = u & 511; b = rem >> 8; h = (rem >> 5) & 7; const int rn = rem & 31;
        r = g == 0 ? 1 : (g == 1 ? 4 : 16); const int nb2 = 32 / r; rho = rn / nb2; n2 = rn % nb2; };
    v4u kreg[6], vreg[6]; bf16x8 qf[2][2];
    auto request = [&](int u) { int g, b, h, r, rho, n2; decode(u, g, b, h, r, rho, n2);
        const bf16* kvb = KV + (size_t)b * SEQ * NKV + g * 512 + h * 64;
#pragma unroll
        for (int i = 0; i < 6; ++i) { const int p = tid + 512 * i, kj = p >> 3, part = p & 7; const int isub = (2 * n2 - 1) * 128 + kj;
            kreg[i] = (v4u){0u, 0u, 0u, 0u}; vreg[i] = (v4u){0u, 0u, 0u, 0u};
            if (isub >= 0) { const bf16* kr = kvb + ((size_t)isub * r + rho) * NKV + part * 8; kreg[i] = *(const v4u*)kr; vreg[i] = *(const v4u*)(kr + 1536); } }
#pragma unroll
        for (int i = 0; i < 2; ++i) { const size_t tq = (size_t)b * SEQ + (size_t)(n2 * 256 + 16 * (wave + 8 * i) + fr) * r + rho;
#pragma unroll
            for (int ks = 0; ks < 2; ++ks) qf[i][ks] = __builtin_bit_cast(bf16x8, *(const v4u*)(Q + tq * NQ + g * 512 + h * 64 + 32 * ks + 8 * fq)); } };
    const int ustep = (F.G % 8 == 0) ? F.G / 8 : F.G; const int ubase = (F.G % 8 == 0) ? (int)(blockIdx.x % 8) * (NU / 8) : 0, uend = (F.G % 8 == 0) ? ubase + NU / 8 : NU;
    int u = ubase + ((F.G % 8 == 0) ? (int)(blockIdx.x / 8) : (int)blockIdx.x);
    if (u < uend) request(u);
    for (; u < uend; u += ustep) {
        int g, b, h, r, rho, n2; decode(u, g, b, h, r, rho, n2);
        __syncthreads();
#pragma unroll
        for (int i = 0; i < 6; ++i) { const int p = tid + 512 * i, kj = p >> 3, part = p & 7; *(LAS v4u*)(Ks + kj * KP + part * 8) = kreg[i]; *(LAS v4u*)(Vs + kj * VPB + part * 16) = vreg[i]; }
        bf16x8 q[2][2];
#pragma unroll
        for (int i = 0; i < 2; ++i) { q[i][0] = qf[i][0]; q[i][1] = qf[i][1]; }
        __syncthreads();
        if (u + ustep < uend) request(u + ustep);
#pragma unroll
        for (int i = 0; i < 2; ++i) {
            const int tt = wave + 8 * i, qi = 16 * tt + fr;
            const size_t tokq = (size_t)b * SEQ + (size_t)(n2 * 256 + qi) * r + rho;
            const int pi0 = tt >> 1;
            f32x4 sc[5][2];
#pragma unroll
            for (int pi = 0; pi < 5; ++pi)
#pragma unroll
                for (int st = 0; st < 2; ++st) { const int tile = 2 * (pi0 + pi) + st; f32x4 a = (f32x4){0.f, 0.f, 0.f, 0.f};
                    a = MFMA16(lds_frag16(Ks + (16 * tile + fr) * KP + 8 * fq), q[i][0], a); a = MFMA16(lds_frag16(Ks + (16 * tile + fr) * KP + 32 + 8 * fq), q[i][1], a);
                    sc[pi][st] = a; }
            const float NEG = -__builtin_inff();
#pragma unroll
            for (int st = 0; st < 2; ++st)
#pragma unroll
                for (int j = 0; j < 4; ++j) { const int k0 = 32 * pi0 + 16 * st + 4 * fq + j; sc[0][st][j] = k0 >= qi ? sc[0][st][j] : NEG; sc[4][st][j] = k0 + 128 <= qi + 128 ? sc[4][st][j] : NEG; }
            if (n2 == 0) {
#pragma unroll
                for (int pi = 0; pi < 5; ++pi)
#pragma unroll
                    for (int st = 0; st < 2; ++st)
#pragma unroll
                        for (int j = 0; j < 4; ++j) { const int kj = 32 * (pi0 + pi) + 16 * st + 4 * fq + j; sc[pi][st][j] = kj >= 128 ? sc[pi][st][j] : NEG; }
            }
            float mx = NEG;
#pragma unroll
            for (int pi = 0; pi < 5; ++pi)
#pragma unroll
                for (int st = 0; st < 2; ++st)
#pragma unroll
                    for (int j = 0; j < 4; ++j) mx = fmaxf(mx, sc[pi][st][j]);
            mx = fmaxf(mx, lane_xor(mx, 16, lane)); mx = fmaxf(mx, lane_xor(mx, 32, lane));
            f32x4 acc[4], den = (f32x4){0.f, 0.f, 0.f, 0.f};
#pragma unroll
            for (int vt = 0; vt < 4; ++vt) acc[vt] = (f32x4){0.f, 0.f, 0.f, 0.f};
#pragma unroll
            for (int pi = 0; pi < 5; ++pi) { float p[8];
#pragma unroll
                for (int j = 0; j < 4; ++j) { p[j] = __builtin_amdgcn_exp2f(sc[pi][0][j] - mx); p[4 + j] = __builtin_amdgcn_exp2f(sc[pi][1][j] - mx); }
                const bf16x8 pf = __builtin_bit_cast(bf16x8, (v4u){pk2(p[0], p[1]), pk2(p[2], p[3]), pk2(p[4], p[5]), pk2(p[6], p[7])});
                { v2u l0, h0, l1, h1, l2, h2, l3, h3;
                  tr_read8<0, 16 * VPB, 32, 16 * VPB + 32, 64, 16 * VPB + 64, 96, 16 * VPB + 96>(vrd + 32 * (pi0 + pi) * VPB, l0, h0, l1, h1, l2, h2, l3, h3);
                  acc[0] = MFMA16(frag_lh(l0, h0), pf, acc[0]); acc[1] = MFMA16(frag_lh(l1, h1), pf, acc[1]); acc[2] = MFMA16(frag_lh(l2, h2), pf, acc[2]); acc[3] = MFMA16(frag_lh(l3, h3), pf, acc[3]); }
                den = MFMA16(ones, pf, den); }
            const float lsum = den[0], inv = 1.f / lsum;
            bf16* op = OG + ((size_t)g * M + tokq) * BW + h * 64 + 4 * fq;
#pragma unroll
            for (int vt = 0; vt < 4; ++vt) *(v2u*)(op + 16 * vt) = (v2u){pk2(acc[vt][0] * inv, acc[vt][1] * inv), pk2(acc[vt][2] * inv, acc[vt][3] * inv)};
            if (fq == 0) LSE[((size_t)g * M + tokq) * 8 + h] = (mx + __builtin_amdgcn_logf(lsum)) * 0.6931471805599453f;
        }
    }
}
__device__ __forceinline__ void att_combine(Frame& F) {
    const int gt = blockIdx.x * (NWAVES * 64) + opaque_tid(), NGT = F.G * NWAVES * 64;
    const bf16* OG = (const bf16*)(F.ws + WS_OG); const float* LSE = (const float*)(F.ws + WS_LSE); bf16* YA = (bf16*)(F.ws + WS_YA);
    for (int it = gt; it < M * 64; it += NGT) {
        const int tok = it >> 6, h = (it >> 3) & 7, pc = it & 7;
        const float l0 = LSE[(size_t)tok * 8 + h], l1 = LSE[((size_t)M + tok) * 8 + h], l2 = LSE[((size_t)2 * M + tok) * 8 + h];
        const float mx = fmaxf(l0, fmaxf(l1, l2)); float w0 = expf(l0 - mx), w1 = expf(l1 - mx), w2 = expf(l2 - mx); const float inv = 1.f / (w0 + w1 + w2); w0 *= inv; w1 *= inv; w2 *= inv;
        const size_t off = (size_t)tok * BW + h * 64 + pc * 8;
        const v4u a = *(const v4u*)(OG + off), c = *(const v4u*)(OG + (size_t)M * BW + off), d = *(const v4u*)(OG + (size_t)2 * M * BW + off);
        v4u o;
        o.x = pk2(w0 * bflo(a.x) + w1 * bflo(c.x) + w2 * bflo(d.x), w0 * bfhi(a.x) + w1 * bfhi(c.x) + w2 * bfhi(d.x));
        o.y = pk2(w0 * bflo(a.y) + w1 * bflo(c.y) + w2 * bflo(d.y), w0 * bfhi(a.y) + w1 * bfhi(c.y) + w2 * bfhi(d.y));
        o.z = pk2(w0 * bflo(a.z) + w1 * bflo(c.z) + w2 * bflo(d.z), w0 * bfhi(a.z) + w1 * bfhi(c.z) + w2 * bfhi(d.z));
        o.w = pk2(w0 * bflo(a.w) + w1 * bflo(c.w) + w2 * bflo(d.w), w0 * bfhi(a.w) + w1 * bfhi(c.w) + w2 * bfhi(d.w));
        __builtin_nontemporal_store(o, (v4u*)(YA + off));
    }
}

constexpr int NPHASE = 2 + 9 * DEPTH;
struct Args { const void* in[21]; float* out; unsigned char* ws; int ph_lo, ph_hi; };
__device__ __forceinline__ void moe_table(Frame& F, int l) {
    LAS int* tab = (LAS int*)(F.lds + LDSCTL_OFF + 64);
    const int tid = opaque_tid();
    if (tid < 64) { const int lane = tid & 63; const int cn = lane < 32 ? (int)__hip_atomic_load(F.ctl + CW_CNT + (l * 32 + lane) * 64, RLX_AGENT) : 0; const int nb = (cn + 255) >> 8; int inc = nb;
#pragma unroll
        for (int o = 1; o < 32; o <<= 1) { const int t = lane_up(inc, o, lane); if (lane >= o) inc += t; }
        if (lane < 32) { tab[lane] = inc - nb; tab[33 + lane] = cn; } if (lane == 31) tab[32] = inc; }
    __syncthreads();
}
__global__ void __launch_bounds__(NWAVES * 64, 2) fwd(Args args) {
    extern __shared__ __attribute__((aligned(16))) unsigned char lds[];
    Frame F;
    F.lds = (LAS unsigned char*)lds; F.ws = args.ws; F.ctl = (unsigned*)(args.ws + WS_CTL);
    F.wave = __builtin_amdgcn_readfirstlane((int)threadIdx.x >> 6); asm volatile("" : "+s"(F.wave)); F.tid = hw_tid(F.wave); F.lane = F.tid & 63; F.G = gridDim.x;
    F.x = (const float*)args.in[0]; F.c = (const float*)args.in[1]; F.pos = (const int*)args.in[2]; F.ada_w = (const float*)args.in[3]; F.ada_b = (const float*)args.in[4];
    F.ln_g = (const float*)args.in[5]; F.ln_b = (const float*)args.in[6]; F.a_w_in = (const float*)args.in[7]; F.a_b_gate = (const float*)args.in[8]; F.a_norm_g = (const float*)args.in[9];
    F.a_w_out = (const float*)args.in[10]; F.b_w_kv = (const float*)args.in[11]; F.b_w_q = (const float*)args.in[12]; F.b_w_o = (const float*)args.in[13];
    F.w_r1 = (const float*)args.in[14]; F.b_r1 = (const float*)args.in[15]; F.w_r2 = (const float*)args.in[16]; F.b_r2 = (const float*)args.in[17];
    F.w_gate = (const float*)args.in[18]; F.w_up = (const float*)args.in[19]; F.w_down = (const float*)args.in[20]; F.out = args.out;
    for (int u = F.tid; u < (LDS_BYTES - LDSCTL_OFF) / 4; u += NWAVES * 64) ((LAS unsigned*)(F.lds + LDSCTL_OFF))[u] = 0u;
    __syncthreads();
    const int lo = args.ph_lo, hi = args.ph_hi;
    XcdBarrier bar; bar.bar = F.ctl + CW_BAR; bar.x = 0; bar.st = nullptr; bar.w = F.wave;
    if (hi - lo > 1) bar = xcd_barrier_post(F.ctl + CW_BAR, (volatile LAS unsigned*)(F.lds + LDSCTL_OFF), F.wave);
#define IN(k) (lo <= (k) && (k) < hi)
#define SEAM(k) do { if ((k) + 1 < hi) xcd_barrier(bar); } while (0)
    const int c0 = (int)blockIdx.x;
    const int vcu = (F.G % 8 == 0) ? (int)(blockIdx.x % 8) * (F.G / 8) + (int)(blockIdx.x / 8) : (int)blockIdx.x;

    if (IN(0)) { pro_a(F); SEAM(0); }
    if (IN(1)) { pro_b(F); SEAM(1); }
    for (int l = 0; l < DEPTH; ++l) {
        const int pb = 2 + 9 * l;
        if (l < NA) {
            if (IN(pb + 0)) {
                pg8::Gemm g{(const bf16*)(F.ws + WS_H), (const bf16*)(F.ws + WS_WIN) + (size_t)l * NPROJ * D, M, NPROJ, D}; pg8::StaticOrder S; S.init(M, NPROJ, F.G, c0);
                pg8::EpiBf16S E{(bf16*)(F.ws + WS_PROJ), NPROJ, 2, 4, 0.08838834764831845f};
                pg8::gemm_phase<pg8::EpiBf16S, pg8::StaticOrder, true>(F.lds, g, S, E, F.wave);
                SEAM(pb + 0);
            }
            if (IN(pb + 1)) { ml_a(F); SEAM(pb + 1); }
            if (IN(pb + 2)) { ml_scan(F); SEAM(pb + 2); }
            if (IN(pb + 3)) { ml_c(F, l); SEAM(pb + 3); }
            if (IN(pb + 4)) {
                pg8::Gemm g{(const bf16*)(F.ws + WS_YA), (const bf16*)(F.ws + WS_WOUT) + (size_t)l * D * D, M, D, D}; pg8::StaticOrder S; S.init(M, D, F.G, c0);
                pg8::EpiBf16S E{(bf16*)(F.ws + WS_YMIX), D, 0, 0, 1.f};
                pg8::gemm_phase<pg8::EpiBf16S, pg8::StaticOrder, false>(F.lds, g, S, E, F.wave);
                SEAM(pb + 4);
            }
        } else {
            if (IN(pb + 0)) {
                if (l == NA) {
                    pg8::Gemm g{(const bf16*)(F.ws + WS_X), (const bf16*)(F.ws + WS_WKV), M, NKV, D}; pg8::StaticOrder S; S.init(M, NKV, F.G, c0);
                    pg8::EpiRope E{(bf16*)(F.ws + WS_KV), NKV, 6, (const float*)(F.ws + WS_ROPE), 1.0f};
                    pg8::gemm_phase<pg8::EpiRope, pg8::StaticOrder, true>(F.lds, g, S, E, F.wave);
                }
                {
                    pg8::Gemm g{(const bf16*)(F.ws + WS_H), (const bf16*)(F.ws + WS_WQ) + (size_t)(l - NA) * NQ * D, M, NQ, D}; pg8::StaticOrder S; S.init(M, NQ, F.G, c0);
                    pg8::EpiRope E{(bf16*)(F.ws + WS_Q), NQ, 6, (const float*)(F.ws + WS_ROPE), 0.125f * 1.4426950408889634f};
                    pg8::gemm_phase<pg8::EpiRope, pg8::StaticOrder, true>(F.lds, g, S, E, F.wave);
                    { const int nq = (M / 256) * (NQ / 256), full = nq / F.G, cutq = nq - full * F.G;
                      if (cutq > 0 && F.G - cutq >= F.G / 4) { __syncthreads(); if (c0 >= cutq) { const int tid = opaque_tid(), lane = tid & 63, wave = __builtin_amdgcn_readfirstlane(tid >> 6);
                              conv_run<5>(F, l, (c0 - cutq) * NWAVES + wave, (F.G - cutq) * NWAVES, lane, wave); } }
                      else { __syncthreads(); const int tid = opaque_tid(), lane = tid & 63, wave = __builtin_amdgcn_readfirstlane(tid >> 6); conv_run<5>(F, l, c0 * NWAVES + wave, F.G * NWAVES, lane, wave); } }
                }
                SEAM(pb + 0);
            }
            if (IN(pb + 1)) { att_mfma(F); SEAM(pb + 1); }
            if (IN(pb + 2)) { att_combine(F); SEAM(pb + 2); }
            if (IN(pb + 4)) {
                pg8::Gemm g{(const bf16*)(F.ws + WS_YA), (const bf16*)(F.ws + WS_WO) + (size_t)(l - NA) * D * BW, M, D, BW}; pg8::StaticOrder S; S.init(M, D, F.G, c0);
                pg8::EpiBf16S E{(bf16*)(F.ws + WS_YMIX), D, 0, 0, 1.f};
                pg8::gemm_phase<pg8::EpiBf16S, pg8::StaticOrder, false>(F.lds, g, S, E, F.wave);
                SEAM(pb + 4);
            }
        }
        if (IN(pb + 5)) { phase_r1<false>(F, l); SEAM(pb + 5); }
        if (IN(pb + 6)) {
            moe_table(F, l);
            pg8::Gemm g{(const bf16*)(F.ws + WS_H), nullptr, 0, 512, D};
            pg8::MoeOrder S{(const LAS int*)(F.lds + LDSCTL_OFF + 64), (const int*)(F.ws + WS_LIST), (const bf16*)(F.ws + WS_WGU) + (size_t)l * NE * 512 * D, (size_t)512 * D, 2, F.G, vcu, 1};
            pg8::EpiGU E{(bf16*)(F.ws + WS_ACT)};
            pg8::gemm_phase<pg8::EpiGU, pg8::MoeOrder, true>(F.lds, g, S, E, F.wave);
            if (l + 1 < DEPTH) { __syncthreads(); tail_fill<4>(F, l + 1, ((const LAS int*)(F.lds + LDSCTL_OFF + 64))[32] * 2, vcu); }
            SEAM(pb + 6);
        }
        if (IN(pb + 7)) {
            if (!IN(pb + 6)) moe_table(F, l);
            pg8::Gemm g{(const bf16*)(F.ws + WS_ACT), nullptr, 0, D, MH};
            pg8::MoeOrder S{(const LAS int*)(F.lds + LDSCTL_OFF + 64), (const int*)(F.ws + WS_LIST), (const bf16*)(F.ws + WS_WD) + (size_t)l * NE * D * MH, (size_t)D * MH, 4, F.G, vcu, 0};
            pg8::EpiBf16S E{(bf16*)(F.ws + WS_Y), D, 0, 0, 1.f};
            pg8::gemm_phase<pg8::EpiBf16S, pg8::MoeOrder, true>(F.lds, g, S, E, F.wave);
            if (l + 1 < DEPTH) { __syncthreads(); const int tu = ((const LAS int*)(F.lds + LDSCTL_OFF + 64))[32] * 4;
                if (l == 0) tail_fill<1>(F, 0, tu, vcu); else if (l == 1) tail_fill<2>(F, 0, tu, vcu); else tail_fill<3>(F, 0, tu, vcu); }
            SEAM(pb + 7);
        }
        if (IN(pb + 8)) { phase_r2<false>(F, l); SEAM(pb + 8); }
    }
#undef IN
#undef SEAM
}

extern "C" void kernel_launch(void* const* d_in, const int* in_sizes, int n_in, void* d_out, int out_size, void* d_ws, size_t ws_size, hipStream_t stream) {
    static int grid = 0;
    if (grid == 0) {
        if (n_in != 21 || in_sizes[0] != M * D || out_size != M * D || ws_size < WS_END) { fprintf(stderr, "kernel_launch: unexpected shapes (n_in %d, in0 %d, out %d, ws %zu < %zu); nothing launched\n", n_in, n_in > 0 ? in_sizes[0] : -1, out_size, ws_size, (size_t)WS_END); grid = -1; return; }
        int dev = 0, cus = 0, per_cu = 0;
        if (hipGetDevice(&dev) != hipSuccess || hipDeviceGetAttribute(&cus, hipDeviceAttributeMultiprocessorCount, dev) != hipSuccess) { grid = -1; return; }
        if (hipFuncSetAttribute((const void*)fwd, hipFuncAttributeMaxDynamicSharedMemorySize, LDS_BYTES) != hipSuccess) { fprintf(stderr, "kernel_launch: hipFuncSetAttribute failed\n"); grid = -1; return; }
        if (hipOccupancyMaxActiveBlocksPerMultiprocessor(&per_cu, (const void*)fwd, NWAVES * 64, LDS_BYTES) != hipSuccess || per_cu < 1) fprintf(stderr, "kernel_launch: occupancy query reports %d workgroups per CU\n", per_cu);
        (void)hipGetLastError();
        grid = cus;
    }
    if (grid < 0) return;
    if (hipMemsetAsync((char*)d_ws + WS_CTL, 0, CTL_ZERO_BYTES, stream) != hipSuccess) return;
    Args a{};
    for (int i = 0; i < 21; ++i) a.in[i] = d_in[i];
    a.out = (float*)d_out; a.ws = (unsigned char*)d_ws;
#if MK_N_LAUNCHES == 1
    a.ph_lo = 0; a.ph_hi = NPHASE;
    hipLaunchKernelGGL(fwd, dim3(grid), dim3(NWAVES * 64), LDS_BYTES, stream, a);
#else
    for (int p = 0; p < NPHASE; ++p) { a.ph_lo = p; a.ph_hi = p + 1; hipLaunchKernelGGL(fwd, dim3(grid), dim3(NWAVES * 64), LDS_BYTES, stream, a); }
#endif
}
```

```cpp
#include <hip/hip_runtime.h>
#include <cstdio>
#include <cstdint>

#ifndef MK_N_LAUNCHES
#define MK_N_LAUNCHES 1
#endif

__device__ __forceinline__ int hw_tid(int wave_s) {
    unsigned z = 0u; asm volatile("" : "+s"(z));
    const unsigned lane = __builtin_amdgcn_mbcnt_hi(~0u, __builtin_amdgcn_mbcnt_lo(~0u, z));
    int t = (int)(((unsigned)wave_s << 6) | lane); asm volatile("" : "+v"(t)); return t;
}
namespace pg8 {
#define PG8_LAS __attribute__((address_space(3)))
typedef unsigned short bf16_t;
typedef short bf16x8 __attribute__((ext_vector_type(8)));
typedef float f32x4 __attribute__((ext_vector_type(4)));
typedef float f32x2 __attribute__((ext_vector_type(2)));
typedef unsigned u32x4 __attribute__((ext_vector_type(4)));
typedef unsigned u32x2 __attribute__((ext_vector_type(2)));
constexpr int BM = 256, BK = 64, HALF = 128, HTB = HALF * BK * 2  , STAGE_BYTES = 8 * HTB, NXCD = 8, WGM = 8;

__host__ __device__ __forceinline__ int lds_byte(int r, int c) { const int st = (r >> 4) * 2 + (c >> 5), rr = r & 15, cc = c & 31, ob = rr * 64 + cc * 2; return st * 1024 + (ob ^ (((ob >> 9) & 1) << 5)); }
__host__ __device__ __forceinline__ void stage_rc(int b, int& R, int& C) { const int st = b / 1024, sb = b % 1024, swz = sb ^ (((sb >> 9) & 1) << 5); R = (st >> 1) * 16 + swz / 64; C = (st & 1) * 32 + (swz % 64) / 2; }
__host__ __device__ __forceinline__ int perm32(int rho) { const int n = rho >> 4, i = rho & 15; return 8 * (i >> 2) + 4 * n + (i & 3); }

struct Unit { int pm, pn, ex, jb; };
struct Gemm { const bf16_t* A; const bf16_t* Bt; int M, N, K; };

struct StaticOrder {
    int nM, nN, nwg, G, c;
    __device__ void init(int M, int N, int G_, int c_) { nM = M / BM; nN = N / BM; nwg = nM * nN; G = G_; c = c_; }
    __device__ bool next(int i, Unit& u) const {
        const long L = (long)i * G + c; if (L >= nwg) return false;
        int wgid = (int)L; { const int q = nwg / NXCD, r = nwg % NXCD, xcd = wgid % NXCD, off = wgid / NXCD; wgid = (xcd < r ? xcd * (q + 1) : r * (q + 1) + (xcd - r) * q) + off; }
        const int nig = WGM * nN, gid = wgid / nig, fm = gid * WGM, gsz = (nM - fm) < WGM ? (nM - fm) : WGM;
        u.pm = fm + ((wgid % nig) % gsz); u.pn = (wgid % nig) / gsz; u.ex = 0; u.jb = 0; return true;
    }
    __device__ __forceinline__ const char* b_ptr(const Gemm& g, const Unit& u) const { return (const char*)g.Bt + (size_t)u.pn * BM * g.K * 2; }
    __device__ __forceinline__ unsigned a_off(const Gemm& g, const Unit& u, int h, int R, int C) const { return (unsigned)((u.pm * BM + h * HALF + R) * g.K + C) * 2u; }
};

struct MoeOrder {
    const PG8_LAS int* tab; const int* list; const bf16_t* W; size_t wstride; int ntn, G, c, gather;
    __device__ bool next(int i, Unit& u) const {
        const int L = i * G + c; const int total = tab[32] * ntn; if (L >= total) return false;
        const int rb = L / ntn; u.pn = L - rb * ntn;
        unsigned z = 0u; asm volatile("" : "+s"(z));
        const unsigned ln = __builtin_amdgcn_mbcnt_hi(~0u, __builtin_amdgcn_mbcnt_lo(~0u, z));
        const unsigned long long m = __ballot(rb >= tab[ln & 31u]);
        const int e = __builtin_popcount((unsigned)m) - 1;
        u.pm = rb; u.ex = e; u.jb = rb - tab[e]; return true;
    }
    __device__ __forceinline__ const char* b_ptr(const Gemm& g, const Unit& u) const { return (const char*)(W + (size_t)u.ex * wstride) + (size_t)u.pn * BM * g.K * 2; }
    __device__ __forceinline__ unsigned a_off(const Gemm& g, const Unit& u, int h, int R, int C) const {
        if (gather) { const int p = u.jb * BM + h * HALF + R; const int cnt = tab[33 + u.ex]; const int tok = list[u.ex * 16384 + (p < cnt ? p : 0)]; return (unsigned)(tok * g.K + C) * 2u; }
        return (unsigned)((u.pm * BM + h * HALF + R) * g.K + C) * 2u;
    }
};

__device__ __forceinline__ unsigned cvt_pk_bf16(float lo, float hi) { unsigned r; asm volatile("v_cvt_pk_bf16_f32 %0, %1, %2" : "=v"(r) : "v"(lo), "v"(hi)); return r; }

struct EpiF32 {
    static constexpr bool PERM = false;
    float* C; int ldc;
    __device__ __forceinline__ void operator()(const f32x4 (&acc)[2][2][4][2], const Unit& u, int wr, int wc, int fr, int fq) const {
        const int row0 = u.pm * BM + wr * 64 + fr, col0 = u.pn * BM + wc * 32 + 4 * fq;
#pragma unroll
        for (int ai = 0; ai < 2; ++ai)
#pragma unroll
            for (int m = 0; m < 4; ++m) { float* rowp = C + (size_t)(row0 + ai * HALF + m * 16) * ldc + col0;
#pragma unroll
                for (int bj = 0; bj < 2; ++bj)
#pragma unroll
                    for (int n = 0; n < 2; ++n) *(f32x4*)(rowp + bj * HALF + n * 16) = acc[ai][bj][m][n]; }
    }
};
struct EpiBf16S {
    static constexpr bool PERM = true;
    bf16_t* O; int ldc; int pn_lo, pn_hi; float scale;
    __device__ __forceinline__ void operator()(const f32x4 (&acc)[2][2][4][2], const Unit& u, int wr, int wc, int fr, int fq) const {
        const int row0 = u.pm * BM + wr * 64 + fr, col0 = u.pn * BM + wc * 32 + 8 * fq;
        const float sc = (u.pn >= pn_lo && u.pn < pn_hi) ? scale : 1.f;
#pragma unroll
        for (int ai = 0; ai < 2; ++ai)
#pragma unroll
            for (int m = 0; m < 4; ++m) { bf16_t* rowp = O + (size_t)(row0 + ai * HALF + m * 16) * ldc + col0;
#pragma unroll
                for (int bj = 0; bj < 2; ++bj) { const f32x4 v0 = acc[ai][bj][m][0] * sc, v1 = acc[ai][bj][m][1] * sc;
                    u32x4 w; w.x = cvt_pk_bf16(v0[0], v0[1]); w.y = cvt_pk_bf16(v0[2], v0[3]); w.z = cvt_pk_bf16(v1[0], v1[1]); w.w = cvt_pk_bf16(v1[2], v1[3]);
                    *(u32x4*)(rowp + bj * HALF) = w; } }
    }
};
struct EpiRope {
    static constexpr bool PERM = true;
    bf16_t* O; int ldc; int rope_tiles; const float* cs; float oscale;
    __device__ __forceinline__ void operator()(const f32x4 (&acc)[2][2][4][2], const Unit& u, int wr, int wc, int fr, int fq) const {
        const int row0 = u.pm * BM + wr * 64 + fr, col0 = u.pn * BM + wc * 32 + 8 * fq;
        const bool rope = u.pn < rope_tiles; const int i0 = 16 * (wc & 1) + 4 * fq;
#pragma unroll
        for (int ai = 0; ai < 2; ++ai)
#pragma unroll
            for (int m = 0; m < 4; ++m) { const int row = row0 + ai * HALF + m * 16; bf16_t* rowp = O + (size_t)row * ldc + col0;
                f32x4 t0 = (f32x4){1.f, 0.f, 1.f, 0.f}, t1 = (f32x4){1.f, 0.f, 1.f, 0.f};
                if (rope) { const f32x4* tp = (const f32x4*)(cs + ((size_t)row * 32 + i0) * 2); t0 = tp[0]; t1 = tp[1]; }
#pragma unroll
                for (int bj = 0; bj < 2; ++bj) { const f32x4 v0 = acc[ai][bj][m][0], v1 = acc[ai][bj][m][1];
                    const float a0 = v0[0] * t0[0] - v0[1] * t0[1], a1 = v0[1] * t0[0] + v0[0] * t0[1], a2 = v0[2] * t0[2] - v0[3] * t0[3], a3 = v0[3] * t0[2] + v0[2] * t0[3];
                    const float b0 = v1[0] * t1[0] - v1[1] * t1[1], b1 = v1[1] * t1[0] + v1[0] * t1[1], b2 = v1[2] * t1[2] - v1[3] * t1[3], b3 = v1[3] * t1[2] + v1[2] * t1[3];
                    u32x4 w; w.x = cvt_pk_bf16(a0 * oscale, a1 * oscale); w.y = cvt_pk_bf16(a2 * oscale, a3 * oscale); w.z = cvt_pk_bf16(b0 * oscale, b1 * oscale); w.w = cvt_pk_bf16(b2 * oscale, b3 * oscale);
                    *(u32x4*)(rowp + bj * HALF) = w; } }
    }
};
struct EpiGU {
    static constexpr bool PERM = true;
    bf16_t* O;
    __device__ __forceinline__ void operator()(const f32x4 (&acc)[2][2][4][2], const Unit& u, int wr, int wc, int fr, int fq) const {
        const int row0 = u.pm * BM + wr * 64 + fr, col0 = u.pn * HALF + wc * 32 + 8 * fq;
#pragma unroll
        for (int ai = 0; ai < 2; ++ai)
#pragma unroll
            for (int m = 0; m < 4; ++m) { bf16_t* rowp = O + (size_t)(row0 + ai * HALF + m * 16) * 256 + col0;
                float r[8];
#pragma unroll
                for (int n = 0; n < 2; ++n)
#pragma unroll
                    for (int j = 0; j < 4; ++j) { const float gt = acc[ai][0][m][n][j], up = acc[ai][1][m][n][j]; r[n * 4 + j] = gt * __builtin_amdgcn_rcpf(1.f + __expf(-gt)) * up; }
                u32x4 w; w.x = cvt_pk_bf16(r[0], r[1]); w.y = cvt_pk_bf16(r[2], r[3]); w.z = cvt_pk_bf16(r[4], r[5]); w.w = cvt_pk_bf16(r[6], r[7]);
                *(u32x4*)rowp = w; }
    }
};

template <class Epi, class Sched, bool ALIGN_EPI>
__device__ __forceinline__ void gemm_phase(PG8_LAS unsigned char* lds, const Gemm g, const Sched& S, const Epi& E, int wave_s) {
    const int tid = hw_tid(wave_s);
    const int wid = __builtin_amdgcn_readfirstlane(tid >> 6), lane = tid & 63, wr = wid >> 2, wc = wid & 3, fr = lane & 15, fq = lane >> 4;
    const int K = g.K, nt = K / BK;
    int sR[2], sC[2]; unsigned voffB[2];
#pragma unroll
    for (int i = 0; i < 2; ++i) { int R, C; stage_rc(tid * 16 + i * 8192, R, C); sR[i] = R; sC[i] = C; const int Rb = Epi::PERM ? ((R & ~31) + perm32(R & 31)) : R; voffB[i] = (unsigned)(Rb * K + C) * 2u; }
    const unsigned kstep = (unsigned)(BK * 2);
    const size_t hstep = (size_t)HALF * K * 2;
    const unsigned ldsw = (unsigned)wid * 1024u;
    const int aoff = lds_byte(wr * 64 + fr, fq * 8), boff = lds_byte(wc * 32 + fr, fq * 8);
    const char* const Ab = (const char*)g.A;
#define PG8_SA(b, h) (((b) * 2 + (h)) * HTB)
#define PG8_SB(b, h) ((4 + (b) * 2 + (h)) * HTB)
#define PG8_STAGEB(bufoff, gbase) do { _Pragma("unroll") for (int _i = 0; _i < 2; ++_i) \
        __builtin_amdgcn_global_load_lds((const unsigned*)((const char*)(gbase) + voffB[_i]), (PG8_LAS unsigned*)(lds + (bufoff) + ldsw + _i * 8192), 16, 0, 0); } while (0)
#define PG8_STAGEA(bufoff, o0, o1) do { \
        __builtin_amdgcn_global_load_lds((const unsigned*)(Ab + (o0)), (PG8_LAS unsigned*)(lds + (bufoff) + ldsw), 16, 0, 0); \
        __builtin_amdgcn_global_load_lds((const unsigned*)(Ab + (o1)), (PG8_LAS unsigned*)(lds + (bufoff) + ldsw + 8192), 16, 0, 0); } while (0)
#define PG8_LDA(dst, b, h) do { _Pragma("unroll") for (int m = 0; m < 4; ++m) _Pragma("unroll") for (int k = 0; k < 2; ++k) dst[m][k] = *(const PG8_LAS bf16x8*)(lds + PG8_SA(b, h) + aoff + m * 2048 + k * 1024); } while (0)
#define PG8_LDB(dst, b, h) do { _Pragma("unroll") for (int n = 0; n < 2; ++n) _Pragma("unroll") for (int k = 0; k < 2; ++k) dst[n][k] = *(const PG8_LAS bf16x8*)(lds + PG8_SB(b, h) + boff + n * 2048 + k * 1024); } while (0)
#define PG8_MMA(ai, bj, At, Bt) do { __builtin_amdgcn_s_setprio(1); _Pragma("unroll") for (int m = 0; m < 4; ++m) _Pragma("unroll") for (int n = 0; n < 2; ++n) _Pragma("unroll") for (int k = 0; k < 2; ++k) \
        acc[ai][bj][m][n] = __builtin_amdgcn_mfma_f32_16x16x32_bf16(Bt[n][k], At[m][k], acc[ai][bj][m][n], 0, 0, 0); __builtin_amdgcn_s_setprio(0); } while (0)
#define PG8_WAIT_V(n) asm volatile("s_waitcnt vmcnt(" #n ")" ::: "memory")
#define PG8_WAIT_L(n) asm volatile("s_waitcnt lgkmcnt(" #n ")" ::: "memory")
#define PG8_BAR __builtin_amdgcn_s_barrier()
#define PG8_SCHED __builtin_amdgcn_sched_barrier(0)
    Unit cur, nxt; int ui = 0;
    if (!S.next(0, cur)) return;
    f32x4 acc[2][2][4][2];
#pragma unroll
    for (int a = 0; a < 2; ++a)
#pragma unroll
        for (int b = 0; b < 2; ++b)
#pragma unroll
            for (int m = 0; m < 4; ++m)
#pragma unroll
                for (int n = 0; n < 2; ++n) acc[a][b][m][n] = (f32x4){0.f, 0.f, 0.f, 0.f};
    bf16x8 At[4][2], B0[2][2], B1[2][2];
    unsigned vA00, vA01, vA10, vA11;
    vA00 = S.a_off(g, cur, 0, sR[0], sC[0]); vA01 = S.a_off(g, cur, 0, sR[1], sC[1]); vA10 = S.a_off(g, cur, 1, sR[0], sC[0]); vA11 = S.a_off(g, cur, 1, sR[1], sC[1]);
    const char* cB = S.b_ptr(g, cur);
    PG8_STAGEB(PG8_SB(0, 0), cB); PG8_STAGEB(PG8_SB(0, 1), cB + hstep); PG8_STAGEA(PG8_SA(0, 0), vA00, vA01); PG8_STAGEA(PG8_SA(0, 1), vA10, vA11);
    if (wr == 1) PG8_BAR;
    PG8_WAIT_V(2); PG8_BAR;
    PG8_STAGEB(PG8_SB(1, 0), cB + kstep); PG8_STAGEA(PG8_SA(1, 0), vA00 + kstep, vA01 + kstep); PG8_STAGEB(PG8_SB(1, 1), cB + hstep + kstep);
    PG8_WAIT_V(6); PG8_BAR;
    for (;;) {
        const bool has_next = S.next(ui + 1, nxt);
        const char* nB = has_next ? S.b_ptr(g, nxt) : cB;
        unsigned nA00 = vA00, nA01 = vA01, nA10 = vA10, nA11 = vA11;
        if (has_next) { nA00 = S.a_off(g, nxt, 0, sR[0], sC[0]); nA01 = S.a_off(g, nxt, 0, sR[1], sC[1]); nA10 = S.a_off(g, nxt, 1, sR[0], sC[0]); nA11 = S.a_off(g, nxt, 1, sR[1], sC[1]); }
#pragma unroll 1
        for (int t = 0; t < nt; t += 2) {
            const bool last = (t == nt - 2);
            const unsigned k1 = (unsigned)(t + 1) * kstep;
            const unsigned k2 = last ? 0u : (unsigned)(t + 2) * kstep, k3 = k2 + kstep;
            const char* b2 = last ? nB : cB + (size_t)(t + 2) * kstep; const char* b3 = b2 + kstep;
            const unsigned s00 = (last ? nA00 : vA00), s01 = (last ? nA01 : vA01), s10 = (last ? nA10 : vA10), s11 = (last ? nA11 : vA11);
            PG8_LDB(B0, 0, 0); PG8_LDB(B1, 0, 1); PG8_SCHED; PG8_LDA(At, 0, 0); PG8_STAGEA(PG8_SA(1, 1), vA10 + k1, vA11 + k1);
            PG8_WAIT_V(8); PG8_WAIT_L(0); PG8_BAR; PG8_MMA(0, 0, At, B0); PG8_MMA(0, 1, At, B1); PG8_BAR; PG8_SCHED;
            PG8_LDA(At, 0, 1); PG8_STAGEB(PG8_SB(0, 0), b2); PG8_STAGEB(PG8_SB(0, 1), b2 + hstep); PG8_STAGEA(PG8_SA(0, 0), s00 + k2, s01 + k2);
            PG8_WAIT_V(8); PG8_WAIT_L(0); PG8_BAR; PG8_MMA(1, 0, At, B0); PG8_MMA(1, 1, At, B1); PG8_BAR; PG8_SCHED;
            PG8_LDB(B0, 1, 0); PG8_LDB(B1, 1, 1); PG8_SCHED; PG8_LDA(At, 1, 0); PG8_STAGEA(PG8_SA(0, 1), s10 + k2, s11 + k2);
            PG8_WAIT_V(8); PG8_WAIT_L(0); PG8_BAR; PG8_MMA(0, 0, At, B0); PG8_MMA(0, 1, At, B1); PG8_BAR; PG8_SCHED;
            PG8_LDA(At, 1, 1); PG8_STAGEB(PG8_SB(1, 0), b3); PG8_STAGEB(PG8_SB(1, 1), b3 + hstep); PG8_STAGEA(PG8_SA(1, 0), s00 + k3, s01 + k3);
            PG8_WAIT_V(8); PG8_WAIT_L(0); PG8_BAR; PG8_MMA(1, 0, At, B0); PG8_MMA(1, 1, At, B1); PG8_BAR; PG8_SCHED;
        }
        if constexpr (ALIGN_EPI) { if (wr == 0) PG8_BAR; }
        E(acc, cur, wr, wc, fr, fq);
        if (!has_next) break;
#pragma unroll
        for (int a = 0; a < 2; ++a)
#pragma unroll
            for (int b = 0; b < 2; ++b)
#pragma unroll
                for (int m = 0; m < 4; ++m)
#pragma unroll
                    for (int n = 0; n < 2; ++n) acc[a][b][m][n] = (f32x4){0.f, 0.f, 0.f, 0.f};
        cur = nxt; cB = nB; vA00 = nA00; vA01 = nA01; vA10 = nA10; vA11 = nA11; ++ui;
        if constexpr (ALIGN_EPI) { if (wr == 1) PG8_BAR; }
    }
    PG8_WAIT_V(0);
    if constexpr (!ALIGN_EPI) { if (wr == 0) PG8_BAR; }
    PG8_BAR;
#undef PG8_SA
#undef PG8_SB
#undef PG8_STAGEA
#undef PG8_STAGEB
#undef PG8_LDA
#undef PG8_LDB
#undef PG8_MMA
#undef PG8_WAIT_V
#undef PG8_WAIT_L
#undef PG8_BAR
#undef PG8_SCHED
}
}

constexpr int NWAVES = 8;
constexpr int BATCH = 2, SEQ = 8192, D = 1024, M = BATCH * SEQ, DEPTH = 4, NA = 2;
constexpr float ALPHA = 1.681792830507429f;
constexpr float LN_EPS = 1e-5f, A_NORM_EPS = 1e-6f;
constexpr int AH = 4, DQK = 128, DV = 256, APROJ = 3080, NPROJ = 3072;
constexpr int CH = 256, NCH = SEQ / CH;
constexpr int BG = 3, BH = 8, HD = 64, BW = 512, NQ = 1536, NKV = 3072;
constexpr int NE = 32, EG = 8, MH = 256;
constexpr int MAXRB = 160;

constexpr size_t MiB = 1u << 20;
constexpr size_t WS_CTL = 0, CTL_ZERO_BYTES = 128 * 1024;
constexpr size_t WS_MOD = 1 * MiB;
constexpr size_t WS_ROPE = 2 * MiB;
constexpr size_t WS_WR = 6 * MiB;
constexpr size_t WS_WG = 6 * MiB + 768 * 1024;
constexpr size_t WS_GATES = 7 * MiB;
constexpr size_t WS_ROUTE = 8 * MiB;
constexpr size_t WS_LIST = 9 * MiB;
constexpr size_t WS_MLS = 11 * MiB;
constexpr size_t WS_WIN = 12 * MiB, WS_WOUT = 24 * MiB, WS_WKV = 28 * MiB, WS_WQ = 34 * MiB, WS_WO = 40 * MiB, WS_WGU = 42 * MiB, WS_WD = 170 * MiB;
constexpr size_t WS_H = 234 * MiB;
constexpr size_t WS_YA = 266 * MiB;
constexpr size_t WS_S0 = 298 * MiB;
constexpr size_t WS_PROJ = WS_S0, WS_DC = WS_S0 + 96 * MiB, WS_CIN = WS_S0 + 128 * MiB;
constexpr size_t WS_Q = WS_S0, WS_OG = WS_S0 + 48 * MiB, WS_LSE = WS_S0 + 96 * MiB, WS_KV = WS_S0 + 112 * MiB;
constexpr size_t WS_YMIX = WS_S0;
constexpr size_t WS_Y = WS_S0, WS_ACT = WS_S0 + 80 * MiB;
constexpr size_t WS_X = WS_S0 + 208 * MiB;
constexpr size_t WS_END = WS_X + 64 * MiB;
constexpr int CW_BAR = 4096;
constexpr int CW_CNT = 16384;

constexpr int RING_BYTES = 131072;
constexpr int LDSCTL_OFF = 145408;
constexpr int LDS_BYTES = 147456;

#define GAS __attribute__((address_space(1)))
#define LAS __attribute__((address_space(3)))
typedef unsigned short bf16;
typedef unsigned v4u __attribute__((ext_vector_type(4)));
typedef unsigned v2u __attribute__((ext_vector_type(2)));
typedef float f32x4 __attribute__((ext_vector_type(4)));
typedef float f32x2 __attribute__((ext_vector_type(2)));
#define RLX_AGENT __ATOMIC_RELAXED, __HIP_MEMORY_SCOPE_AGENT
#ifndef ST_NT
#define ST_NT(p, v) __builtin_nontemporal_store((v), (p))
#endif
__device__ __forceinline__ unsigned f2bf(float f) { unsigned u = __builtin_bit_cast(unsigned, f); return (u + 0x7fffu + ((u >> 16) & 1u)) >> 16; }
typedef __bf16 bf16n2 __attribute__((ext_vector_type(2)));
__device__ __forceinline__ unsigned pk2(float lo, float hi) { bf16n2 v; v.x = (__bf16)lo; v.y = (__bf16)hi; return __builtin_bit_cast(unsigned, v); }
__device__ __forceinline__ float u2f(unsigned w) { return __builtin_bit_cast(float, w); }
__device__ __forceinline__ unsigned f2u(float f) { return __builtin_bit_cast(unsigned, f); }
__device__ __forceinline__ float bflo(unsigned w) { return __builtin_bit_cast(float, w << 16); }
__device__ __forceinline__ float bfhi(unsigned w) { return __builtin_bit_cast(float, w & 0xffff0000u); }
__device__ __forceinline__ float bf2f(bf16 v) { return __builtin_bit_cast(float, (unsigned)v << 16); }
template <int CTRL> __device__ __forceinline__ float dpp_mov(float v) { return __builtin_bit_cast(float, __builtin_amdgcn_update_dpp(0, __builtin_bit_cast(int, v), CTRL, 0xF, 0xF, true)); }
__device__ __forceinline__ float rdlane(float v, int l) { return __builtin_bit_cast(float, __builtin_amdgcn_readlane(__builtin_bit_cast(int, v), l)); }
__device__ __forceinline__ float quad_sum(float v) { v += dpp_mov<0xB1>(v); v += dpp_mov<0x4E>(v); return v; }
__device__ __forceinline__ float quad_max(float v) { v = fmaxf(v, dpp_mov<0xB1>(v)); v = fmaxf(v, dpp_mov<0x4E>(v)); return v; }
__device__ __forceinline__ float row16_sum(float v) { v += dpp_mov<0xB1>(v); v += dpp_mov<0x4E>(v); v += dpp_mov<0x141>(v); v += dpp_mov<0x140>(v); return v; }
__device__ __forceinline__ float row16_max(float v) { v = fmaxf(v, dpp_mov<0xB1>(v)); v = fmaxf(v, dpp_mov<0x4E>(v)); v = fmaxf(v, dpp_mov<0x141>(v)); v = fmaxf(v, dpp_mov<0x140>(v)); return v; }
__device__ __forceinline__ float wave_sum(float v) { v = row16_sum(v); return (rdlane(v, 0) + rdlane(v, 16)) + (rdlane(v, 32) + rdlane(v, 48)); }
__device__ __forceinline__ float wave_max(float v) { v = row16_max(v); return fmaxf(fmaxf(rdlane(v, 0), rdlane(v, 16)), fmaxf(rdlane(v, 32), rdlane(v, 48))); }
#define opaque_tid() hw_tid(F.wave)
__device__ __forceinline__ float sigmoidf_(float x) { return __builtin_amdgcn_rcpf(1.f + __expf(-x)); }
__device__ __forceinline__ float logsigmoidf_(float x) { return fminf(x, 0.f) - __logf(1.f + __expf(-fabsf(x))); }
__device__ __forceinline__ float lane_xor(float v, int m, int lane) { return __builtin_bit_cast(float, __builtin_amdgcn_ds_bpermute((lane ^ m) << 2, __builtin_bit_cast(int, v))); }
__device__ __forceinline__ float lane_up(float v, int o, int lane) { return __builtin_bit_cast(float, __builtin_amdgcn_ds_bpermute(((lane - o) & 63) << 2, __builtin_bit_cast(int, v))); }
__device__ __forceinline__ int lane_up(int v, int o, int lane) { return __builtin_amdgcn_ds_bpermute(((lane - o) & 63) << 2, v); }
__device__ __forceinline__ int lane_get(int v, int src) { return __builtin_amdgcn_ds_bpermute(src << 2, v); }

#define XB_TMO      128
#define XB_XCNT(j)  (256  + 64 * (j))
#define XB_XSUB(j)  (1280 + 64 * (j))
#define XB_XGEN(j)  (2304 + 64 * (j))
#define XB_TOP      3328
#define XB_TOPGEN   3392
#define XCD_BAR_WORDS 3456
#define XB_SPIN_CAP (1u << 18)

__device__ __forceinline__ unsigned xb_ld(unsigned* p)              { return __hip_atomic_load(p, __ATOMIC_RELAXED, __HIP_MEMORY_SCOPE_AGENT); }
__device__ __forceinline__ unsigned xb_add(unsigned* p, unsigned v) { return __hip_atomic_fetch_add(p, v, __ATOMIC_RELAXED, __HIP_MEMORY_SCOPE_AGENT); }
__device__ __forceinline__ unsigned xb_xcc_id() { return (unsigned)__builtin_amdgcn_s_getreg((3 << 11) | 20) & 0xFu; }
#define XB_SPIN(cond, bar) do { unsigned _sp = 0; while (cond) { __builtin_amdgcn_s_sleep(1); \
    if ((++_sp & 255u) == 0u) { if (xb_ld(&(bar)[XB_TMO])) break; if (_sp > XB_SPIN_CAP) { atomicAdd(&(bar)[XB_TMO], 1u); break; } } } } while (0)

struct XcdBarrier {
    unsigned* bar; unsigned x;
    volatile LAS unsigned* st;
    int w;
};
__device__ __forceinline__ XcdBarrier xcd_barrier_post(unsigned* bar, volatile LAS unsigned* st, int wave_s) {
    XcdBarrier b; b.bar = bar; b.x = xb_xcc_id(); b.st = st; b.w = wave_s;
    if (hw_tid(wave_s) == 0) (void)xb_add(&bar[XB_XCNT(b.x)], 1u);
    return b;
}
__device__ __forceinline__ void xcd_barrier_complete(unsigned* bar, unsigned x, unsigned& nloc, unsigned& nx) {
    const unsigned G = gridDim.x * gridDim.y * gridDim.z;
    unsigned sum, cnt, mine, sp = 0u;
    for (;;) {
        sum = 0u; cnt = 0u; mine = 0u;
#pragma unroll
        for (unsigned j = 0; j < 16; ++j) { const unsigned c = xb_ld(&bar[XB_XCNT(j)]); sum += c; cnt += (c > 0u) ? 1u : 0u; mine = (j == x) ? c : mine; }
        if (sum == G) break;
        __builtin_amdgcn_s_sleep(1);
        if ((++sp & 255u) == 0u) { if (xb_ld(&bar[XB_TMO])) break; if (sp > XB_SPIN_CAP) { atomicAdd(&bar[XB_TMO], 1u); break; } }
    }
    nloc = mine > 0u ? mine : 1u; nx = cnt > 0u ? cnt : 1u;
}
__device__ __forceinline__ void xcd_barrier(const XcdBarrier& b) {
    asm volatile("s_waitcnt vmcnt(0)" ::: "memory");
    __syncthreads();
    if (hw_tid(b.w) == 0) {
        unsigned* bar = b.bar;
        __builtin_amdgcn_s_waitcnt(0);
        unsigned nloc = b.st[0], nx = b.st[1];
        if (nloc == 0u) { xcd_barrier_complete(bar, b.x, nloc, nx); b.st[0] = nloc; b.st[1] = nx; }
        const unsigned old = xb_add(&bar[XB_XSUB(b.x)], 1u);
        const unsigned gen = old / nloc;
        if (old + 1u == (gen + 1u) * nloc) {
            __builtin_amdgcn_fence(__ATOMIC_RELEASE, "agent");
            asm volatile("s_waitcnt vmcnt(0)" ::: "memory");
            const unsigned og = xb_add(&bar[XB_TOP], 1u);
            const unsigned tg = og / nx;
            if (og + 1u == (tg + 1u) * nx) xb_add(&bar[XB_TOPGEN], 1u);
            else XB_SPIN(xb_ld(&bar[XB_TOPGEN]) == tg, bar);
            __builtin_amdgcn_fence(__ATOMIC_ACQUIRE, "agent");
            xb_add(&bar[XB_XGEN(b.x)], 1u);
            asm volatile("s_waitcnt vmcnt(0)" ::: "memory");
        } else {
            XB_SPIN(xb_ld(&bar[XB_XGEN(b.x)]) == gen, bar);
            __builtin_amdgcn_fence(__ATOMIC_ACQUIRE, "agent");
            asm volatile("s_waitcnt vmcnt(0)" ::: "memory");
        }
    }
    __syncthreads();
}

struct Frame {
    LAS unsigned char* lds;
    unsigned* ctl;
    unsigned char* ws;
    int tid, lane, wave, G;
    const float *x, *c; const int* pos; const float *ada_w, *ada_b, *ln_g, *ln_b, *a_w_in, *a_b_gate, *a_norm_g, *a_w_out, *b_w_kv, *b_w_q, *b_w_o,
                *w_r1, *b_r1, *w_r2, *b_r2, *w_gate, *w_up, *w_down;
    float* out;
};

__device__ __forceinline__ int rowmap(int mode, int n) {
    if (mode == 1 || (mode == 2 && n < 1536)) { const int e = n & 63; return (n & ~63) + 2 * (e & 31) + (e >> 5); }
    if (mode == 3) return ((n >> 7) << 8) + (n & 127);
    if (mode == 4) return ((n >> 7) << 8) + 128 + (n & 127);
    return n;
}
__device__ __forceinline__ void transpose_load(const float* W, int ldw, int k0, int n0, f32x4 (&t)[8], int lane) {
#pragma unroll
    for (int i = 0; i < 8; ++i) t[i] = *(const f32x4*)(W + (size_t)(k0 + 8 * i + (lane >> 3)) * ldw + n0 + 4 * (lane & 7));
}
__device__ __forceinline__ void transpose_store(const f32x4 (&t)[8], int k0, int n0, bf16* WT, int ldk, int mode, LAS float* scr, int lane) {
#pragma unroll
    for (int i = 0; i < 8; ++i) { LAS float* d = scr + (8 * i + (lane >> 3)) * 33 + 4 * (lane & 7); d[0] = t[i].x; d[1] = t[i].y; d[2] = t[i].z; d[3] = t[i].w; }
    asm volatile("s_waitcnt lgkmcnt(0)" ::: "memory");
    const int c = lane & 7;
#pragma unroll
    for (int j = 0; j < 4; ++j) { const int n = (lane >> 3) + 8 * j; const LAS float* s = scr + (8 * c) * 33 + n;
        v4u o; o.x = pk2(s[0 * 33], s[1 * 33]); o.y = pk2(s[2 * 33], s[3 * 33]); o.z = pk2(s[4 * 33], s[5 * 33]); o.w = pk2(s[6 * 33], s[7 * 33]);
        *(v4u*)(WT + (size_t)rowmap(mode, n0 + n) * ldk + k0 + 8 * c) = o; }
    asm volatile("s_waitcnt lgkmcnt(0)" ::: "memory");
}
struct TItem { const float* W; bf16* WT; int ldw, k0, n0, ldk, mode; };
__device__ __forceinline__ TItem conv_item(Frame& F, int kind, int l, int r) {
    TItem t; t.mode = 0;
    const float* const wg = F.w_gate; const float* const wu = F.w_up;
    if (kind == 0) { t.W = F.a_w_in + (size_t)l * D * APROJ; t.ldw = APROJ; t.k0 = 64 * (r / 96); t.n0 = 32 * (r % 96); t.WT = (bf16*)(F.ws + WS_WIN) + (size_t)l * NPROJ * D; t.ldk = D; }
    else if (kind == 1) { t.W = F.a_w_out + (size_t)l * D * D; t.ldw = D; t.k0 = 64 * (r / 32); t.n0 = 32 * (r % 32); t.WT = (bf16*)(F.ws + WS_WOUT) + (size_t)l * D * D; t.ldk = D; }
    else if (kind == 2) { t.W = F.b_w_kv; t.ldw = NKV; t.k0 = 64 * (r / 96); t.n0 = 32 * (r % 96); t.WT = (bf16*)(F.ws + WS_WKV); t.ldk = D; t.mode = 2; }
    else if (kind == 3) { t.W = F.b_w_q + (size_t)l * D * NQ; t.ldw = NQ; t.k0 = 64 * (r / 48); t.n0 = 32 * (r % 48); t.WT = (bf16*)(F.ws + WS_WQ) + (size_t)l * NQ * D; t.ldk = D; t.mode = 1; }
    else if (kind == 4) { t.W = F.b_w_o + (size_t)l * BW * D; t.ldw = D; t.k0 = 64 * (r / 32); t.n0 = 32 * (r % 32); t.WT = (bf16*)(F.ws + WS_WO) + (size_t)l * D * BW; t.ldk = BW; }
    else { const int sub = r >> 12, q = r & 4095, le = l * NE + (q >> 7), rr = q & 127;
        if (sub < 2) { t.W = (sub == 0 ? wg : wu) + (size_t)le * D * MH; t.ldw = MH; t.k0 = 64 * (rr / 8); t.n0 = 32 * (rr % 8); t.WT = (bf16*)(F.ws + WS_WGU) + (size_t)le * 512 * D; t.ldk = D; t.mode = 3 + sub; }
        else { t.W = F.w_down + (size_t)le * MH * D; t.ldw = D; t.k0 = 64 * (rr / 32); t.n0 = 32 * (rr % 32); t.WT = (bf16*)(F.ws + WS_WD) + (size_t)le * D * MH; t.ldk = MH; } }
    return t;
}
template <int STAGE> __device__ __forceinline__ int stage_count(int l) { return STAGE == 0 ? 1536 + 512 + 12288 : STAGE == 1 ? 1536 + 512 : STAGE == 2 ? 1536 + 768 + 256 : STAGE == 3 ? 768 + 256 : STAGE == 4 ? (l >= NA ? 8192 : 12288) : 4096; }
template <int STAGE> __device__ __forceinline__ TItem stage_item(Frame& F, int r, int l) {
    if (STAGE == 0) { if (r < 1536) return conv_item(F, 0, 0, r); r -= 1536; if (r < 512) return conv_item(F, 1, 0, r); return conv_item(F, 5, 0, r - 512); }
    if (STAGE == 1) { if (r < 1536) return conv_item(F, 0, 1, r); return conv_item(F, 1, 1, r - 1536); }
    if (STAGE == 2) { if (r < 1536) return conv_item(F, 2, 0, r); r -= 1536; if (r < 768) return conv_item(F, 3, 0, r); return conv_item(F, 4, 0, r - 768); }
    if (STAGE == 3) { if (r < 768) return conv_item(F, 3, 1, r); return conv_item(F, 4, 1, r - 768); }
    if (STAGE == 5) return conv_item(F, 5, l, 8192 + r);
    return conv_item(F, 5, l, r);
}
template <int STAGE> __device__ __forceinline__ void conv_run(Frame& F, int l, int gw, int NGW, int lane, int wave) {
    LAS float* scr = (LAS float*)(F.lds + wave * 16384);
    const int NITEMS = stage_count<STAGE>(l);
    f32x4 cur[8], nxt[8];
    int it = gw;
    if (it < NITEMS) { const TItem t = stage_item<STAGE>(F, it, l); transpose_load(t.W, t.ldw, t.k0, t.n0, cur, lane); }
#pragma unroll 1
    for (; it < NITEMS; it += NGW) {
        const TItem t = stage_item<STAGE>(F, it, l);
        const bool more = it + NGW < NITEMS;
        if (more) { const TItem tn = stage_item<STAGE>(F, it + NGW, l); transpose_load(tn.W, tn.ldw, tn.k0, tn.n0, nxt, lane); }
        transpose_store(cur, t.k0, t.n0, t.WT, t.ldk, t.mode, scr, lane);
        if (more) {
#pragma unroll
            for (int j = 0; j < 8; ++j) cur[j] = nxt[j]; }
    }
}
__device__ __forceinline__ void gemv_run(Frame& F, int tid, int lane, int wave) {
    LAS float* red = (LAS float*)F.lds;
    LAS float* sc = (LAS float*)(F.lds + 8192);
    float* mod = (float*)(F.ws + WS_MOD);
    for (int i = tid; i < 2 * D; i += NWAVES * 64) { const float c = F.c[i]; sc[i] = c / (1.f + expf(-c)); }
    __syncthreads();
    for (int it = blockIdx.x; it < 4 * 64; it += F.G) {
        const int l = it >> 6, n0 = (it & 63) * 96;
        const float* W = F.ada_w + (size_t)l * D * 6144 + n0 + 2 * (lane < 48 ? lane : 0);
        float a00 = 0.f, a01 = 0.f, a10 = 0.f, a11 = 0.f;
        const int k0 = wave * 128;
#pragma unroll 1
        for (int kb = k0; kb < k0 + 128; kb += 32) {
            f32x2 w[32];
#pragma unroll
            for (int k = 0; k < 32; ++k) w[k] = *(const f32x2*)(W + (size_t)(kb + k) * 6144);
#pragma unroll
            for (int k = 0; k < 32; ++k) { const float c0 = sc[kb + k], c1 = sc[D + kb + k]; a00 += c0 * w[k].x; a01 += c0 * w[k].y; a10 += c1 * w[k].x; a11 += c1 * w[k].y; }
        }
        if (lane < 48) { red[(wave * 2 + 0) * 96 + 2 * lane] = a00; red[(wave * 2 + 0) * 96 + 2 * lane + 1] = a01;
                         red[(wave * 2 + 1) * 96 + 2 * lane] = a10; red[(wave * 2 + 1) * 96 + 2 * lane + 1] = a11; }
        __syncthreads();
        if (tid < 192) { const int b = tid / 96, nn = tid % 96; float s = 0.f;
#pragma unroll
            for (int w8 = 0; w8 < 8; ++w8) s += red[(w8 * 2 + b) * 96 + nn];
            mod[(size_t)(l * 2 + b) * 6144 + n0 + nn] = s + F.ada_b[l * 6144 + n0 + nn]; }
        __syncthreads();
    }
}
__device__ __forceinline__ void rope_table(Frame& F, int gt, int NGT) {
    float* cs = (float*)(F.ws + WS_ROPE);
    const float inv = powf(10000.f, -(float)(gt & 31) * 2.0f / 64.0f);
    for (int i = gt; i < M * 32; i += NGT) { const int tok = i >> 5;
        const float ang = (float)F.pos[tok] * inv;
        const double a = (double)ang; const double n = rint(a * 0.15915494309189535); const float r = (float)(a - n * 6.283185307179586);
        *(f32x2*)(cs + 2 * (size_t)i) = (f32x2){cosf(r), sinf(r)}; }
}
template <int STAGE> __device__ __forceinline__ void tail_fill(Frame& F, int l, int total_units, int vcu) {
    const int tid = opaque_tid(), lane = tid & 63, wave = __builtin_amdgcn_readfirstlane(tid >> 6);
    const int maxu = (total_units + F.G - 1) / F.G; int cut = total_units - (maxu - 1) * F.G; if (cut < 0 || F.G - cut < F.G / 2) cut = 0;
    if (vcu >= cut) {
        const int j = vcu - cut, n = F.G - cut;
        if (STAGE == 4) conv_run<STAGE>(F, l, j * NWAVES + wave, n * NWAVES, lane, wave);
        else {
            conv_run<STAGE>(F, l, j * NWAVES + wave, n * NWAVES, lane, wave);
            if (STAGE == 1) rope_table(F, j * (NWAVES * 64) + tid, n * (NWAVES * 64));
        }
    }
}
__device__ __forceinline__ void pro_a(Frame& F) {
    const int tid = opaque_tid(), lane = tid & 63, wave = __builtin_amdgcn_readfirstlane(tid >> 6);
    gemv_run(F, tid, lane, wave);
    conv_run<0>(F, 0, blockIdx.x * NWAVES + wave, F.G * NWAVES, lane, wave);
    {
        const int gt = blockIdx.x * (NWAVES * 64) + tid, NGT = F.G * NWAVES * 64;
        float* WR = (float*)(F.ws + WS_WR); float* WG = (float*)(F.ws + WS_WG);
        for (int i = gt; i < 4 * 48 * D; i += NGT) { const int l = i / (48 * D), c = (i / D) % 48, k = i % D;
            WR[i] = c < 4 ? F.w_r1[(size_t)(l * D + k) * 4 + c] : (c < 36 ? F.w_r2[(size_t)(l * D + k) * 32 + (c - 4)] : 0.f); }
        for (int i = gt; i < 2 * 8 * D; i += NGT) { const int l = i / (8 * D), j = (i / D) % 8, k = i % D; WG[i] = F.a_w_in[(size_t)(l * D + k) * APROJ + NPROJ + j]; }
    }
}

__device__ __forceinline__ void store_row_bf16(bf16* dst, const f32x4 (&h)[4], int lane) {
#pragma unroll
    for (int j = 0; j < 4; ++j) { v2u o; o.x = pk2(h[j].x, h[j].y); o.y = pk2(h[j].z, h[j].w); ST_NT((v2u*)(dst + 256 * j + 4 * lane), o); }
}
template <int NR> __device__ __forceinline__ void gates_rows_lds(const f32x4 (&h)[NR][4], const LAS float* W, const float* bg, float* grow0, int lane) {
    float p[NR][8];
#pragma unroll
    for (int g = 0; g < 8; ++g) { f32x4 w[4];
#pragma unroll
        for (int j = 0; j < 4; ++j) w[j] = *(const LAS f32x4*)(W + g * D + 256 * j + 4 * lane);
#pragma unroll
        for (int r = 0; r < NR; ++r) { float s = 0.f;
#pragma unroll
            for (int j = 0; j < 4; ++j) s += (h[r][j].x * w[j].x + h[r][j].y * w[j].y) + (h[r][j].z * w[j].z + h[r][j].w * w[j].w);
            p[r][g] = wave_sum(s) + bg[g]; } }
    if (lane == 0) {
#pragma unroll
        for (int r = 0; r < NR; ++r) { *(f32x4*)(grow0 + r * 8) = (f32x4){p[r][0], p[r][1], p[r][2], p[r][3]}; *(f32x4*)(grow0 + r * 8 + 4) = (f32x4){p[r][4], p[r][5], p[r][6], p[r][7]}; } }
}
__device__ __forceinline__ void pro_b(Frame& F) {
    const int tid = opaque_tid(), lane = tid & 63, wave = __builtin_amdgcn_readfirstlane(tid >> 6), gw = blockIdx.x * NWAVES + wave, NGW = F.G * NWAVES;
    const float* mod = (const float*)(F.ws + WS_MOD); bf16* H = (bf16*)(F.ws + WS_H); float* gates = (float*)(F.ws + WS_GATES); const float* WG = (const float*)(F.ws + WS_WG);
    bf16* const xres = (bf16*)(F.ws + WS_X);
    constexpr int RB = 2;
    LAS float* VEC = (LAS float*)F.lds;
    LAS float* WGS = VEC + 4096;
    {
        const float* const m0 = mod; const float* const m1 = mod + 6144;
        const float* const p0 = m0 + 1024; const float* const p1 = m0; const float* const p2 = m1 + 1024; const float* const p3 = m1;
        const bool hi = tid >= 256; const int e = (tid & 255) * 4;
        const f32x4 a = *(const f32x4*)((hi ? p1 : p0) + e), b = *(const f32x4*)((hi ? p3 : p2) + e);
        LAS float* dst = VEC + (hi ? 1024 : 0) + e;
        *(LAS f32x4*)(dst) = a; *(LAS f32x4*)(dst + 2048) = b;
#pragma unroll
        for (int k = 0; k < 4; ++k) *(LAS f32x4*)(WGS + tid * 4 + 2048 * k) = *(const f32x4*)(WG + tid * 4 + 2048 * k);
    }
    f32x4 xv[RB][4];
    auto request = [&](int rowa) {
#pragma unroll
        for (int r = 0; r < RB; ++r)
#pragma unroll
            for (int j = 0; j < 4; ++j) xv[r][j] = *(const f32x4*)(F.x + (size_t)(rowa + r) * D + 256 * j + 4 * lane); };
    const int step = NGW * RB;
    int row0 = gw * RB;
    if (row0 < M) request(row0);
    __syncthreads();
    for (; row0 < M; row0 += step) {
        const int b = row0 >> 13; const LAS float* vl = VEC + 4 * lane + 2048 * b;
        f32x4 h[RB][4];
#pragma unroll
        for (int r = 0; r < RB; ++r)
#pragma unroll
            for (int j = 0; j < 4; ++j) h[r][j] = xv[r][j];
        if (row0 + step < M) request(row0 + step);
#pragma unroll
        for (int r = 0; r < RB; ++r) { store_row_bf16(xres + (size_t)(row0 + r) * D, h[r], lane);
#pragma unroll
            for (int j = 0; j < 4; ++j) h[r][j] = h[r][j] * (1.f + *(const LAS f32x4*)(vl + 256 * j)) + *(const LAS f32x4*)(vl + 1024 + 256 * j);
            store_row_bf16(H + (size_t)(row0 + r) * D, h[r], lane); }
        gates_rows_lds<RB>(h, WGS, F.a_b_gate, gates + (size_t)row0 * 8, lane);
    }
}
template <bool DRY> __device__ __forceinline__ void phase_r1(Frame& F, int l) {
    const int tid = opaque_tid(), lane = tid & 63, wave = __builtin_amdgcn_readfirstlane(tid >> 6), fr = lane & 15, fq = lane >> 4;
    const float* mod = (const float*)(F.ws + WS_MOD); bf16* H = (bf16*)(F.ws + WS_H); const bf16* ymix = (const bf16*)(F.ws + WS_YMIX);
    const float* WR = (const float*)(F.ws + WS_WR) + (size_t)l * 48 * D;
    unsigned* cnt = F.ctl + CW_CNT + l * 32 * 64;     int* list = (int*)(F.ws + WS_LIST); unsigned* route = (unsigned*)(F.ws + WS_ROUTE);
    bf16* const xres = (bf16*)(F.ws + WS_X);
    constexpr int HSP = 1028, RB = 2, BR = NWAVES * RB;
    LAS float* HS = (LAS float*)F.lds; LAS float* PS = (LAS float*)(F.lds + 100864); LAS float* LG = (LAS float*)(F.lds + 125440);
    LAS float* VEC = (LAS float*)(F.lds + 67584);
    {
        const float* const m0 = mod + (size_t)(l * 2 + 0) * 6144; const float* const m1 = mod + (size_t)(l * 2 + 1) * 6144;
        const float* const p0 = F.ln_g + (size_t)(l * 2 + 0) * D; const float* const p1 = F.ln_b + (size_t)(l * 2 + 0) * D;
        const float* const p2 = m0 + 2048; const float* const p3 = m0 + 4096; const float* const p4 = m0 + 3072; const float* const p5 = m1 + 2048; const float* const p6 = m1 + 4096; const float* const p7 = m1 + 3072;
        const bool hi = tid >= 256; const int e = (tid & 255) * 4;
        const f32x4 a = *(const f32x4*)((hi ? p1 : p0) + e), b = *(const f32x4*)((hi ? p3 : p2) + e), c = *(const f32x4*)((hi ? p5 : p4) + e), d = *(const f32x4*)((hi ? p7 : p6) + e);
        LAS float* dst = VEC + (hi ? 1024 : 0) + e;
        *(LAS f32x4*)(dst) = a; *(LAS f32x4*)(dst + 2048) = b; *(LAS f32x4*)(dst + 4096) = c; *(LAS f32x4*)(dst + 6144) = d;
        if (tid < 36) VEC[8192 + tid] = tid < 4 ? F.b_r1[l * 4 + tid] : F.b_r2[l * 32 + tid - 4];
    }
    f32x4 b4[8][3];
#pragma unroll
    for (int mi = 0; mi < 8; ++mi)
#pragma unroll
        for (int ct = 0; ct < 3; ++ct) b4[mi][ct] = *(const f32x4*)(WR + (size_t)(16 * ct + fr) * D + 16 * (8 * wave + mi) + 4 * fq);
    int pe = 0, prow0 = -1; unsigned pp0 = 0u, pp1 = 0u; float pw0 = 0.f, pw1 = 0.f;
    auto flush = [&]() { if (prow0 >= 0 && lane < RB) { const int prow = prow0 + lane, pe0 = pe & 255, pe1 = pe >> 8; list[pe0 * 16384 + (int)pp0] = prow; list[pe1 * 16384 + (int)pp1] = prow;
            *(v4u*)(route + (size_t)prow * 8) = (v4u){(unsigned)pe0, pp0, (unsigned)pe1, pp1}; *(v2u*)(route + (size_t)prow * 8 + 4) = (v2u){f2u(pw0), f2u(pw1)}; } prow0 = -1; };
    auto route_rows = [&](int r0) {
        if (lane < RB) {
            const LAS float* lg = LG + (wave * RB + lane) * 40;
            const float l10 = lg[0], l11 = lg[1], l12 = lg[2], l13 = lg[3];
            int gi = 0; float mx = l10;
            if (l11 > mx) { mx = l11; gi = 1; }
            if (l12 > mx) { mx = l12; gi = 2; }
            if (l13 > mx) { mx = l13; gi = 3; }
            const float pg = 1.f / (expf(l10 - mx) + expf(l11 - mx) + expf(l12 - mx) + expf(l13 - mx));
            int j0 = 0; float v0 = lg[4 + gi * 8];
            for (int j = 1; j < 8; ++j) { const float t = lg[4 + gi * 8 + j]; if (t > v0) { v0 = t; j0 = j; } }
            int j1 = -1; float v1 = -3.0e38f;
            for (int j = 0; j < 8; ++j) { const float t = lg[4 + gi * 8 + j]; if (j != j0 && t > v1) { v1 = t; j1 = j; } }
            const float ee = expf(v1 - v0);
            pw0 = pg / (1.f + ee); pw1 = pg * ee / (1.f + ee); const int pe0 = gi * 8 + j0, pe1 = gi * 8 + j1; pe = pe0 | (pe1 << 8);
            pp0 = __hip_atomic_fetch_add(cnt + pe0 * 64, DRY ? 0u : 1u, RLX_AGENT); pp1 = __hip_atomic_fetch_add(cnt + pe1 * 64, DRY ? 0u : 1u, RLX_AGENT);
        }
        prow0 = r0; };
    int lrow0 = -1;
    v2u xv[RB][4], yv[RB][4];
    auto request = [&](int r0) {
#pragma unroll
        for (int r = 0; r < RB; ++r)
#pragma unroll
            for (int j = 0; j < 4; ++j) { xv[r][j] = *(const v2u*)(xres + (size_t)(r0 + r) * D + 256 * j + 4 * lane); yv[r][j] = *(const v2u*)(ymix + (size_t)(r0 + r) * D + 256 * j + 4 * lane); } };
    int rowb = blockIdx.x * BR;
    if (rowb < M) request(rowb + wave * RB);
    __syncthreads();
    for (; rowb < M; rowb += F.G * BR) {
        const int row0 = rowb + wave * RB; const int b = row0 >> 13;
        const LAS float* vl = VEC + 4 * lane; const LAS float* vg1 = vl + (2 + 3 * b) * 1024;
        f32x4 h[RB][4];
#pragma unroll
        for (int j = 0; j < 4; ++j) { const f32x4 g1 = *(const LAS f32x4*)(vg1 + 256 * j);
#pragma unroll
            for (int r = 0; r < RB; ++r) { const v2u a = yv[r][j], x = xv[r][j]; h[r][j] = (f32x4){bflo(x.x), bfhi(x.x), bflo(x.y), bfhi(x.y)} * ALPHA + (1.f + g1) * (f32x4){bflo(a.x), bfhi(a.x), bflo(a.y), bfhi(a.y)}; } }
        { const int nb = rowb + F.G * BR; if (nb < M) request(nb + wave * RB); }
#pragma unroll
        for (int r = 0; r < RB; ++r) { float s = 0.f;
#pragma unroll
            for (int j = 0; j < 4; ++j) s += (h[r][j].x + h[r][j].y) + (h[r][j].z + h[r][j].w);
            const float mean = wave_sum(s) * (1.f / D); float q = 0.f;
#pragma unroll
            for (int j = 0; j < 4; ++j) { h[r][j] = h[r][j] - mean; q += (h[r][j].x * h[r][j].x + h[r][j].y * h[r][j].y) + (h[r][j].z * h[r][j].z + h[r][j].w * h[r][j].w); }
            const float rstd = 1.f / sqrtf(wave_sum(q) * (1.f / D) + LN_EPS);
#pragma unroll
            for (int j = 0; j < 4; ++j) h[r][j] = h[r][j] * rstd * *(const LAS f32x4*)(vl + 256 * j) + *(const LAS f32x4*)(vl + 1024 + 256 * j); }
#pragma unroll
        for (int r = 0; r < RB; ++r) {
            store_row_bf16(xres + (size_t)(row0 + r) * D, h[r], lane);
#pragma unroll
            for (int j = 0; j < 4; ++j) h[r][j] = h[r][j] * (1.f + *(const LAS f32x4*)(vg1 + 1024 + 256 * j)) + *(const LAS f32x4*)(vg1 + 2048 + 256 * j);
            store_row_bf16(H + (size_t)(row0 + r) * D, h[r], lane); }
#pragma unroll
        for (int r = 0; r < RB; ++r)
#pragma unroll
            for (int j = 0; j < 4; ++j) *(LAS f32x4*)(HS + (wave * RB + r) * HSP + 256 * j + 4 * lane) = h[r][j];
        __syncthreads();
        flush();
        if (lrow0 >= 0) route_rows(lrow0);
        f32x4 lacc[3];
#pragma unroll
        for (int ct = 0; ct < 3; ++ct) lacc[ct] = (f32x4){0.f, 0.f, 0.f, 0.f};
#pragma unroll
        for (int mi = 0; mi < 8; ++mi) { const f32x4 a0 = *(const LAS f32x4*)(HS + fr * HSP + 16 * (8 * wave + mi) + 4 * fq);
#pragma unroll
            for (int i = 0; i < 4; ++i)
#pragma unroll
                for (int ct = 0; ct < 3; ++ct) lacc[ct] = __builtin_amdgcn_mfma_f32_16x16x4f32(a0[i], b4[mi][ct][i], lacc[ct], 0, 0, 0); }
#pragma unroll
        for (int ct = 0; ct < 3; ++ct) *(LAS f32x4*)(PS + ((wave * 3 + ct) * 64 + lane) * 4) = lacc[ct];
        __syncthreads();
#pragma unroll
        for (int i = 0; i < 2; ++i) { const int idx = tid + 512 * i;
            if (idx < 768) { const int j = idx & 3, ln = (idx >> 2) & 63, ct = idx >> 8; const int off = (ct * 64 + ln) * 4 + j; float v = 0.f;
#pragma unroll
                for (int ks = 0; ks < 8; ++ks) v += PS[off + ks * 768];
                const int rowl = 4 * (ln >> 4) + j, col = 16 * ct + (ln & 15);
                if (col < 36) LG[rowl * 40 + col] = v + VEC[8192 + col]; } }
        lrow0 = row0;
    }
    __syncthreads();
    flush();
    if (lrow0 >= 0) route_rows(lrow0);
    flush();
}
template <bool DRY> __device__ __forceinline__ void phase_r2(Frame& F, int l) {
    const int tid = opaque_tid(), lane = tid & 63, wave = __builtin_amdgcn_readfirstlane(tid >> 6), gw = blockIdx.x * NWAVES + wave, NGW = F.G * NWAVES;
    const float* mod = (const float*)(F.ws + WS_MOD); bf16* H = (bf16*)(F.ws + WS_H); const bf16* Y = (const bf16*)(F.ws + WS_Y);
    float* gates = (float*)(F.ws + WS_GATES); const float* WG = (const float*)(F.ws + WS_WG);
    const unsigned* route = (const unsigned*)(F.ws + WS_ROUTE);
    bf16* const xres = (bf16*)(F.ws + WS_X);
    constexpr int RB = 2;
    const bool has_next = l < DEPTH - 1, has_gates = l + 1 < NA;
    LAS float* VEC = (LAS float*)F.lds;
    LAS float* WGS = VEC + 8192;
    {
        const int ln = has_next ? l + 1 : l;
        const float* const m0 = mod + (size_t)(l * 2 + 0) * 6144; const float* const m1 = mod + (size_t)(l * 2 + 1) * 6144;
        const float* const n0 = mod + (size_t)(ln * 2 + 0) * 6144; const float* const n1 = mod + (size_t)(ln * 2 + 1) * 6144;
        const float* const p0 = F.ln_g + (size_t)(l * 2 + 1) * D; const float* const p1 = F.ln_b + (size_t)(l * 2 + 1) * D;
        const float* const p2 = m0 + 5120; const float* const p3 = m1 + 5120; const float* const p4 = n0 + 1024; const float* const p5 = n0; const float* const p6 = n1 + 1024; const float* const p7 = n1;
        const bool hi = tid >= 256; const int e = (tid & 255) * 4;
        const f32x4 a = *(const f32x4*)((hi ? p1 : p0) + e), b = *(const f32x4*)((hi ? p3 : p2) + e), c = *(const f32x4*)((hi ? p5 : p4) + e), d = *(const f32x4*)((hi ? p7 : p6) + e);
        LAS float* dst = VEC + (hi ? 1024 : 0) + e;
        *(LAS f32x4*)(dst) = a; *(LAS f32x4*)(dst + 2048) = b; *(LAS f32x4*)(dst + 4096) = c; *(LAS f32x4*)(dst + 6144) = d;
        if (has_gates) { const float* wn = WG + (size_t)(l + 1) * 8 * D + tid * 4;
#pragma unroll
            for (int k = 0; k < 4; ++k) *(LAS f32x4*)(WGS + tid * 4 + 2048 * k) = *(const f32x4*)(wn + 2048 * k); }
    }
    int excl;
    { const int cn = lane < 32 ? (int)__hip_atomic_load(F.ctl + CW_CNT + (l * 32 + lane) * 64, RLX_AGENT) : 0; const int nb = (cn + 255) >> 8; int inc = nb;
#pragma unroll
      for (int o = 1; o < 32; o <<= 1) { const int t = lane_up(inc, o, lane); if (lane >= o) inc += t; }
      excl = inc - nb; }
    __syncthreads();
    v4u q0 = (v4u){0u, 0u, 0u, 0u}; v2u q1 = (v2u){0u, 0u};
    auto load_route = [&](int rowa) { const size_t rr = (size_t)(rowa + (lane < RB ? lane : 0)) * 8; q0 = *(const v4u*)(route + rr); q1 = *(const v2u*)(route + rr + 4); };
    v2u xv[RB][4], ya[RB][4], yc[RB][4]; float w0[RB], w1[RB];
    auto request = [&](int rowa) {
        const unsigned q0x = q0.x, q0y = q0.y, q0z = q0.z, q0w = q0.w, q1x = q1.x, q1y = q1.y;
#pragma unroll
        for (int r = 0; r < RB; ++r) {
            const int e0 = __builtin_amdgcn_readlane((int)q0x, r), p0 = __builtin_amdgcn_readlane((int)q0y, r), e1 = __builtin_amdgcn_readlane((int)q0z, r), p1 = __builtin_amdgcn_readlane((int)q0w, r);
            w0[r] = u2f((unsigned)__builtin_amdgcn_readlane((int)q1x, r)); w1[r] = u2f((unsigned)__builtin_amdgcn_readlane((int)q1y, r));
            const int s0 = __builtin_amdgcn_readlane(excl, e0) * 256 + p0, s1 = __builtin_amdgcn_readlane(excl, e1) * 256 + p1;
#pragma unroll
            for (int j = 0; j < 4; ++j) { xv[r][j] = *(const v2u*)(xres + (size_t)(rowa + r) * D + 256 * j + 4 * lane);
                ya[r][j] = *(const v2u*)(Y + (size_t)s0 * D + 256 * j + 4 * lane); yc[r][j] = *(const v2u*)(Y + (size_t)s1 * D + 256 * j + 4 * lane); } } };
    const int step = NGW * RB;
    int row0 = gw * RB;
    if (row0 < M) { load_route(row0); request(row0); if (row0 + step < M) load_route(row0 + step); }
    const float* bg = F.a_b_gate + (has_gates ? (l + 1) * 8 : 0);
    for (; row0 < M; row0 += step) {
        const int b = row0 >> 13; const LAS float* vl = VEC + 4 * lane;
        f32x4 v[RB][4];
#pragma unroll
        for (int j = 0; j < 4; ++j) { const f32x4 g2 = *(const LAS f32x4*)(vl + (2 + b) * 1024 + 256 * j);
#pragma unroll
            for (int r = 0; r < RB; ++r) { const v2u a = ya[r][j], c = yc[r][j];
                const f32x4 y = (f32x4){bflo(a.x), bfhi(a.x), bflo(a.y), bfhi(a.y)} * w0[r] + (f32x4){bflo(c.x), bfhi(c.x), bflo(c.y), bfhi(c.y)} * w1[r];
                const v2u x = xv[r][j]; v[r][j] = (f32x4){bflo(x.x), bfhi(x.x), bflo(x.y), bfhi(x.y)} * ALPHA + (1.f + g2) * y; } }
        if (row0 + step < M) { request(row0 + step); if (row0 + 2 * step < M) load_route(row0 + 2 * step); }
#pragma unroll
        for (int r = 0; r < RB; ++r) { float s = 0.f;
#pragma unroll
            for (int j = 0; j < 4; ++j) s += (v[r][j].x + v[r][j].y) + (v[r][j].z + v[r][j].w);
            const float mean = wave_sum(s) * (1.f / D); float q = 0.f;
#pragma unroll
            for (int j = 0; j < 4; ++j) { v[r][j] = v[r][j] - mean; q += (v[r][j].x * v[r][j].x + v[r][j].y * v[r][j].y) + (v[r][j].z * v[r][j].z + v[r][j].w * v[r][j].w); }
            const float rstd = 1.f / sqrtf(wave_sum(q) * (1.f / D) + LN_EPS);
#pragma unroll
            for (int j = 0; j < 4; ++j) v[r][j] = v[r][j] * rstd * *(const LAS f32x4*)(vl + 256 * j) + *(const LAS f32x4*)(vl + 1024 + 256 * j); }
#pragma unroll
        for (int r = 0; r < RB; ++r) { const int row = row0 + r;
            if (l == DEPTH - 1) {
#pragma unroll
                for (int j = 0; j < 4; ++j) ST_NT((f32x4*)(F.out + (size_t)row * D + 256 * j + 4 * lane), v[r][j]); }
            else store_row_bf16(xres + (size_t)row * D, v[r], lane);
            if (has_next) {
#pragma unroll
                for (int j = 0; j < 4; ++j) v[r][j] = v[r][j] * (1.f + *(const LAS f32x4*)(vl + (4 + 2 * b) * 1024 + 256 * j)) + *(const LAS f32x4*)(vl + (5 + 2 * b) * 1024 + 256 * j);
                store_row_bf16(H + (size_t)row * D, v[r], lane);
            } }
        if (has_gates) gates_rows_lds<RB>(v, WGS, bg, gates + (size_t)row0 * 8, lane);
    }
}

typedef short bf16x8 __attribute__((ext_vector_type(8)));
#define MFMA16(a, b, c) __builtin_amdgcn_mfma_f32_16x16x32_bf16((a), (b), (c), 0, 0, 0)
constexpr int RS = 136;
template <bool MAXOP> __device__ __forceinline__ float block_scan256(float v, LAS float* scr, int lane, int wave) {
#pragma unroll
    for (int o = 1; o < 64; o <<= 1) { const float t = lane_up(v, o, lane); if (lane >= o) v = MAXOP ? fmaxf(v, t) : v + t; }
    if (lane == 63 && wave < 4) scr[wave] = v;
    __syncthreads();
    float add = MAXOP ? -3.0e38f : 0.f;
#pragma unroll
    for (int w = 0; w < 3; ++w) if (w < wave) add = MAXOP ? fmaxf(add, scr[w]) : add + scr[w];
    v = MAXOP ? fmaxf(v, add) : v + add;
    __syncthreads();
    return v;
}
__device__ __forceinline__ bf16x8 lds_frag16(const LAS bf16* p) { return __builtin_bit_cast(bf16x8, *(const LAS v4u*)p); }
template <int O0, int O1, int O2, int O3, int O4, int O5, int O6, int O7>
__device__ __forceinline__ void tr_read8(unsigned a, v2u& r0, v2u& r1, v2u& r2, v2u& r3, v2u& r4, v2u& r5, v2u& r6, v2u& r7) {
    asm volatile("ds_read_b64_tr_b16 %0, %8 offset:%9\n\tds_read_b64_tr_b16 %1, %8 offset:%10\n\tds_read_b64_tr_b16 %2, %8 offset:%11\n\tds_read_b64_tr_b16 %3, %8 offset:%12\n\t"
                 "ds_read_b64_tr_b16 %4, %8 offset:%13\n\tds_read_b64_tr_b16 %5, %8 offset:%14\n\tds_read_b64_tr_b16 %6, %8 offset:%15\n\tds_read_b64_tr_b16 %7, %8 offset:%16\n\t"
                 "s_waitcnt lgkmcnt(0)"
                 : "=&v"(r0), "=&v"(r1), "=&v"(r2), "=&v"(r3), "=&v"(r4), "=&v"(r5), "=&v"(r6), "=&v"(r7)
                 : "v"(a), "i"(O0), "i"(O1), "i"(O2), "i"(O3), "i"(O4), "i"(O5), "i"(O6), "i"(O7) : "memory");
}
__device__ __forceinline__ bf16x8 frag_lh(v2u lo, v2u hi) { return __builtin_bit_cast(bf16x8, (v4u){lo.x, lo.y, hi.x, hi.y}); }

__device__ __forceinline__ void ml_a(Frame& F) {
    const int tid = opaque_tid(), lane = tid & 63, wave = __builtin_amdgcn_readfirstlane(tid >> 6), fr = lane & 15, fq = lane >> 4;
    LAS unsigned char* KWb = F.lds;
    LAS unsigned char* VRb = F.lds + 18432;
    constexpr int KPB = 288, VPB = 544;
    const unsigned krd = (unsigned)(__UINTPTR_TYPE__)KWb + (4 * fq + (fr >> 2)) * KPB + (lane & 3) * 8;
    const unsigned vrd = (unsigned)(__UINTPTR_TYPE__)VRb + (4 * fq + (fr >> 2)) * VPB + (lane & 3) * 8 + wave * 64;
    const bf16x8 ones = __builtin_bit_cast(bf16x8, (v4u){0x3f803f80u, 0x3f803f80u, 0x3f803f80u, 0x3f803f80u});
    LAS float* wv = (LAS float*)(F.lds + 55296);
    LAS float* scr = (LAS float*)(F.lds + 56320);
    const bf16* proj = (const bf16*)(F.ws + WS_PROJ); const float* gates = (const float*)(F.ws + WS_GATES);
    float* Bv = (float*)(F.ws + WS_MLS); float* Mloc = Bv + 256; float* dn = (float*)(F.ws + WS_MLS + 65536); unsigned* dC = (unsigned*)(F.ws + WS_DC);
    for (int u = blockIdx.x; u < 256; u += F.G) {
        const int bh = u >> 5, c = u & 31, b = bh >> 2, h = bh & 3, t0 = b * SEQ + c * CH;
        v4u kreg[2], vreg[4];
        auto request = [&](int sb) { const bf16* rows = proj + (size_t)(t0 + sb * 64) * NPROJ;
#pragma unroll
            for (int i = 0; i < 2; ++i) { const int p = tid + 512 * i, s = p >> 4, part = p & 15; kreg[i] = *(const v4u*)(rows + (size_t)s * NPROJ + 512 + h * DQK + part * 8); }
#pragma unroll
            for (int i = 0; i < 4; ++i) { const int p = tid + 512 * i, s = p >> 5, part = p & 31; vreg[i] = *(const v4u*)(rows + (size_t)s * NPROJ + 1024 + h * DV + part * 8); } };
        request(0);
        float ip = 0.f, lf = 0.f;
        if (tid < 256) { ip = gates[(size_t)(t0 + tid) * 8 + h]; lf = logsigmoidf_(gates[(size_t)(t0 + tid) * 8 + 4 + h]); }
        const float bs = block_scan256<false>(lf, scr, lane, wave);
        const float as = tid < 256 ? ip - bs : -3.0e38f;
        const float wm = wave_max(as); if (lane == 0) scr[wave] = wm;
        __syncthreads();
        float mloc = scr[0];
#pragma unroll
        for (int w = 1; w < 8; ++w) mloc = fmaxf(mloc, scr[w]);
        if (tid < 256) wv[tid] = expf(as - mloc);
        if (tid == 255) { Bv[u] = bs; Mloc[u] = mloc; }
        f32x4 acc[2][8];
#pragma unroll
        for (int i = 0; i < 2; ++i)
#pragma unroll
            for (int j = 0; j < 8; ++j) acc[i][j] = (f32x4){0.f, 0.f, 0.f, 0.f};
        f32x4 dn4 = (f32x4){0.f, 0.f, 0.f, 0.f};
#pragma unroll 1
        for (int sb = 0; sb < 4; ++sb) {
            __syncthreads();
#pragma unroll
            for (int i = 0; i < 2; ++i) { const int p = tid + 512 * i, s = p >> 4, part = p & 15; v4u a = kreg[i]; const float w = wv[sb * 64 + s];
                a.x = pk2(bflo(a.x) * w, bfhi(a.x) * w); a.y = pk2(bflo(a.y) * w, bfhi(a.y) * w); a.z = pk2(bflo(a.z) * w, bfhi(a.z) * w); a.w = pk2(bflo(a.w) * w, bfhi(a.w) * w);
                *(LAS v4u*)(KWb + s * KPB + part * 16) = a; }
#pragma unroll
            for (int i = 0; i < 4; ++i) { const int p = tid + 512 * i, s = p >> 5, part = p & 31; *(LAS v4u*)(VRb + s * VPB + part * 16) = vreg[i]; }
            __syncthreads();
            if (sb < 3) request(sb + 1);
            v2u va[8];
            tr_read8<0, 16 * VPB, 32, 16 * VPB + 32, 32 * VPB, 48 * VPB, 32 * VPB + 32, 48 * VPB + 32>(vrd, va[0], va[1], va[2], va[3], va[4], va[5], va[6], va[7]);
#define ML_A_STEP(KS, HF) { v2u kb[8]; constexpr int KO = (KS) * 32 * KPB + (HF) * 128; \
                tr_read8<KO, KO + 16 * KPB, KO + 32, KO + 16 * KPB + 32, KO + 64, KO + 16 * KPB + 64, KO + 96, KO + 16 * KPB + 96>(krd, kb[0], kb[1], kb[2], kb[3], kb[4], kb[5], kb[6], kb[7]); \
                const bf16x8 a0 = frag_lh(va[4 * (KS)], va[4 * (KS) + 1]), a1 = frag_lh(va[4 * (KS) + 2], va[4 * (KS) + 3]); \
                _Pragma("unroll") for (int d4 = 0; d4 < 4; ++d4) { const int dt = 4 * (HF) + d4; const bf16x8 bb = frag_lh(kb[2 * d4], kb[2 * d4 + 1]); \
                    acc[0][dt] = MFMA16(a0, bb, acc[0][dt]); acc[1][dt] = MFMA16(a1, bb, acc[1][dt]); if (dt == wave) dn4 = MFMA16(ones, bb, dn4); } }
            ML_A_STEP(0, 0) ML_A_STEP(0, 1) ML_A_STEP(1, 0) ML_A_STEP(1, 1)
#undef ML_A_STEP
        }
        unsigned* dCu = dC + (size_t)u * 16384;
        const bool odd = (fr & 1) != 0;
#pragma unroll
        for (int i = 0; i < 2; ++i) { unsigned* const bp = dCu + (size_t)((32 * wave + 16 * i + 4 * fq + (odd ? 1 : 0)) * 64 + (fr >> 1));
#pragma unroll
            for (int dt = 0; dt < 8; ++dt) { const f32x4 a = acc[i][dt];
                const float n0 = dpp_mov<0xB1>(a[0]), n1 = dpp_mov<0xB1>(a[1]), n2 = dpp_mov<0xB1>(a[2]), n3 = dpp_mov<0xB1>(a[3]);
                bp[8 * dt] = odd ? pk2(n1, a[1]) : pk2(a[0], n0); bp[2 * 64 + 8 * dt] = odd ? pk2(n3, a[3]) : pk2(a[2], n2); } }
        if (fq == 0) dn[u * 128 + 16 * wave + fr] = dn4[0];
        __syncthreads();
    }
}
__device__ __forceinline__ void ml_scan(Frame& F) {
    const int tid = opaque_tid(), lane = tid & 63; (void)lane;
    const float* Bv = (const float*)(F.ws + WS_MLS); const float* Mloc = Bv + 256; float* Min = (float*)(F.ws + WS_MLS) + 512;
    const float* dn = (const float*)(F.ws + WS_MLS + 65536); float* nin = (float*)(F.ws + WS_MLS + 262144);
    const unsigned* dC = (const unsigned*)(F.ws + WS_DC); unsigned* CinT = (unsigned*)(F.ws + WS_CIN);
    LAS float* sB = (LAS float*)F.lds; LAS float* sM = sB + 32; LAS float* f1 = sB + 64; LAS float* f2 = sB + 96; LAS float* ms = sB + 128;
    for (int it0 = blockIdx.x * (NWAVES * 64); it0 < 8 * 16384; it0 += F.G * NWAVES * 64) {
        const int bh = it0 >> 14, e2 = (it0 & 16383) + tid;
        unsigned d[NCH];
#pragma unroll
        for (int c = 0; c < NCH; ++c) d[c] = dC[(size_t)(bh * NCH + c) * 16384 + e2];
        __syncthreads();
        if (tid < NCH) { sB[tid] = Bv[bh * NCH + tid]; sM[tid] = Mloc[bh * NCH + tid]; }
        __syncthreads();
        if (tid == 0) { float m = 0.f;
            for (int c = 0; c < NCH; ++c) { const float ml = sM[c], mm = fmaxf(m, ml); ms[c] = m; f1[c] = expf(m - mm); f2[c] = expf(ml - mm); m = sB[c] + mm; } }
        __syncthreads();
        f32x2 C = (f32x2){0.f, 0.f};
#pragma unroll
        for (int c = 0; c < NCH; ++c) { CinT[(size_t)(bh * NCH + c) * 16384 + e2] = pk2(C.x, C.y); C = C * f1[c] + (f32x2){bflo(d[c]), bfhi(d[c])} * f2[c]; }
        if ((it0 & 16383) == 0) {
            if (tid < 128) { float n = 0.f;
                for (int c = 0; c < NCH; ++c) { nin[(bh * NCH + c) * 128 + tid] = n; n = n * f1[c] + dn[(bh * NCH + c) * 128 + tid] * f2[c]; } }
            if (tid < NCH) Min[bh * NCH + tid] = ms[tid];
        }
    }
}
__device__ __forceinline__ void ml_c(Frame& F, int l) {
    const int tid = opaque_tid(), lane = tid & 63, wave = __builtin_amdgcn_readfirstlane(tid >> 6), fr = lane & 15, fq = lane >> 4;
    LAS bf16* CT = (LAS bf16*)(F.lds);
    LAS bf16* KB = (LAS bf16*)(F.lds + 69632);
    LAS unsigned char* VRb = F.lds + 87040;
    constexpr int VPB = 544;
    LAS float* eav = (LAS float*)(F.lds + 123904);
    LAS float* etv = eav + 256;
    LAS float* iwv = eav + 512;
    LAS float* thv = eav + 768;
    LAS bf16* NB = (LAS bf16*)(F.lds + 128000);
    LAS float* scr = (LAS float*)(F.lds + 128256);
    const bf16* proj = (const bf16*)(F.ws + WS_PROJ); const float* gates = (const float*)(F.ws + WS_GATES);
    const float* Min = (const float*)(F.ws + WS_MLS) + 512; const float* nin = (const float*)(F.ws + WS_MLS + 262144); const bf16* CinT = (const bf16*)(F.ws + WS_CIN);
    bf16* YA = (bf16*)(F.ws + WS_YA);
    const bf16x8 ones = __builtin_bit_cast(bf16x8, (v4u){0x3f803f80u, 0x3f803f80u, 0x3f803f80u, 0x3f803f80u});
    for (int u = blockIdx.x; u < 256; u += F.G) {
        const int bh = u >> 5, c = u & 31, b = bh >> 2, h = bh & 3, t0 = b * SEQ + c * CH;
        v4u cin[8];
        { const bf16* src = CinT + (size_t)u * 32768;
#pragma unroll
          for (int i = 0; i < 8; ++i) { const int p = tid + 512 * i, v = p >> 4, part = p & 15; cin[i] = *(const v4u*)(src + v * 128 + part * 8); } }
        float ip = 0.f, lf = 0.f;
        if (tid < 256) { ip = gates[(size_t)(t0 + tid) * 8 + h]; lf = logsigmoidf_(gates[(size_t)(t0 + tid) * 8 + 4 + h]); }
        const float bs = block_scan256<false>(lf, scr, lane, wave);
        const float as = tid < 256 ? ip - bs : -3.0e38f;
        const float pm = block_scan256<true>(as, scr, lane, wave);
        const float wm = wave_max(as); if (lane == 0) scr[wave] = wm;
        __syncthreads();
        float mloc = scr[0];
#pragma unroll
        for (int w = 1; w < 8; ++w) mloc = fmaxf(mloc, scr[w]);
        const float m_in = Min[u];
        if (tid < 256) { const float mt = bs + fmaxf(m_in, pm); eav[tid] = expf(as - mloc); etv[tid] = expf(bs + mloc - mt); iwv[tid] = expf(bs + m_in - mt); thv[tid] = expf(-mt); }
        if (tid < 64) { const f32x2 n2 = *(const f32x2*)(nin + u * 128 + 2 * tid); ((LAS unsigned*)NB)[tid] = pk2(n2.x, n2.y); }
#pragma unroll
        for (int i = 0; i < 8; ++i) { const int p = tid + 512 * i, v = p >> 4, part = p & 15; *(LAS v4u*)(CT + v * RS + part * 8) = cin[i]; }
        __syncthreads();
#pragma unroll 1
        for (int pass = 0; pass < 2; ++pass) {
            const int tt = pass == 0 ? 15 - wave : wave, nsb = pass == 0 ? 4 : 2;
            const int tmax = 16 * tt + 15, tq = 16 * tt + fr; const size_t row = (size_t)(t0 + tq);
            bf16x8 qf[4];
#pragma unroll
            for (int ks = 0; ks < 4; ++ks) qf[ks] = __builtin_bit_cast(bf16x8, *(const v4u*)(proj + row * NPROJ + h * DQK + 32 * ks + 8 * fq));
            f32x4 acc[17];
#pragma unroll
            for (int vt = 0; vt < 17; ++vt) acc[vt] = (f32x4){0.f, 0.f, 0.f, 0.f};
#pragma unroll
            for (int ks = 0; ks < 4; ++ks) {
#pragma unroll
                for (int vt = 0; vt < 16; ++vt) { acc[vt] = MFMA16(lds_frag16(CT + (16 * vt + fr) * RS + 32 * ks + 8 * fq), qf[ks], acc[vt]);
                    if ((vt & 3) == 3) __builtin_amdgcn_sched_barrier(0); }
                acc[16] = MFMA16(lds_frag16(NB + 32 * ks + 8 * fq), qf[ks], acc[16]);
            }
            { const float iw = iwv[tq];
#pragma unroll
              for (int vt = 0; vt < 17; ++vt) acc[vt] *= iw; }
            const float et = etv[tq];
            v4u kreg[2], vreg[4];
            auto request = [&](int sb) { const bf16* rows = proj + (size_t)(t0 + sb * 64) * NPROJ;
#pragma unroll
                for (int i = 0; i < 2; ++i) { const int p = tid + 512 * i, s = p >> 4, part = p & 15; kreg[i] = *(const v4u*)(rows + (size_t)s * NPROJ + 512 + h * DQK + part * 8); }
#pragma unroll
                for (int i = 0; i < 4; ++i) { const int p = tid + 512 * i, s = p >> 5, part = p & 31; vreg[i] = *(const v4u*)(rows + (size_t)s * NPROJ + 1024 + h * DV + part * 8); } };
            request(0);
#pragma unroll 1
            for (int sb = 0; sb < nsb; ++sb) {
                __syncthreads();
#pragma unroll
                for (int i = 0; i < 2; ++i) { const int p = tid + 512 * i, s = p >> 4, part = p & 15; *(LAS v4u*)(KB + s * RS + part * 8) = kreg[i]; }
#pragma unroll
                for (int i = 0; i < 4; ++i) { const int p = tid + 512 * i, s = p >> 5, part = p & 31; *(LAS v4u*)(VRb + s * VPB + part * 16) = vreg[i]; }
                __syncthreads();
                if (sb + 1 < nsb) request(sb + 1);
#pragma unroll
                for (int sp = 0; sp < 2; ++sp) {
                    const int s0 = sb * 64 + 32 * sp;
                    if (s0 <= tmax) {
                        f32x4 sa = (f32x4){0.f, 0.f, 0.f, 0.f}, sc = (f32x4){0.f, 0.f, 0.f, 0.f};
#pragma unroll
                        for (int ks = 0; ks < 4; ++ks) { sa = MFMA16(lds_frag16(KB + (32 * sp + fr) * RS + 32 * ks + 8 * fq), qf[ks], sa);
                                                         sc = MFMA16(lds_frag16(KB + (32 * sp + 16 + fr) * RS + 32 * ks + 8 * fq), qf[ks], sc); }
                        float p[8];
#pragma unroll
                        for (int j = 0; j < 4; ++j) { const int sA = s0 + 4 * fq + j, sB = sA + 16;
                            p[j] = sA <= tq ? sa[j] * eav[sA] * et : 0.f; p[4 + j] = sB <= tq ? sc[j] * eav[sB] * et : 0.f; }
                        const bf16x8 pf = __builtin_bit_cast(bf16x8, (v4u){pk2(p[0], p[1]), pk2(p[2], p[3]), pk2(p[4], p[5]), pk2(p[6], p[7])});
                        const unsigned va = (unsigned)(__UINTPTR_TYPE__)VRb + (32 * sp + 4 * fq + (fr >> 2)) * VPB + (lane & 3) * 8;
#define ML_C_PV4(G) { v2u l0, h0, l1, h1, l2, h2, l3, h3; constexpr int VO = 128 * (G); \
                        tr_read8<VO, VO + 16 * VPB, VO + 32, VO + 16 * VPB + 32, VO + 64, VO + 16 * VPB + 64, VO + 96, VO + 16 * VPB + 96>(va, l0, h0, l1, h1, l2, h2, l3, h3); \
                        acc[4 * (G)] = MFMA16(frag_lh(l0, h0), pf, acc[4 * (G)]); acc[4 * (G) + 1] = MFMA16(frag_lh(l1, h1), pf, acc[4 * (G) + 1]); \
                        acc[4 * (G) + 2] = MFMA16(frag_lh(l2, h2), pf, acc[4 * (G) + 2]); acc[4 * (G) + 3] = MFMA16(frag_lh(l3, h3), pf, acc[4 * (G) + 3]); __builtin_amdgcn_sched_barrier(0); }
                        ML_C_PV4(0) ML_C_PV4(1) ML_C_PV4(2) ML_C_PV4(3)
#undef ML_C_PV4
                        acc[16] = MFMA16(ones, pf, acc[16]);
                    }
                }
            }
            v2u ogr[16];
#pragma unroll
            for (int vt = 0; vt < 16; ++vt) ogr[vt] = *(const v2u*)(proj + row * NPROJ + 2048 + h * DV + 4 * fq + 16 * vt);
            const float dnm = 1.f / fmaxf(fabsf(acc[16][0]), thv[tq]);
            float s1 = 0.f;
#pragma unroll
            for (int vt = 0; vt < 16; ++vt) { acc[vt] *= dnm; s1 += (acc[vt][0] + acc[vt][1]) + (acc[vt][2] + acc[vt][3]); }
            s1 += lane_xor(s1, 16, lane); s1 += lane_xor(s1, 32, lane);
            const float mean = s1 * (1.f / DV); float s2 = 0.f;
#pragma unroll
            for (int vt = 0; vt < 16; ++vt) { acc[vt] -= mean; s2 += (acc[vt][0] * acc[vt][0] + acc[vt][1] * acc[vt][1]) + (acc[vt][2] * acc[vt][2] + acc[vt][3] * acc[vt][3]); }
            s2 += lane_xor(s2, 16, lane); s2 += lane_xor(s2, 32, lane);
            const float rstd = 1.f / sqrtf(s2 * (1.f / DV) + A_NORM_EPS);
            const float* ng = F.a_norm_g + l * 1024 + h * DV + 4 * fq; bf16* yp = YA + row * D + h * DV + 4 * fq;
#pragma unroll
            for (int vt = 0; vt < 16; ++vt) { const v2u og = ogr[vt]; const f32x4 g = *(const f32x4*)(ng + 16 * vt);
                const float y0 = acc[vt][0] * rstd * g.x * sigmoidf_(bflo(og.x)), y1 = acc[vt][1] * rstd * g.y * sigmoidf_(bfhi(og.x)),
                            y2 = acc[vt][2] * rstd * g.z * sigmoidf_(bflo(og.y)), y3 = acc[vt][3] * rstd * g.w * sigmoidf_(bfhi(og.y));
                *(v2u*)(yp + 16 * vt) = (v2u){pk2(y0, y1), pk2(y2, y3)}; }
        }
        __syncthreads();
    }
}

__device__ __forceinline__ void att_mfma(Frame& F) {
    const int tid = opaque_tid(), lane = tid & 63, wave = __builtin_amdgcn_readfirstlane(tid >> 6), fr = lane & 15, fq = lane >> 4;
    constexpr int NK = 384, KP = 72, VPB = 160;
    LAS bf16* Ks = (LAS bf16*)(F.lds); LAS unsigned char* Vs = F.lds + NK * KP * 2;
    const bf16* Q = (const bf16*)(F.ws + WS_Q); const bf16* KV = (const bf16*)(F.ws + WS_KV);
    bf16* OG = (bf16*)(F.ws + WS_OG); float* LSE = (float*)(F.ws + WS_LSE);
    const bf16x8 ones = __builtin_bit_cast(bf16x8, (v4u){0x3f803f80u, 0x3f803f80u, 0x3f803f80u, 0x3f803f80u});
    constexpr int NU = 1536;
    const unsigned vrd = (unsigned)(__UINTPTR_TYPE__)Vs + (4 * fq + (fr >> 2)) * VPB + (lane & 3) * 8;
    auto decode = [&](int u, int& g, int& b, int& h, int& r, int& rho, int& n2) { g = u >> 9; const int rem = u & 511; b = rem >> 8; h = (rem >> 5) & 7; const int rn = rem & 31;
        r = g == 0 ? 1 : (g == 1 ? 4 : 16); const int nb2 = 32 / r; rho = rn / nb2; n2 = rn % nb2; };
    v4u kreg[6], vreg[6]; bf16x8 qf[2][2];
    auto request = [&](int u) { int g, b, h, r, rho, n2; decode(u, g, b, h, r, rho, n2);
        const bf16* kvb = KV + (size_t)b * SEQ * NKV + g * 512 + h * 64;
#pragma unroll
        for (int i = 0; i < 6; ++i) { const int p = tid + 512 * i, kj = p >> 3, part = p & 7; const int isub = (2 * n2 - 1) * 128 + kj;
            kreg[i] = (v4u){0u, 0u, 0u, 0u}; vreg[i] = (v4u){0u, 0u, 0u, 0u};
            if (isub >= 0) { const bf16* kr = kvb + ((size_t)isub * r + rho) * NKV + part * 8; kreg[i] = *(const v4u*)kr; vreg[i] = *(const v4u*)(kr + 1536); } }
#pragma unroll
        for (int i = 0; i < 2; ++i) { const size_t tq = (size_t)b * SEQ + (size_t)(n2 * 256 + 16 * (wave + 8 * i) + fr) * r + rho;
#pragma unroll
            for (int ks = 0; ks < 2; ++ks) qf[i][ks] = __builtin_bit_cast(bf16x8, *(const v4u*)(Q + tq * NQ + g * 512 + h * 64 + 32 * ks + 8 * fq)); } };
    const int ustep = (F.G % 8 == 0) ? F.G / 8 : F.G; const int ubase = (F.G % 8 == 0) ? (int)(blockIdx.x % 8) * (NU / 8) : 0, uend = (F.G % 8 == 0) ? ubase + NU / 8 : NU;
    int u = ubase + ((F.G % 8 == 0) ? (int)(blockIdx.x / 8) : (int)blockIdx.x);
    if (u < uend) request(u);
    for (; u < uend; u += ustep) {
        int g, b, h, r, rho, n2; decode(u, g, b, h, r, rho, n2);
        __syncthreads();
#pragma unroll
        for (int i = 0; i < 6; ++i) { const int p = tid + 512 * i, kj = p >> 3, part = p & 7; *(LAS v4u*)(Ks + kj * KP + part * 8) = kreg[i]; *(LAS v4u*)(Vs + kj * VPB + part * 16) = vreg[i]; }
        bf16x8 q[2][2];
#pragma unroll
        for (int i = 0; i < 2; ++i) { q[i][0] = qf[i][0]; q[i][1] = qf[i][1]; }
        __syncthreads();
        if (u + ustep < uend) request(u + ustep);
#pragma unroll
        for (int i = 0; i < 2; ++i) {
            const int tt = wave + 8 * i, qi = 16 * tt + fr;
            const size_t tokq = (size_t)b * SEQ + (size_t)(n2 * 256 + qi) * r + rho;
            const int pi0 = tt >> 1;
            f32x4 sc[5][2];
#pragma unroll
            for (int pi = 0; pi < 5; ++pi)
#pragma unroll
                for (int st = 0; st < 2; ++st) { const int tile = 2 * (pi0 + pi) + st; f32x4 a = (f32x4){0.f, 0.f, 0.f, 0.f};
                    a = MFMA16(lds_frag16(Ks + (16 * tile + fr) * KP + 8 * fq), q[i][0], a); a = MFMA16(lds_frag16(Ks + (16 * tile + fr) * KP + 32 + 8 * fq), q[i][1], a);
                    sc[pi][st] = a; }
            const float NEG = -__builtin_inff();
#pragma unroll
            for (int st = 0; st < 2; ++st)
#pragma unroll
                for (int j = 0; j < 4; ++j) { const int k0 = 32 * pi0 + 16 * st + 4 * fq + j; sc[0][st][j] = k0 >= qi ? sc[0][st][j] : NEG; sc[4][st][j] = k0 + 128 <= qi + 128 ? sc[4][st][j] : NEG; }
            if (n2 == 0) {
#pragma unroll
                for (int pi = 0; pi < 5; ++pi)
#pragma unroll
                    for (int st = 0; st < 2; ++st)
#pragma unroll
                        for (int j = 0; j < 4; ++j) { const int kj = 32 * (pi0 + pi) + 16 * st + 4 * fq + j; sc[pi][st][j] = kj >= 128 ? sc[pi][st][j] : NEG; }
            }
            float mx = NEG;
#pragma unroll
            for (int pi = 0; pi < 5; ++pi)
#pragma unroll
                for (int st = 0; st < 2; ++st)
#pragma unroll
                    for (int j = 0; j < 4; ++j) mx = fmaxf(mx, sc[pi][st][j]);
            mx = fmaxf(mx, lane_xor(mx, 16, lane)); mx = fmaxf(mx, lane_xor(mx, 32, lane));
            f32x4 acc[4], den = (f32x4){0.f, 0.f, 0.f, 0.f};
#pragma unroll
            for (int vt = 0; vt < 4; ++vt) acc[vt] = (f32x4){0.f, 0.f, 0.f, 0.f};
#pragma unroll
            for (int pi = 0; pi < 5; ++pi) { float p[8];
#pragma unroll
                for (int j = 0; j < 4; ++j) { p[j] = __builtin_amdgcn_exp2f(sc[pi][0][j] - mx); p[4 + j] = __builtin_amdgcn_exp2f(sc[pi][1][j] - mx); }
                const bf16x8 pf = __builtin_bit_cast(bf16x8, (v4u){pk2(p[0], p[1]), pk2(p[2], p[3]), pk2(p[4], p[5]), pk2(p[6], p[7])});
                { v2u l0, h0, l1, h1, l2, h2, l3, h3;
                  tr_read8<0, 16 * VPB, 32, 16 * VPB + 32, 64, 16 * VPB + 64, 96, 16 * VPB + 96>(vrd + 32 * (pi0 + pi) * VPB, l0, h0, l1, h1, l2, h2, l3, h3);
                  acc[0] = MFMA16(frag_lh(l0, h0), pf, acc[0]); acc[1] = MFMA16(frag_lh(l1, h1), pf, acc[1]); acc[2] = MFMA16(frag_lh(l2, h2), pf, acc[2]); acc[3] = MFMA16(frag_lh(l3, h3), pf, acc[3]); }
                den = MFMA16(ones, pf, den); }
            const float lsum = den[0], inv = 1.f / lsum;
            bf16* op = OG + ((size_t)g * M + tokq) * BW + h * 64 + 4 * fq;
#pragma unroll
            for (int vt = 0; vt < 4; ++vt) *(v2u*)(op + 16 * vt) = (v2u){pk2(acc[vt][0] * inv, acc[vt][1] * inv), pk2(acc[vt][2] * inv, acc[vt][3] * inv)};
            if (fq == 0) LSE[((size_t)g * M + tokq) * 8 + h] = (mx + __builtin_amdgcn_logf(lsum)) * 0.6931471805599453f;
        }
    }
}
__device__ __forceinline__ void att_combine(Frame& F) {
    const int gt = blockIdx.x * (NWAVES * 64) + opaque_tid(), NGT = F.G * NWAVES * 64;
    const bf16* OG = (const bf16*)(F.ws + WS_OG); const float* LSE = (const float*)(F.ws + WS_LSE); bf16* YA = (bf16*)(F.ws + WS_YA);
    for (int it = gt; it < M * 64; it += NGT) {
        const int tok = it >> 6, h = (it >> 3) & 7, pc = it & 7;
        const float l0 = LSE[(size_t)tok * 8 + h], l1 = LSE[((size_t)M + tok) * 8 + h], l2 = LSE[((size_t)2 * M + tok) * 8 + h];
        const float mx = fmaxf(l0, fmaxf(l1, l2)); float w0 = expf(l0 - mx), w1 = expf(l1 - mx), w2 = expf(l2 - mx); const float inv = 1.f / (w0 + w1 + w2); w0 *= inv; w1 *= inv; w2 *= inv;
        const size_t off = (size_t)tok * BW + h * 64 + pc * 8;
        const v4u a = *(const v4u*)(OG + off), c = *(const v4u*)(OG + (size_t)M * BW + off), d = *(const v4u*)(OG + (size_t)2 * M * BW + off);
        v4u o;
        o.x = pk2(w0 * bflo(a.x) + w1 * bflo(c.x) + w2 * bflo(d.x), w0 * bfhi(a.x) + w1 * bfhi(c.x) + w2 * bfhi(d.x));
        o.y = pk2(w0 * bflo(a.y) + w1 * bflo(c.y) + w2 * bflo(d.y), w0 * bfhi(a.y) + w1 * bfhi(c.y) + w2 * bfhi(d.y));
        o.z = pk2(w0 * bflo(a.z) + w1 * bflo(c.z) + w2 * bflo(d.z), w0 * bfhi(a.z) + w1 * bfhi(c.z) + w2 * bfhi(d.z));
        o.w = pk2(w0 * bflo(a.w) + w1 * bflo(c.w) + w2 * bflo(d.w), w0 * bfhi(a.w) + w1 * bfhi(c.w) + w2 * bfhi(d.w));
        __builtin_nontemporal_store(o, (v4u*)(YA + off));
    }
}

constexpr int NPHASE = 2 + 9 * DEPTH;
struct Args { const void* in[21]; float* out; unsigned char* ws; int ph_lo, ph_hi; };
__device__ __forceinline__ void moe_table(Frame& F, int l) {
    LAS int* tab = (LAS int*)(F.lds + LDSCTL_OFF + 64);
    const int tid = opaque_tid();
    if (tid < 64) { const int lane = tid & 63; const int cn = lane < 32 ? (int)__hip_atomic_load(F.ctl + CW_CNT + (l * 32 + lane) * 64, RLX_AGENT) : 0; const int nb = (cn + 255) >> 8; int inc = nb;
#pragma unroll
        for (int o = 1; o < 32; o <<= 1) { const int t = lane_up(inc, o, lane); if (lane >= o) inc += t; }
        if (lane < 32) { tab[lane] = inc - nb; tab[33 + lane] = cn; } if (lane == 31) tab[32] = inc; }
    __syncthreads();
}
__global__ void __launch_bounds__(NWAVES * 64, 2) fwd(Args args) {
    extern __shared__ __attribute__((aligned(16))) unsigned char lds[];
    Frame F;
    F.lds = (LAS unsigned char*)lds; F.ws = args.ws; F.ctl = (unsigned*)(args.ws + WS_CTL);
    F.wave = __builtin_amdgcn_readfirstlane((int)threadIdx.x >> 6); asm volatile("" : "+s"(F.wave)); F.tid = hw_tid(F.wave); F.lane = F.tid & 63; F.G = gridDim.x;
    F.x = (const float*)args.in[0]; F.c = (const float*)args.in[1]; F.pos = (const int*)args.in[2]; F.ada_w = (const float*)args.in[3]; F.ada_b = (const float*)args.in[4];
    F.ln_g = (const float*)args.in[5]; F.ln_b = (const float*)args.in[6]; F.a_w_in = (const float*)args.in[7]; F.a_b_gate = (const float*)args.in[8]; F.a_norm_g = (const float*)args.in[9];
    F.a_w_out = (const float*)args.in[10]; F.b_w_kv = (const float*)args.in[11]; F.b_w_q = (const float*)args.in[12]; F.b_w_o = (const float*)args.in[13];
    F.w_r1 = (const float*)args.in[14]; F.b_r1 = (const float*)args.in[15]; F.w_r2 = (const float*)args.in[16]; F.b_r2 = (const float*)args.in[17];
    F.w_gate = (const float*)args.in[18]; F.w_up = (const float*)args.in[19]; F.w_down = (const float*)args.in[20]; F.out = args.out;
    for (int u = F.tid; u < (LDS_BYTES - LDSCTL_OFF) / 4; u += NWAVES * 64) ((LAS unsigned*)(F.lds + LDSCTL_OFF))[u] = 0u;
    __syncthreads();
    const int lo = args.ph_lo, hi = args.ph_hi;
    XcdBarrier bar; bar.bar = F.ctl + CW_BAR; bar.x = 0; bar.st = nullptr; bar.w = F.wave;
    if (hi - lo > 1) bar = xcd_barrier_post(F.ctl + CW_BAR, (volatile LAS unsigned*)(F.lds + LDSCTL_OFF), F.wave);
#define IN(k) (lo <= (k) && (k) < hi)
#define SEAM(k) do { if ((k) + 1 < hi) xcd_barrier(bar); } while (0)
    const int c0 = (int)blockIdx.x;
    const int vcu = (F.G % 8 == 0) ? (int)(blockIdx.x % 8) * (F.G / 8) + (int)(blockIdx.x / 8) : (int)blockIdx.x;

    if (IN(0)) { pro_a(F); SEAM(0); }
    if (IN(1)) { pro_b(F); SEAM(1); }
    for (int l = 0; l < DEPTH; ++l) {
        const int pb = 2 + 9 * l;
        if (l < NA) {
            if (IN(pb + 0)) {
                pg8::Gemm g{(const bf16*)(F.ws + WS_H), (const bf16*)(F.ws + WS_WIN) + (size_t)l * NPROJ * D, M, NPROJ, D}; pg8::StaticOrder S; S.init(M, NPROJ, F.G, c0);
                pg8::EpiBf16S E{(bf16*)(F.ws + WS_PROJ), NPROJ, 2, 4, 0.08838834764831845f};
                pg8::gemm_phase<pg8::EpiBf16S, pg8::StaticOrder, true>(F.lds, g, S, E, F.wave);
                SEAM(pb + 0);
            }
            if (IN(pb + 1)) { ml_a(F); SEAM(pb + 1); }
            if (IN(pb + 2)) { ml_scan(F); SEAM(pb + 2); }
            if (IN(pb + 3)) { ml_c(F, l); SEAM(pb + 3); }
            if (IN(pb + 4)) {
                pg8::Gemm g{(const bf16*)(F.ws + WS_YA), (const bf16*)(F.ws + WS_WOUT) + (size_t)l * D * D, M, D, D}; pg8::StaticOrder S; S.init(M, D, F.G, c0);
                pg8::EpiBf16S E{(bf16*)(F.ws + WS_YMIX), D, 0, 0, 1.f};
                pg8::gemm_phase<pg8::EpiBf16S, pg8::StaticOrder, false>(F.lds, g, S, E, F.wave);
                SEAM(pb + 4);
            }
        } else {
            if (IN(pb + 0)) {
                if (l == NA) {
                    pg8::Gemm g{(const bf16*)(F.ws + WS_X), (const bf16*)(F.ws + WS_WKV), M, NKV, D}; pg8::StaticOrder S; S.init(M, NKV, F.G, c0);
                    pg8::EpiRope E{(bf16*)(F.ws + WS_KV), NKV, 6, (const float*)(F.ws + WS_ROPE), 1.0f};
                    pg8::gemm_phase<pg8::EpiRope, pg8::StaticOrder, true>(F.lds, g, S, E, F.wave);
                }
                {
                    pg8::Gemm g{(const bf16*)(F.ws + WS_H), (const bf16*)(F.ws + WS_WQ) + (size_t)(l - NA) * NQ * D, M, NQ, D}; pg8::StaticOrder S; S.init(M, NQ, F.G, c0);
                    pg8::EpiRope E{(bf16*)(F.ws + WS_Q), NQ, 6, (const float*)(F.ws + WS_ROPE), 0.125f * 1.4426950408889634f};
                    pg8::gemm_phase<pg8::EpiRope, pg8::StaticOrder, true>(F.lds, g, S, E, F.wave);
                    { const int nq = (M / 256) * (NQ / 256), full = nq / F.G, cutq = nq - full * F.G;
                      if (cutq > 0 && F.G - cutq >= F.G / 4) { __syncthreads(); if (c0 >= cutq) { const int tid = opaque_tid(), lane = tid & 63, wave = __builtin_amdgcn_readfirstlane(tid >> 6);
                              conv_run<5>(F, l, (c0 - cutq) * NWAVES + wave, (F.G - cutq) * NWAVES, lane, wave); } }
                      else { __syncthreads(); const int tid = opaque_tid(), lane = tid & 63, wave = __builtin_amdgcn_readfirstlane(tid >> 6); conv_run<5>(F, l, c0 * NWAVES + wave, F.G * NWAVES, lane, wave); } }
                }
                SEAM(pb + 0);
            }
            if (IN(pb + 1)) { att_mfma(F); SEAM(pb + 1); }
            if (IN(pb + 2)) { att_combine(F); SEAM(pb + 2); }
            if (IN(pb + 4)) {
                pg8::Gemm g{(const bf16*)(F.ws + WS_YA), (const bf16*)(F.ws + WS_WO) + (size_t)(l - NA) * D * BW, M, D, BW}; pg8::StaticOrder S; S.init(M, D, F.G, c0);
                pg8::EpiBf16S E{(bf16*)(F.ws + WS_YMIX), D, 0, 0, 1.f};
                pg8::gemm_phase<pg8::EpiBf16S, pg8::StaticOrder, false>(F.lds, g, S, E, F.wave);
                SEAM(pb + 4);
            }
        }
        if (IN(pb + 5)) { phase_r1<false>(F, l); SEAM(pb + 5); }
        if (IN(pb + 6)) {
            moe_table(F, l);
            pg8::Gemm g{(const bf16*)(F.ws + WS_H), nullptr, 0, 512, D};
            pg8::MoeOrder S{(const LAS int*)(F.lds + LDSCTL_OFF + 64), (const int*)(F.ws + WS_LIST), (const bf16*)(F.ws + WS_WGU) + (size_t)l * NE * 512 * D, (size_t)512 * D, 2, F.G, vcu, 1};
            pg8::EpiGU E{(bf16*)(F.ws + WS_ACT)};
            pg8::gemm_phase<pg8::EpiGU, pg8::MoeOrder, true>(F.lds, g, S, E, F.wave);
            if (l + 1 < DEPTH) { __syncthreads(); tail_fill<4>(F, l + 1, ((const LAS int*)(F.lds + LDSCTL_OFF + 64))[32] * 2, vcu); }
            SEAM(pb + 6);
        }
        if (IN(pb + 7)) {
            if (!IN(pb + 6)) moe_table(F, l);
            pg8::Gemm g{(const bf16*)(F.ws + WS_ACT), nullptr, 0, D, MH};
            pg8::MoeOrder S{(const LAS int*)(F.lds + LDSCTL_OFF + 64), (const int*)(F.ws + WS_LIST), (const bf16*)(F.ws + WS_WD) + (size_t)l * NE * D * MH, (size_t)D * MH, 4, F.G, vcu, 0};
            pg8::EpiBf16S E{(bf16*)(F.ws + WS_Y), D, 0, 0, 1.f};
            pg8::gemm_phase<pg8::EpiBf16S, pg8::MoeOrder, true>(F.lds, g, S, E, F.wave);
            if (l + 1 < DEPTH) { __syncthreads(); const int tu = ((const LAS int*)(F.lds + LDSCTL_OFF + 64))[32] * 4;
                if (l == 0) tail_fill<1>(F, 0, tu, vcu); else if (l == 1) tail_fill<2>(F, 0, tu, vcu); else tail_fill<3>(F, 0, tu, vcu); }
            SEAM(pb + 7);
        }
        if (IN(pb + 8)) { phase_r2<false>(F, l); SEAM(pb + 8); }
    }
#undef IN
#undef SEAM
}

extern "C" void kernel_launch(void* const* d_in, const int* in_sizes, int n_in, void* d_out, int out_size, void* d_ws, size_t ws_size, hipStream_t stream) {
    static int grid = 0;
    if (grid == 0) {
        if (n_in != 21 || in_sizes[0] != M * D || out_size != M * D || ws_size < WS_END) { fprintf(stderr, "kernel_launch: unexpected shapes (n_in %d, in0 %d, out %d, ws %zu < %zu); nothing launched\n", n_in, n_in > 0 ? in_sizes[0] : -1, out_size, ws_size, (size_t)WS_END); grid = -1; return; }
        int dev = 0, cus = 0, per_cu = 0;
        if (hipGetDevice(&dev) != hipSuccess || hipDeviceGetAttribute(&cus, hipDeviceAttributeMultiprocessorCount, dev) != hipSuccess) { grid = -1; return; }
        if (hipFuncSetAttribute((const void*)fwd, hipFuncAttributeMaxDynamicSharedMemorySize, LDS_BYTES) != hipSuccess) { fprintf(stderr, "kernel_launch: hipFuncSetAttribute failed\n"); grid = -1; return; }
        if (hipOccupancyMaxActiveBlocksPerMultiprocessor(&per_cu, (const void*)fwd, NWAVES * 64, LDS_BYTES) != hipSuccess || per_cu < 1) fprintf(stderr, "kernel_launch: occupancy query reports %d workgroups per CU\n", per_cu);
        (void)hipGetLastError();
        grid = cus;
    }
    if (grid < 0) return;
    if (hipMemsetAsync((char*)d_ws + WS_CTL, 0, CTL_ZERO_BYTES, stream) != hipSuccess) return;
    Args a{};
    for (int i = 0; i < 21; ++i) a.in[i] = d_in[i];
    a.out = (float*)d_out; a.ws = (unsigned char*)d_ws;
#if MK_N_LAUNCHES == 1
    a.ph_lo = 0; a.ph_hi = NPHASE;
    hipLaunchKernelGGL(fwd, dim3(grid), dim3(NWAVES * 64), LDS_BYTES, stream, a);
#else
    for (int p = 0; p < NPHASE; ++p) { a.ph_lo = p; a.ph_hi = p + 1; hipLaunchKernelGGL(fwd, dim3(grid), dim3(NWAVES * 64), LDS_BYTES, stream, a); }
#endif
}
```
